# Optimizing an MI355X kernel written in HIP

```python
import math
import jax, jax.numpy as jnp
from jax import lax
import numpy as np

D_MODEL = 1024
BATCH = 8
SEQ = 2048
DEPTH = 2
DEC_BATCH = 128
DEC_SEQ = 1
PAST_LEN = 16384
PAGE_SIZE = 128

N_MIXERS = 2
N_GDN = (DEPTH + 1) // 2
N_SSD = DEPTH // 2

CONV_W = 4
CHUNK = 64

GDN_HEADS = 8
GDN_DK = 128
GDN_DV = 128
GDN_QK = GDN_HEADS * GDN_DK
GDN_VD = GDN_HEADS * GDN_DV
GDN_CONV_DIM = 2 * GDN_QK + GDN_VD
GDN_IN = GDN_CONV_DIM + GDN_VD + 2 * GDN_HEADS

SSD_INNER = 2 * D_MODEL
SSD_HEADDIM = 64
SSD_HEADS = SSD_INNER // SSD_HEADDIM
SSD_GROUPS = 4
SSD_STATE = 128
SSD_HPG = SSD_HEADS // SSD_GROUPS
SSD_CONV_DIM = SSD_INNER + 2 * SSD_GROUPS * SSD_STATE
SSD_IN = SSD_INNER + SSD_CONV_DIM + SSD_HEADS

D_FF = 2816
FFN_CONV_W = 3

DN_ALPHA = (2 * DEPTH) ** 0.25
DN_BETA = (8 * DEPTH) ** -0.25
LN_EPS = 1e-5
RMS_EPS = 1e-6

kernel_name = "hybrid_gdn_mamba2_convffn_deepnorm_step"


def _layer_norm(x, g, b):
    xf = x.astype(jnp.float32)
    mu = jnp.mean(xf, -1, keepdims=True)
    var = jnp.mean(jnp.square(xf - mu), -1, keepdims=True)
    return ((xf - mu) * lax.rsqrt(var + LN_EPS) * g + b).astype(x.dtype)


def _rmsnorm(t, w):
    return t * lax.rsqrt(jnp.mean(jnp.square(t), -1, keepdims=True) + RMS_EPS) * w


def _l2norm(t):
    return t * lax.rsqrt(jnp.sum(jnp.square(t), -1, keepdims=True) + 1e-6)


def _causal_dwconv(x, buf, w, b):
    xx = jnp.concatenate([buf.astype(x.dtype), x], axis=1)
    seq_len, width = x.shape[1], w.shape[0]
    y = b + xx[:, 0:seq_len] * w[0]
    for k in range(1, width):
        y = y + xx[:, k:k + seq_len] * w[k]
    return y, xx[:, -(width - 1):]


def _to_chunks(a, csz):
    seq_len = a.shape[1]
    n = -(-seq_len // csz)
    a = jnp.pad(a, [(0, 0), (0, n * csz - seq_len)] + [(0, 0)] * (a.ndim - 2))
    return a.reshape(a.shape[0], n, csz, *a.shape[2:])


def _gated_delta_rule(q, k, v, beta, g, s0):
    seq_len = q.shape[1]
    csz = min(CHUNK, seq_len)
    qc, kc, vc, bc, gc = (_to_chunks(t, csz) for t in (q, k, v, beta, g))
    gcum = jnp.cumsum(gc, axis=2)
    gcum_h = jnp.swapaxes(gcum, 2, 3)
    incl = jnp.tril(jnp.ones((csz, csz), dtype=bool))
    strict = jnp.tril(jnp.ones((csz, csz), dtype=bool), -1)
    gamma = jnp.exp(jnp.where(incl, gcum_h[..., :, None] - gcum_h[..., None, :], -jnp.inf))
    kb = kc * bc[..., None]
    kk = jnp.einsum('bnihd,bnjhd->bnhij', kb, kc) * gamma
    eye = jnp.eye(csz, dtype=kk.dtype)
    a_mat = eye + jnp.where(strict, kk, 0.0)
    t_mat = lax.linalg.triangular_solve(a_mat, jnp.broadcast_to(eye, a_mat.shape),
                                        left_side=True, lower=True)
    u = jnp.einsum('bnhij,bnjhd->bnihd', t_mat, vc * bc[..., None])
    w = jnp.einsum('bnhij,bnjhd->bnihd', t_mat, kb * jnp.exp(gcum)[..., None])
    qk = jnp.einsum('bnihd,bnjhd->bnhij', qc, kc) * gamma
    q_dec = qc * jnp.exp(gcum)[..., None]
    g_last = gcum[:, :, -1]
    k_dec = kc * jnp.exp(g_last[:, :, None] - gcum)[..., None]

    def step(s, inp):
        u_n, w_n, qk_n, qd_n, kd_n, gl_n = inp
        v_new = u_n - jnp.einsum('bihk,bhkv->bihv', w_n, s)
        o_n = jnp.einsum('bihk,bhkv->bihv', qd_n, s) + jnp.einsum('bhij,bjhv->bihv', qk_n, v_new)
        s = s * jnp.exp(gl_n)[..., None, None] + jnp.einsum('bihk,bihv->bhkv', kd_n, v_new)
        return s, o_n

    xs = tuple(jnp.moveaxis(t, 1, 0) for t in (u, w, qk, q_dec, k_dec, g_last))
    s_fin, o = lax.scan(step, s0, xs)
    o = jnp.moveaxis(o, 0, 1)
    o = o.reshape(o.shape[0], -1, GDN_HEADS, GDN_DV)[:, :seq_len]
    return o, s_fin


def _ssd_scan(x, dt, a, bm, cm, s0):
    bsz, seq_len = x.shape[0], x.shape[1]
    csz = min(CHUNK, seq_len)
    xc = _to_chunks(x * dt[..., None], csz)
    ac = _to_chunks(dt * a, csz)
    bc = _to_chunks(bm, csz)
    cc = _to_chunks(cm, csz)
    n = xc.shape[1]
    acum = jnp.cumsum(ac, axis=2)
    acum_h = jnp.swapaxes(acum, 2, 3)
    incl = jnp.tril(jnp.ones((csz, csz), dtype=bool))
    seg = jnp.exp(jnp.where(incl, acum_h[..., :, None] - acum_h[..., None, :], -jnp.inf))
    cb = jnp.einsum('bnigs,bnjgs->bngij', cc, bc)
    scores = seg.reshape(bsz, n, SSD_GROUPS, SSD_HPG, csz, csz) * cb[:, :, :, None]
    xg = xc.reshape(bsz, n, csz, SSD_GROUPS, SSD_HPG, SSD_HEADDIM)
    y_diag = jnp.einsum('bnghij,bnjghp->bnighp', scores, xg).reshape(bsz, n, csz, SSD_HEADS, SSD_HEADDIM)
    a_last = acum[:, :, -1]
    decay_to_end = jnp.exp(a_last[:, :, None] - acum)
    xdec = (xc * decay_to_end[..., None]).reshape(bsz, n, csz, SSD_GROUPS, SSD_HPG, SSD_HEADDIM)
    chunk_states = jnp.einsum('bnjgs,bnjghp->bnghps', bc, xdec).reshape(
        bsz, n, SSD_HEADS, SSD_HEADDIM, SSD_STATE)

    def step(s, inp):
        c_n, acum_n, cs_n, al_n = inp
        sg = s.reshape(bsz, SSD_GROUPS, SSD_HPG, SSD_HEADDIM, SSD_STATE)
        y_off = jnp.einsum('bigs,bghps->bighp', c_n, sg).reshape(
            bsz, csz, SSD_HEADS, SSD_HEADDIM) * jnp.exp(acum_n)[..., None]
        s = s * jnp.exp(al_n)[..., None, None] + cs_n
        return s, y_off

    xs = tuple(jnp.moveaxis(t, 1, 0) for t in (cc, acum, chunk_states, a_last))
    s_fin, y_off = lax.scan(step, s0, xs)
    y = y_diag + jnp.moveaxis(y_off, 0, 1)
    y = y.reshape(bsz, -1, SSD_HEADS, SSD_HEADDIM)[:, :seq_len]
    return y, s_fin


def _gdn_mixer(x, conv_buf, s0, w_in, conv_w, conv_b, a_log, dt_bias, norm_w, w_out):
    bsz, seq_len, _ = x.shape
    proj = x @ w_in
    qkv = proj[..., :GDN_CONV_DIM]
    z = proj[..., GDN_CONV_DIM:GDN_CONV_DIM + GDN_VD]
    b_raw = proj[..., GDN_CONV_DIM + GDN_VD:GDN_CONV_DIM + GDN_VD + GDN_HEADS]
    a_raw = proj[..., GDN_CONV_DIM + GDN_VD + GDN_HEADS:]
    qkv, new_buf = _causal_dwconv(qkv, conv_buf, conv_w, conv_b)
    qkv = jax.nn.silu(qkv).astype(jnp.float32)
    q = _l2norm(qkv[..., :GDN_QK].reshape(bsz, seq_len, GDN_HEADS, GDN_DK)) * (GDN_DK ** -0.5)
    k = _l2norm(qkv[..., GDN_QK:2 * GDN_QK].reshape(bsz, seq_len, GDN_HEADS, GDN_DK))
    v = qkv[..., 2 * GDN_QK:].reshape(bsz, seq_len, GDN_HEADS, GDN_DV)
    beta = jax.nn.sigmoid(b_raw.astype(jnp.float32))
    g = -jnp.exp(a_log.astype(jnp.float32)) * jax.nn.softplus(a_raw.astype(jnp.float32) + dt_bias)
    o, s_fin = _gated_delta_rule(q, k, v, beta, g, s0.astype(jnp.float32))
    o = _rmsnorm(o, norm_w) * jax.nn.silu(z.astype(jnp.float32).reshape(bsz, seq_len, GDN_HEADS, GDN_DV))
    out = o.reshape(bsz, seq_len, GDN_VD).astype(x.dtype) @ w_out
    return out, new_buf, s_fin.astype(s0.dtype)


def _ssd_mixer(x, conv_buf, s0, w_in, conv_w, conv_b, a_log, dt_bias, d_skip, norm_w, w_out):
    bsz, seq_len, _ = x.shape
    gn = SSD_GROUPS * SSD_STATE
    proj = x @ w_in
    z = proj[..., :SSD_INNER]
    xbc = proj[..., SSD_INNER:SSD_INNER + SSD_CONV_DIM]
    dt_raw = proj[..., SSD_INNER + SSD_CONV_DIM:]
    xbc, new_buf = _causal_dwconv(xbc, conv_buf, conv_w, conv_b)
    xbc = jax.nn.silu(xbc).astype(jnp.float32)
    xs = xbc[..., :SSD_INNER].reshape(bsz, seq_len, SSD_HEADS, SSD_HEADDIM)
    bm = xbc[..., SSD_INNER:SSD_INNER + gn].reshape(bsz, seq_len, SSD_GROUPS, SSD_STATE)
    cm = xbc[..., SSD_INNER + gn:].reshape(bsz, seq_len, SSD_GROUPS, SSD_STATE)
    dt = jax.nn.softplus(dt_raw.astype(jnp.float32) + dt_bias)
    a = -jnp.exp(a_log.astype(jnp.float32))
    y, s_fin = _ssd_scan(xs, dt, a, bm, cm, s0.astype(jnp.float32))
    y = y + d_skip[:, None] * xs
    y = y.reshape(bsz, seq_len, SSD_INNER) * jax.nn.silu(z.astype(jnp.float32))
    y = _rmsnorm(y.reshape(bsz, seq_len, SSD_GROUPS, SSD_INNER // SSD_GROUPS),
                 norm_w.reshape(SSD_GROUPS, SSD_INNER // SSD_GROUPS)).reshape(bsz, seq_len, SSD_INNER)
    out = y.astype(x.dtype) @ w_out
    return out, new_buf, s_fin.astype(s0.dtype)


def _conv_ffn(x, buf, w_up, conv_w, conv_b, w_down):
    gv = x @ w_up
    gate, val = gv[..., :D_FF], gv[..., D_FF:]
    gate, new_buf = _causal_dwconv(gate, buf, conv_w, conv_b)
    return (jax.nn.silu(gate) * val) @ w_down, new_buf


def _trunk(x, gdn_conv, gdn_state, ssd_conv, ssd_state, ffn_conv, weights):
    (gdn_w_in, gdn_conv_w, gdn_conv_b, gdn_a_log, gdn_dt_bias, gdn_norm_w, gdn_w_out,
     ssd_w_in, ssd_conv_w, ssd_conv_b, ssd_a_log, ssd_dt_bias, ssd_d, ssd_norm_w, ssd_w_out,
     ffn_w_up, ffn_conv_w, ffn_conv_b, ffn_w_down, ln1_g, ln1_b, ln2_g, ln2_b) = weights
    gdn_conv_out, gdn_state_out, ssd_conv_out, ssd_state_out, ffn_conv_out = [], [], [], [], []
    for i in range(DEPTH):
        j = i // N_MIXERS
        if i % N_MIXERS == 0:
            h, nb, ns = _gdn_mixer(x, gdn_conv[j], gdn_state[j], gdn_w_in[j], gdn_conv_w[j], gdn_conv_b[j],
                                   gdn_a_log[j], gdn_dt_bias[j], gdn_norm_w[j], gdn_w_out[j])
            gdn_conv_out.append(nb)
            gdn_state_out.append(ns)
        else:
            h, nb, ns = _ssd_mixer(x, ssd_conv[j], ssd_state[j], ssd_w_in[j], ssd_conv_w[j], ssd_conv_b[j],
                                   ssd_a_log[j], ssd_dt_bias[j], ssd_d[j], ssd_norm_w[j], ssd_w_out[j])
            ssd_conv_out.append(nb)
            ssd_state_out.append(ns)
        x = _layer_norm(DN_ALPHA * x + h, ln1_g[i], ln1_b[i])
        f, fb = _conv_ffn(x, ffn_conv[i], ffn_w_up[i], ffn_conv_w[i], ffn_conv_b[i], ffn_w_down[i])
        ffn_conv_out.append(fb)
        x = _layer_norm(DN_ALPHA * x + f, ln2_g[i], ln2_b[i])
    return (x, jnp.stack(gdn_conv_out), jnp.stack(gdn_state_out), jnp.stack(ssd_conv_out),
            jnp.stack(ssd_state_out), jnp.stack(ffn_conv_out))


def setup_inputs(seed: int = 0) -> dict:
    key = jax.random.key(seed)
    ks = iter(jax.random.split(key, 64))

    def nrm(shape, scale):
        return jax.random.normal(next(ks), shape, jnp.float32) * scale

    def dt_bias(shape):
        dt = jnp.exp(jax.random.uniform(next(ks), shape, jnp.float32, math.log(1e-3), math.log(1e-1)))
        return dt + jnp.log(-jnp.expm1(-dt))

    def a_log(shape):
        return jnp.log(jax.random.uniform(next(ks), shape, jnp.float32, 1.0, 16.0))

    return {
        "x_prompt": nrm((BATCH, SEQ, D_MODEL), 1.0),
        "x_sample": nrm((DEC_BATCH, DEC_SEQ, D_MODEL), 1.0),
        "cache_gdn_conv": nrm((N_GDN, DEC_BATCH, CONV_W - 1, GDN_CONV_DIM), 1.0),
        "state_gdn": nrm((N_GDN, DEC_BATCH, GDN_HEADS, GDN_DK, GDN_DV), 0.5),
        "cache_ssd_conv": nrm((N_SSD, DEC_BATCH, CONV_W - 1, SSD_CONV_DIM), 1.0),
        "state_ssd": nrm((N_SSD, DEC_BATCH, SSD_HEADS, SSD_HEADDIM, SSD_STATE), 0.1),
        "cache_ffn_conv": nrm((DEPTH, DEC_BATCH, FFN_CONV_W - 1, D_FF), 1.0),
        "gdn_w_in": nrm((N_GDN, D_MODEL, GDN_IN), D_MODEL ** -0.5),
        "gdn_conv_w": nrm((N_GDN, CONV_W, GDN_CONV_DIM), CONV_W ** -0.5),
        "gdn_conv_b": nrm((N_GDN, GDN_CONV_DIM), 0.02),
        "gdn_a_log": a_log((N_GDN, GDN_HEADS)),
        "gdn_dt_bias": dt_bias((N_GDN, GDN_HEADS)),
        "gdn_norm_w": 1.0 + nrm((N_GDN, GDN_DV), 0.02),
        "gdn_w_out": nrm((N_GDN, GDN_VD, D_MODEL), DN_BETA * GDN_VD ** -0.5),
        "ssd_w_in": nrm((N_SSD, D_MODEL, SSD_IN), D_MODEL ** -0.5),
        "ssd_conv_w": nrm((N_SSD, CONV_W, SSD_CONV_DIM), CONV_W ** -0.5),
        "ssd_conv_b": nrm((N_SSD, SSD_CONV_DIM), 0.02),
        "ssd_a_log": a_log((N_SSD, SSD_HEADS)),
        "ssd_dt_bias": dt_bias((N_SSD, SSD_HEADS)),
        "ssd_d": 1.0 + nrm((N_SSD, SSD_HEADS), 0.02),
        "ssd_norm_w": 1.0 + nrm((N_SSD, SSD_INNER), 0.02),
        "ssd_w_out": nrm((N_SSD, SSD_INNER, D_MODEL), DN_BETA * SSD_INNER ** -0.5),
        "ffn_w_up": nrm((DEPTH, D_MODEL, 2 * D_FF), D_MODEL ** -0.5),
        "ffn_conv_w": nrm((DEPTH, FFN_CONV_W, D_FF), FFN_CONV_W ** -0.5),
        "ffn_conv_b": nrm((DEPTH, D_FF), 0.02),
        "ffn_w_down": nrm((DEPTH, D_FF, D_MODEL), DN_BETA * D_FF ** -0.5),
        "ln1_g": 1.0 + nrm((DEPTH, D_MODEL), 0.02),
        "ln1_b": nrm((DEPTH, D_MODEL), 0.02),
        "ln2_g": 1.0 + nrm((DEPTH, D_MODEL), 0.02),
        "ln2_b": nrm((DEPTH, D_MODEL), 0.02),
    }


def reference(x_prompt, x_sample, cache_gdn_conv, state_gdn, cache_ssd_conv, state_ssd, cache_ffn_conv,
              gdn_w_in, gdn_conv_w, gdn_conv_b, gdn_a_log, gdn_dt_bias, gdn_norm_w, gdn_w_out,
              ssd_w_in, ssd_conv_w, ssd_conv_b, ssd_a_log, ssd_dt_bias, ssd_d, ssd_norm_w, ssd_w_out,
              ffn_w_up, ffn_conv_w, ffn_conv_b, ffn_w_down, ln1_g, ln1_b, ln2_g, ln2_b):
    weights = (gdn_w_in, gdn_conv_w, gdn_conv_b, gdn_a_log, gdn_dt_bias, gdn_norm_w, gdn_w_out,
               ssd_w_in, ssd_conv_w, ssd_conv_b, ssd_a_log, ssd_dt_bias, ssd_d, ssd_norm_w, ssd_w_out,
               ffn_w_up, ffn_conv_w, ffn_conv_b, ffn_w_down, ln1_g, ln1_b, ln2_g, ln2_b)
    bp = x_prompt.shape[0]
    z_gdn_conv = jnp.zeros((cache_gdn_conv.shape[0], bp) + cache_gdn_conv.shape[2:], cache_gdn_conv.dtype)
    z_gdn_state = jnp.zeros((state_gdn.shape[0], bp) + state_gdn.shape[2:], state_gdn.dtype)
    z_ssd_conv = jnp.zeros((cache_ssd_conv.shape[0], bp) + cache_ssd_conv.shape[2:], cache_ssd_conv.dtype)
    z_ssd_state = jnp.zeros((state_ssd.shape[0], bp) + state_ssd.shape[2:], state_ssd.dtype)
    z_ffn_conv = jnp.zeros((cache_ffn_conv.shape[0], bp) + cache_ffn_conv.shape[2:], cache_ffn_conv.dtype)
    y_p, gcp, gsp, scp, ssp, fcp = _trunk(x_prompt, z_gdn_conv, z_gdn_state, z_ssd_conv, z_ssd_state,
                                          z_ffn_conv, weights)
    y_s, gcs, gss, scs, sss, fcs = _trunk(x_sample, cache_gdn_conv, state_gdn, cache_ssd_conv, state_ssd,
                                          cache_ffn_conv, weights)
    return (y_p, y_s, gcp, gcs, gsp, gss, scp, scs, ssp, sss, fcp, fcs)
```

```cpp
#include <hip/hip_runtime.h>
#include <hip/hip_cooperative_groups.h>
#include <cstdio>
namespace cg = cooperative_groups;

#ifndef ONE_LAUNCH
#define ONE_LAUNCH 1
#endif

#define LAS __attribute__((address_space(3)))
typedef unsigned short bf16_t;
typedef short bf16x8 __attribute__((ext_vector_type(8)));
typedef float f32x4 __attribute__((ext_vector_type(4)));
typedef float f32x2 __attribute__((ext_vector_type(2)));
typedef unsigned u32x4 __attribute__((ext_vector_type(4)));
typedef unsigned u32x2 __attribute__((ext_vector_type(2)));

constexpr int D = 1024, BP = 8, SL = 2048, MP = BP * SL, DB = 128;
constexpr int GH = 8, GIN = 4112, GINP = 4352;
constexpr int SIN = 5152, SINP = 5376, SINNER = 2048, SHEADS = 32;
constexpr int DFF = 2816, NUP = 5632;
constexpr float DN_ALPHA = 1.4142135623730951f;
constexpr float LN_EPS = 1e-5f, RMS_EPS = 1e-6f;

constexpr size_t MB = 1u << 20;
constexpr size_t WS_WGI = 0, WS_WGO = 17 * MB / 2, WS_WSI = 21 * MB / 2, WS_WSO = 21 * MB, WS_WUP0 = 25 * MB, WS_WUP1 = 36 * MB,
                 WS_WDN0 = 47 * MB, WS_WDN1 = 105 * MB / 2, WS_XB = 58 * MB, WS_XF = 90 * MB, WS_PROJ = 154 * MB, WS_H = 330 * MB,
                 WS_YB = 394 * MB, WS_BA = 482 * MB, WS_DEC = 484 * MB;
constexpr size_t WS_XBD = WS_DEC, WS_XFD = WS_XBD + 256 * 1024, WS_PROJD = WS_XFD + 512 * 1024, WS_BAD = WS_PROJD + 1441792,
                 WS_HD = WS_BAD + 16384, WS_YBD = WS_HD + 512 * 1024, WS_EGL = WS_YBD + 720896, WS_BARR = WS_EGL + 8192, WS_END = WS_BARR + 16384;
constexpr size_t WS_UT = WS_YB, WS_WN = WS_YB + 32 * MB, WS_QK = WS_YB + 64 * MB, WS_QD = WS_PROJ + 128 * MB, WS_KDT = WS_XF;
constexpr size_t WS_O = WS_H, WS_XA = WS_H, WS_BCA = WS_XF;

constexpr size_t O_YP = 0, O_YS = 16777216, O_GCP = 16908288, O_GCS = 16982016, O_GSP = 18161664, O_GSS = 19210240, O_SCP = 35987456,
                 O_SCS = 36061184, O_SSP = 37240832, O_SSS = 39337984, O_FCP = 72892416, O_FCS = 72982528;

constexpr int LDS_BYTES = 131072 + 2048;

__device__ __forceinline__ int make_tid(int wave_s) { unsigned ones = ~0u; asm volatile("" : "+s"(ones)); int t = wave_s * 64 + (int)__builtin_amdgcn_mbcnt_hi(ones, __builtin_amdgcn_mbcnt_lo(ones, 0u)); asm volatile("" : "+v"(t)); return t; }
__device__ __forceinline__ float bf2f(unsigned b) { return __uint_as_float(b << 16); }
typedef __bf16 bf16x2_t __attribute__((ext_vector_type(2)));
__device__ __forceinline__ unsigned pack2(float lo, float hi) { const f32x2 v = {lo, hi}; const bf16x2_t b = __builtin_convertvector(v, bf16x2_t); return __builtin_bit_cast(unsigned, b); }
__device__ __forceinline__ float lo_f(unsigned w) { return __uint_as_float(w << 16); }
__device__ __forceinline__ float hi_f(unsigned w) { return __uint_as_float(w & 0xffff0000u); }
__device__ __forceinline__ float silu_f(float x) { return x * __builtin_amdgcn_rcpf(1.f + __expf(-x)); }
__device__ __forceinline__ float sigmoid_f(float x) { return __builtin_amdgcn_rcpf(1.f + __expf(-x)); }
__device__ __forceinline__ float softplus_f(float x) { return x > 20.f ? x : log1pf(__expf(x)); }
#define DPP_F(x, ctrl, rmask) __builtin_bit_cast(float, __builtin_amdgcn_update_dpp(0, __builtin_bit_cast(int, (x)), (ctrl), (rmask), 0xf, false))
__device__ __forceinline__ float wave_sum(float v) {
    v += DPP_F(v, 0xB1, 0xf);
    v += DPP_F(v, 0x4E, 0xf);
    v += DPP_F(v, 0x141, 0xf);
    v += DPP_F(v, 0x140, 0xf);
    v += DPP_F(v, 0x142, 0xa);
    v += DPP_F(v, 0x143, 0xc);
    return __builtin_bit_cast(float, __builtin_amdgcn_readlane(__builtin_bit_cast(int, v), 63));
}
__device__ __forceinline__ float wave_incl_scan(float v, int lane) {
#pragma unroll
    for (int o = 1; o < 64; o <<= 1) { float t = __shfl_up(v, o); if (lane >= o) v += t; }
    return v;
}
__device__ __forceinline__ f32x4 mfma16(bf16x8 a, bf16x8 b, f32x4 c) { return __builtin_amdgcn_mfma_f32_16x16x32_bf16(a, b, c, 0, 0, 0); }
__device__ __forceinline__ void lds_barrier() { asm volatile("s_waitcnt lgkmcnt(0)" ::: "memory"); __builtin_amdgcn_s_barrier(); asm volatile("" ::: "memory"); }
__device__ __forceinline__ u32x2 pack4(f32x4 v) { u32x2 r; r.x = pack2(v[0], v[1]); r.y = pack2(v[2], v[3]); return r; }

namespace pg8 {
constexpr int BM = 256, BK = 64, HALF = 128, HTB = HALF * BK * 2, STAGE_BYTES = 8 * HTB, NXCD = 8, WGM = 8;
__device__ __forceinline__ int lds_byte(int r, int c) { const int st = (r >> 4) * 2 + (c >> 5), rr = r & 15, cc = c & 31, ob = rr * 64 + cc * 2; return st * 1024 + (ob ^ (((ob >> 9) & 1) << 5)); }
__device__ __forceinline__ void stage_rc(int b, int& R, int& C) { const int st = b / 1024, sb = b % 1024, swz = sb ^ (((sb >> 9) & 1) << 5); R = (st >> 1) * 16 + swz / 64; C = (st & 1) * 32 + (swz % 64) / 2; }
__device__ __forceinline__ int perm32(int rho) { const int n = rho >> 4, i = rho & 15; return 8 * (i >> 2) + 4 * n + (i & 3); }
struct Unit { int pm, pn; };
struct Gemm { const bf16_t* A; const bf16_t* Bt; int M, N, K; };
struct StaticOrder {
    int nM, nN, nwg, G, c;
    __device__ void init(int M, int N, int G_, int c_) { nM = M / BM; nN = N / BM; nwg = nM * nN; G = G_; c = c_; }
    __device__ bool next(int i, Unit& u) const {
        const long L = (long)i * G + c; if (L >= nwg) return false;
        int wgid = (int)L; { const int q = nwg / NXCD, r = nwg % NXCD, xcd = wgid % NXCD, off = wgid / NXCD; wgid = (xcd < r ? xcd * (q + 1) : r * (q + 1) + (xcd - r) * q) + off; }
        const int nig = WGM * nN, gid = wgid / nig, fm = gid * WGM, gsz = (nM - fm) < WGM ? (nM - fm) : WGM;
        u.pm = fm + ((wgid % nig) % gsz); u.pn = (wgid % nig) / gsz; return true;
    }
};
struct EpiF32 {
    static constexpr bool PERM = false;
    float* C; int ldc;
    __device__ __forceinline__ void operator()(const f32x4 (&acc)[2][2][4][2], const Unit& u, int wr, int wc, int fr, int fq) const {
        const int row0 = u.pm * BM + wr * 64 + fr, col0 = u.pn * BM + wc * 32 + 4 * fq;
#pragma unroll
        for (int ai = 0; ai < 2; ++ai)
#pragma unroll
            for (int m = 0; m < 4; ++m) { float* rowp = C + (size_t)(row0 + ai * HALF + m * 16) * ldc + col0;
#pragma unroll
                for (int bj = 0; bj < 2; ++bj)
#pragma unroll
                    for (int n = 0; n < 2; ++n) *(f32x4*)(rowp + bj * HALF + n * 16) = acc[ai][bj][m][n]; }
    }
};
struct EpiBf16 {
    static constexpr bool PERM = true;
    bf16_t* O; int ldo;
    __device__ __forceinline__ void operator()(const f32x4 (&acc)[2][2][4][2], const Unit& u, int wr, int wc, int fr, int fq) const {
        const int row0 = u.pm * BM + wr * 64 + fr, col0 = u.pn * BM + wc * 32 + 8 * fq;
#pragma unroll
        for (int ai = 0; ai < 2; ++ai)
#pragma unroll
            for (int m = 0; m < 4; ++m) { bf16_t* rowp = O + (size_t)(row0 + ai * HALF + m * 16) * ldo + col0;
#pragma unroll
                for (int bj = 0; bj < 2; ++bj) { const f32x4 v0 = acc[ai][bj][m][0], v1 = acc[ai][bj][m][1];
                    u32x4 w; w.x = pack2(v0[0], v0[1]); w.y = pack2(v0[2], v0[3]); w.z = pack2(v1[0], v1[1]); w.w = pack2(v1[2], v1[3]);
                    *(u32x4*)(rowp + bj * HALF) = w; } }
    }
};
__device__ __forceinline__ float dpp_ror1(float x) { return __builtin_bit_cast(float, __builtin_amdgcn_update_dpp(0, __builtin_bit_cast(int, x), 0x121, 0xf, 0xf, false)); }
__device__ __forceinline__ float dpp_ror2(float x) { return __builtin_bit_cast(float, __builtin_amdgcn_update_dpp(0, __builtin_bit_cast(int, x), 0x122, 0xf, 0xf, false)); }
struct EpiGate {
    bf16_t* HB; const float* cw; const float* cb; float* edge; float* first; float* cache;
    __device__ __forceinline__ void operator()(const f32x4 (&acc)[2][2][4][2], const Unit& u, int wr, int wc, int fr_, int fq_) const {
        int fr = fr_, fq = fq_; asm volatile("" : "+v"(fr), "+v"(fq));
#pragma unroll
        for (int n = 0; n < 2; ++n) {
            const int ch = u.pn * 128 + wc * 32 + 8 * fq + 4 * n;
            const f32x4 w0 = *(const f32x4*)(cw + ch), w1 = *(const f32x4*)(cw + DFF + ch), w2 = *(const f32x4*)(cw + 2 * DFF + ch), bb = *(const f32x4*)(cb + ch);
#pragma unroll
            for (int ai = 0; ai < 2; ++ai) {
                const int strip = u.pm * 4 + ai * 2 + wr;
                f32x4 pr1 = (f32x4){0.f, 0.f, 0.f, 0.f}, pr2 = pr1;
#pragma unroll
                for (int m = 0; m < 4; ++m) {
                    const f32x4 g = acc[ai][0][m][n], v = acc[ai][1][m][n];
                    f32x4 c1, c2;
#pragma unroll
                    for (int j = 0; j < 4; ++j) { c1[j] = dpp_ror1(g[j]); c2[j] = dpp_ror2(g[j]); }
                    const f32x4 p1 = (m == 0 || fr >= 1) ? c1 : pr1;
                    const f32x4 p2 = (m == 0 || fr >= 2) ? c2 : pr2;
                    pr1 = c1; pr2 = c2;
                    const size_t row = (size_t)u.pm * 256 + ai * 128 + wr * 64 + m * 16 + fr;
                    if (m == 0 && fr < 2) {
                        const f32x4 pa = (fr == 0) ? (bb + w2 * g) : (bb + w1 * p1 + w2 * g);
                        float* fp = first + ((size_t)strip * 2 + fr) * (2 * DFF) + ch;
                        *(f32x4*)fp = pa; *(f32x4*)(fp + DFF) = v;
                    } else {
                        const f32x4 y = bb + w0 * p2 + w1 * p1 + w2 * g; f32x4 o;
#pragma unroll
                        for (int j = 0; j < 4; ++j) o[j] = silu_f(y[j]) * v[j];
                        *(u32x2*)(HB + row * DFF + ch) = pack4(o);
                    }
                    if (m == 3 && fr >= 14) {
                        *(f32x4*)(edge + ((size_t)strip * 2 + (fr - 14)) * DFF + ch) = g;
                        if ((strip & 31) == 31) *(f32x4*)(cache + ((size_t)(strip >> 5) * 2 + (fr - 14)) * DFF + ch) = g;
                    }
                }
            }
        }
    }
};
struct EpiUni {
    int mode; bf16_t* O; int ldo; const float* cw; const float* cb; float* aux; float* cache;
    __device__ __forceinline__ void operator()(const f32x4 (&acc)[2][2][4][2], const Unit& u, int wr, int wc, int fr_, int fq_) const {
        (void)fr_; (void)fq_;
        unsigned ones = ~0u; asm volatile("" : "+s"(ones));
        const int lane_e = (int)__builtin_amdgcn_mbcnt_hi(ones, __builtin_amdgcn_mbcnt_lo(ones, 0u)), fr = lane_e & 15, fq = lane_e >> 4;
        if (mode == 2) { EpiGate e{O, cw, cb, aux, aux + (size_t)256 * 2 * DFF, cache}; e(acc, u, wr, wc, fr, fq); }
        else { EpiBf16 e{O, ldo}; e(acc, u, wr, wc, fr, fq); }
    }
};

template <class Epi, class Sched>
__device__ __forceinline__ void gemm_phase(LAS unsigned char* lds, const Gemm g, const Sched& S, const Epi& E, int tid_in) {
    const int tid = tid_in, wid = __builtin_amdgcn_readfirstlane(tid >> 6), lane = tid & 63, wr = wid >> 2, wc = wid & 3, fr = lane & 15, fq = lane >> 4;
    const int K = g.K, nt = K / BK;
    unsigned voffA[2], voffB[2];
#pragma unroll
    for (int i = 0; i < 2; ++i) { int R, C; stage_rc(tid * 16 + i * 8192, R, C); const int Rb = (E.mode != 0) ? ((R & ~31) + perm32(R & 31)) : R;
        voffA[i] = (unsigned)(R * K + C) * 2u; voffB[i] = (unsigned)(Rb * K + C) * 2u; }
    const size_t kstep = (size_t)(BK * 2);
    const size_t hstep = (size_t)HALF * K * 2;
    const size_t tstep = 2 * hstep;
    const unsigned ldsw = (unsigned)wid * 1024u;
    const int aoff = lds_byte(wr * 64 + fr, fq * 8), boff = lds_byte(wc * 32 + fr, fq * 8);
#define PG8_SA(b, h) (((b) * 2 + (h)) * HTB)
#define PG8_SB(b, h) ((4 + (b) * 2 + (h)) * HTB)
#define PG8_STAGE(bufoff, gbase, voff) do { _Pragma("unroll") for (int _i = 0; _i < 2; ++_i) \
        __builtin_amdgcn_global_load_lds((const unsigned*)((const char*)(gbase) + (voff)[_i]), (LAS unsigned*)(lds + (bufoff) + ldsw + _i * 8192), 16, 0, 0); } while (0)
#define PG8_LDA(dst, b, h) do { _Pragma("unroll") for (int m = 0; m < 4; ++m) _Pragma("unroll") for (int k = 0; k < 2; ++k) dst[m][k] = *(const LAS bf16x8*)(lds + PG8_SA(b, h) + aoff + m * 2048 + k * 1024); } while (0)
#define PG8_LDB(dst, b, h) do { _Pragma("unroll") for (int n = 0; n < 2; ++n) _Pragma("unroll") for (int k = 0; k < 2; ++k) dst[n][k] = *(const LAS bf16x8*)(lds + PG8_SB(b, h) + boff + n * 2048 + k * 1024); } while (0)
#define PG8_MMA(ai, bj, At, Bt) do { __builtin_amdgcn_s_setprio(1); _Pragma("unroll") for (int m = 0; m < 4; ++m) _Pragma("unroll") for (int n = 0; n < 2; ++n) _Pragma("unroll") for (int k = 0; k < 2; ++k) \
        acc[ai][bj][m][n] = __builtin_amdgcn_mfma_f32_16x16x32_bf16(Bt[n][k], At[m][k], acc[ai][bj][m][n], 0, 0, 0); __builtin_amdgcn_s_setprio(0); } while (0)
#define PG8_WAIT_V(n) asm volatile("s_waitcnt vmcnt(" #n ")" ::: "memory")
#define PG8_WAIT_L(n) asm volatile("s_waitcnt lgkmcnt(" #n ")" ::: "memory")
#define PG8_BAR __builtin_amdgcn_s_barrier()
#define PG8_SCHED __builtin_amdgcn_sched_barrier(0)
    Unit cur, nxt; int ui = 0;
    if (!S.next(0, cur)) return;
    f32x4 acc[2][2][4][2];
#pragma unroll
    for (int a = 0; a < 2; ++a)
#pragma unroll
        for (int b = 0; b < 2; ++b)
#pragma unroll
            for (int m = 0; m < 4; ++m)
#pragma unroll
                for (int n = 0; n < 2; ++n) acc[a][b][m][n] = (f32x4){0.f, 0.f, 0.f, 0.f};
    bf16x8 At[4][2], B0[2][2], B1[2][2];
    const char* cA = (const char*)g.A + (size_t)cur.pm * tstep; const char* cB = (const char*)g.Bt + (size_t)cur.pn * tstep;
    PG8_STAGE(PG8_SB(0, 0), cB, voffB); PG8_STAGE(PG8_SA(0, 0), cA, voffA); PG8_STAGE(PG8_SB(0, 1), cB + hstep, voffB); PG8_STAGE(PG8_SA(0, 1), cA + hstep, voffA);
    if (wr == 1) PG8_BAR;
    PG8_WAIT_V(4); PG8_BAR;
    PG8_STAGE(PG8_SB(1, 0), cB + kstep, voffB); PG8_STAGE(PG8_SA(1, 0), cA + kstep, voffA); PG8_STAGE(PG8_SB(1, 1), cB + hstep + kstep, voffB);
    PG8_WAIT_V(6); PG8_BAR;
    for (;;) {
        const bool has_next = S.next(ui + 1, nxt);
        const char* nA = has_next ? (const char*)g.A + (size_t)nxt.pm * tstep : cA; const char* nB = has_next ? (const char*)g.Bt + (size_t)nxt.pn * tstep : cB;
        for (int t = 0; t < nt; t += 2) {
            const bool last = (t == nt - 2);
            const char* a1 = cA + (size_t)(t + 1) * kstep;
            const char* a2 = last ? nA : cA + (size_t)(t + 2) * kstep; const char* b2 = last ? nB : cB + (size_t)(t + 2) * kstep;
            const char* a3 = a2 + kstep; const char* b3 = b2 + kstep;
            PG8_LDB(B0, 0, 0); PG8_SCHED; PG8_LDA(At, 0, 0); PG8_STAGE(PG8_SA(1, 1), a1 + hstep, voffA);
            PG8_WAIT_L(8); PG8_BAR; PG8_WAIT_L(0); PG8_MMA(0, 0, At, B0); PG8_BAR; PG8_SCHED;
            PG8_LDB(B1, 0, 1); PG8_STAGE(PG8_SB(0, 0), b2, voffB);
            PG8_BAR; PG8_WAIT_L(0); PG8_MMA(0, 1, At, B1); PG8_BAR;
            PG8_LDA(At, 0, 1); PG8_STAGE(PG8_SA(0, 0), a2, voffA);
            PG8_BAR; PG8_WAIT_L(0); PG8_MMA(1, 0, At, B0); PG8_BAR; PG8_SCHED;
            PG8_STAGE(PG8_SB(0, 1), b2 + hstep, voffB);
            PG8_WAIT_V(6); PG8_BAR; PG8_MMA(1, 1, At, B1); PG8_BAR;
            PG8_LDB(B0, 1, 0); PG8_SCHED; PG8_LDA(At, 1, 0); PG8_STAGE(PG8_SA(0, 1), a2 + hstep, voffA);
            PG8_WAIT_L(8); PG8_BAR; PG8_WAIT_L(0); PG8_MMA(0, 0, At, B0); PG8_BAR; PG8_SCHED;
            PG8_LDB(B1, 1, 1); PG8_STAGE(PG8_SB(1, 0), b3, voffB);
            PG8_BAR; PG8_WAIT_L(0); PG8_MMA(0, 1, At, B1); PG8_BAR;
            PG8_LDA(At, 1, 1); PG8_STAGE(PG8_SA(1, 0), a3, voffA);
            PG8_BAR; PG8_WAIT_L(0); PG8_MMA(1, 0, At, B0); PG8_BAR; PG8_SCHED;
            PG8_STAGE(PG8_SB(1, 1), b3 + hstep, voffB);
            PG8_WAIT_V(6); PG8_BAR; PG8_MMA(1, 1, At, B1); PG8_BAR;
        }
        E(acc, cur, wr, wc, fr, fq);
        if (!has_next) break;
#pragma unroll
        for (int a = 0; a < 2; ++a)
#pragma unroll
            for (int b = 0; b < 2; ++b)
#pragma unroll
                for (int m = 0; m < 4; ++m)
#pragma unroll
                    for (int n = 0; n < 2; ++n) acc[a][b][m][n] = (f32x4){0.f, 0.f, 0.f, 0.f};
        cur = nxt; cA = nA; cB = nB; ++ui;
    }
    PG8_WAIT_V(0);
    if (wr == 0) PG8_BAR;
    PG8_BAR;
#undef PG8_SA
#undef PG8_SB
#undef PG8_STAGE
#undef PG8_LDA
#undef PG8_LDB
#undef PG8_MMA
#undef PG8_WAIT_V
#undef PG8_WAIT_L
#undef PG8_BAR
#undef PG8_SCHED
}
}

struct Args {
    const float* in[30];
    float* out;
    unsigned char* ws;
    int ph_lo, ph_hi;
};

struct DecStore {
    int ldp, nbf, nf; bf16_t* Pd; float* BAd;
    __device__ __forceinline__ void operator()(int row, int col, float v0, float v1) const {
        if (col < nbf) { *(unsigned*)(Pd + (size_t)row * ldp + col) = pack2(v0, v1); }
        else if (col < nbf + nf) { BAd[row * 32 + col - nbf] = v0; BAd[row * 32 + col - nbf + 1] = v1; }
    }
};
__device__ __forceinline__ void small_gemm_item(LAS unsigned char* lds, const bf16_t* __restrict__ A, int lda, const bf16_t* __restrict__ Bt, int K, int item, const DecStore& st, int tid_in) {
    const int tid = tid_in, wid = tid >> 6, lane = tid & 63, fr = lane & 15, fq = lane >> 4;
    const int rg = item & 7, cgp = item >> 3;
    const int kw = K >> 3;
    const bf16_t* ap = A + (size_t)(rg * 16 + fr) * lda + wid * kw + fq * 8;
    const bf16_t* bp = Bt + (size_t)(cgp * 64 + fr) * K + wid * kw + fq * 8;
    f32x4 acc[4];
#pragma unroll
    for (int n = 0; n < 4; ++n) acc[n] = (f32x4){0.f, 0.f, 0.f, 0.f};
    int k0 = 0;
    for (; k0 + 128 <= kw; k0 += 128) {
        bf16x8 a[4], bq[4][4];
#pragma unroll
        for (int q = 0; q < 4; ++q) { a[q] = *(const bf16x8*)(ap + k0 + 32 * q);
#pragma unroll
            for (int n = 0; n < 4; ++n) bq[q][n] = *(const bf16x8*)(bp + (size_t)n * 16 * K + k0 + 32 * q); }
#pragma unroll
        for (int q = 0; q < 4; ++q)
#pragma unroll
            for (int n = 0; n < 4; ++n) acc[n] = mfma16(a[q], bq[q][n], acc[n]);
    }
    for (; k0 < kw; k0 += 32) {
        const bf16x8 a = *(const bf16x8*)(ap + k0);
#pragma unroll
        for (int n = 0; n < 4; ++n) { const bf16x8 b = *(const bf16x8*)(bp + (size_t)n * 16 * K + k0); acc[n] = mfma16(a, b, acc[n]); }
    }
    LAS float* red = (LAS float*)lds;
#pragma unroll
    for (int n = 0; n < 4; ++n)
#pragma unroll
        for (int r = 0; r < 4; ++r) red[wid * 1024 + (fq * 4 + r) * 64 + n * 16 + fr] = acc[n][r];
    __syncthreads();
    {
        const int row = tid >> 5, c2 = (tid & 31) * 2; float v0 = 0.f, v1 = 0.f;
#pragma unroll
        for (int w = 0; w < 8; ++w) { v0 += red[w * 1024 + row * 64 + c2]; v1 += red[w * 1024 + row * 64 + c2 + 1]; }
        st(rg * 16 + row, cgp * 64 + c2, v0, v1);
    }
    __syncthreads();
}

template <int NT>
__device__ __forceinline__ void narrow_item(const bf16_t* __restrict__ A, const bf16_t* __restrict__ Bt, int K, float* __restrict__ BAo, int item, int tid_in) {
    const int tid = tid_in, wid = tid >> 6, lane = tid & 63, fr = lane & 15, fq = lane >> 4;
    const int row0 = item * 128 + wid * 16;
    const bf16_t* ap = A + (size_t)(row0 + fr) * K + fq * 8;
    const bf16_t* bp = Bt + (size_t)fr * K + fq * 8;
    f32x4 acc[NT];
#pragma unroll
    for (int n = 0; n < NT; ++n) acc[n] = (f32x4){0.f, 0.f, 0.f, 0.f};
#pragma unroll 4
    for (int k = 0; k < K; k += 32) {
        const bf16x8 a = *(const bf16x8*)(ap + k);
#pragma unroll
        for (int n = 0; n < NT; ++n) { const bf16x8 bfr = *(const bf16x8*)(bp + (size_t)n * 16 * K + k); acc[n] = mfma16(bfr, a, acc[n]); }
    }
#pragma unroll
    for (int n = 0; n < NT; ++n) *(f32x4*)(BAo + (size_t)(row0 + fr) * 32 + n * 16 + fq * 4) = acc[n];
}

__device__ __forceinline__ void convert_rows16(const float* __restrict__ src, bf16_t* __restrict__ dst, int tid_in) {
#pragma unroll
    for (int i = 0; i < 8; ++i) { const int e = i * 512 + tid_in; const f32x4 v = __builtin_nontemporal_load((const f32x4*)src + e);
        u32x2 w; w.x = pack2(v[0], v[1]); w.y = pack2(v[2], v[3]); ((u32x2*)dst)[e] = w; }
}

__device__ __forceinline__ void unpack8(const u32x4 w, float (&f)[8]) {
    f[0] = lo_f(w.x); f[1] = hi_f(w.x); f[2] = lo_f(w.y); f[3] = hi_f(w.y); f[4] = lo_f(w.z); f[5] = hi_f(w.z); f[6] = lo_f(w.w); f[7] = hi_f(w.w);
}
__device__ __forceinline__ u32x4 pack8(const float (&f)[8]) { u32x4 w; w.x = pack2(f[0], f[1]); w.y = pack2(f[2], f[3]); w.z = pack2(f[4], f[5]); w.w = pack2(f[6], f[7]); return w; }
__device__ __forceinline__ void ln_row(const bf16_t* __restrict__ xres, const bf16_t* __restrict__ h, const float* __restrict__ gam, const float* __restrict__ bet,
                                       float* __restrict__ outF, bf16_t* __restrict__ outB, int lane) {
    float v[2][8]; float s = 0.f;
#pragma unroll
    for (int i = 0; i < 2; ++i) { float a[8], b[8]; unpack8(((const u32x4*)xres)[i * 64 + lane], a); unpack8(((const u32x4*)h)[i * 64 + lane], b);
#pragma unroll
        for (int j = 0; j < 8; ++j) { v[i][j] = a[j] * DN_ALPHA + b[j]; s += v[i][j]; } }
    const float mu = wave_sum(s) * (1.f / 1024.f); float q = 0.f;
#pragma unroll
    for (int i = 0; i < 2; ++i)
#pragma unroll
        for (int j = 0; j < 8; ++j) { v[i][j] -= mu; q += v[i][j] * v[i][j]; }
    const float rstd = __builtin_amdgcn_rsqf(wave_sum(q) * (1.f / 1024.f) + LN_EPS);
#pragma unroll
    for (int i = 0; i < 2; ++i) { float o[8];
#pragma unroll
        for (int hh = 0; hh < 2; ++hh) { const f32x4 g = ((const f32x4*)gam)[i * 128 + lane * 2 + hh], b = ((const f32x4*)bet)[i * 128 + lane * 2 + hh];
#pragma unroll
            for (int j = 0; j < 4; ++j) o[hh * 4 + j] = v[i][hh * 4 + j] * rstd * g[j] + b[j]; }
        if (outB) ((u32x4*)outB)[i * 64 + lane] = pack8(o);
        if (outF) { ((f32x4*)outF)[i * 128 + lane * 2] = (f32x4){o[0], o[1], o[2], o[3]}; ((f32x4*)outF)[i * 128 + lane * 2 + 1] = (f32x4){o[4], o[5], o[6], o[7]}; } }
}

__device__ __forceinline__ void ln_row2(const bf16_t* __restrict__ x0, const bf16_t* __restrict__ h0, const bf16_t* __restrict__ x1, const bf16_t* __restrict__ h1,
                                        const float* __restrict__ gam, const float* __restrict__ bet, float* oF0, bf16_t* oB0, float* oF1, bf16_t* oB1, int lane) {
    u32x4 xa[2][2], ha[2][2];
#pragma unroll
    for (int i = 0; i < 2; ++i) { xa[0][i] = ((const u32x4*)x0)[i * 64 + lane]; ha[0][i] = __builtin_nontemporal_load((const u32x4*)h0 + i * 64 + lane); xa[1][i] = ((const u32x4*)x1)[i * 64 + lane]; ha[1][i] = __builtin_nontemporal_load((const u32x4*)h1 + i * 64 + lane); }
#pragma unroll
    for (int rr = 0; rr < 2; ++rr) {
        float v[2][8]; float s = 0.f;
#pragma unroll
        for (int i = 0; i < 2; ++i) { float a[8], b[8]; unpack8(xa[rr][i], a); unpack8(ha[rr][i], b);
#pragma unroll
            for (int j = 0; j < 8; ++j) { v[i][j] = a[j] * DN_ALPHA + b[j]; s += v[i][j]; } }
        const float mu = wave_sum(s) * (1.f / 1024.f); float q = 0.f;
#pragma unroll
        for (int i = 0; i < 2; ++i)
#pragma unroll
            for (int j = 0; j < 8; ++j) { v[i][j] -= mu; q += v[i][j] * v[i][j]; }
        const float rstd = __builtin_amdgcn_rsqf(wave_sum(q) * (1.f / 1024.f) + LN_EPS);
        float* outF = rr ? oF1 : oF0; bf16_t* outB = rr ? oB1 : oB0;
#pragma unroll
        for (int i = 0; i < 2; ++i) { float o[8];
#pragma unroll
            for (int hh = 0; hh < 2; ++hh) { const f32x4 g = ((const f32x4*)gam)[i * 128 + lane * 2 + hh], b = ((const f32x4*)bet)[i * 128 + lane * 2 + hh];
#pragma unroll
                for (int j = 0; j < 4; ++j) o[hh * 4 + j] = v[i][hh * 4 + j] * rstd * g[j] + b[j]; }
            if (outB) ((u32x4*)outB)[i * 64 + lane] = pack8(o);
            if (outF) { __builtin_nontemporal_store((f32x4){o[0], o[1], o[2], o[3]}, (f32x4*)outF + i * 128 + lane * 2); __builtin_nontemporal_store((f32x4){o[4], o[5], o[6], o[7]}, (f32x4*)outF + i * 128 + lane * 2 + 1); } }
    }
}

__device__ __forceinline__ void ffn_fixup_item(const float* __restrict__ edge, const float* __restrict__ first, bf16_t* __restrict__ HB, const float* __restrict__ cw, int strip, int tid_in) {
    const int t = tid_in; if (t >= 352) return;
    const int c0 = t * 8;
    const bool has_hist = (strip & 31) != 0;
#pragma unroll
    for (int hh = 0; hh < 2; ++hh) {
        const int ch = c0 + 4 * hh;
        const f32x4 w0 = *(const f32x4*)(cw + ch), w1 = *(const f32x4*)(cw + DFF + ch);
        f32x4 e0 = (f32x4){0.f, 0.f, 0.f, 0.f}, e1 = e0;
        if (has_hist) { e0 = *(const f32x4*)(edge + ((size_t)(strip - 1) * 2 + 0) * DFF + ch); e1 = *(const f32x4*)(edge + ((size_t)(strip - 1) * 2 + 1) * DFF + ch); }
#pragma unroll
        for (int rr = 0; rr < 2; ++rr) {
            const float* fp = first + ((size_t)strip * 2 + rr) * (2 * DFF) + ch;
            const f32x4 pa = *(const f32x4*)fp, v = *(const f32x4*)(fp + DFF);
            const f32x4 y = (rr == 0) ? (pa + w0 * e0 + w1 * e1) : (pa + w0 * e1); f32x4 o;
#pragma unroll
            for (int j = 0; j < 4; ++j) o[j] = silu_f(y[j]) * v[j];
            *(u32x2*)(HB + ((size_t)strip * 64 + rr) * DFF + ch) = pack4(o);
        }
    }
}
__device__ __forceinline__ void ffn_gate_dec_item(const bf16_t* __restrict__ GVd, bf16_t* __restrict__ HBd, const float* __restrict__ cw, const float* __restrict__ cb,
                                                  const float* __restrict__ cache_in  , float* __restrict__ cache_out, int item, int tid_in) {
    const int t = tid_in; if (t >= 352) return;
    const int c0 = t * 8;
    float w0[8], w1[8], w2[8], bb[8];
#pragma unroll
    for (int j = 0; j < 8; ++j) { w0[j] = cw[c0 + j]; w1[j] = cw[DFF + c0 + j]; w2[j] = cw[2 * DFF + c0 + j]; bb[j] = cb[c0 + j]; }
    for (int r = 0; r < 16; ++r) {
        const int row = item * 16 + r;
        float gcur[8], vv[8], o[8];
        const int cp = 256 * (c0 >> 7) + (c0 & 127);
        unpack8(*(const u32x4*)(GVd + (size_t)row * NUP + cp), gcur); unpack8(*(const u32x4*)(GVd + (size_t)row * NUP + cp + 128), vv);
        const float* ci = cache_in + (size_t)row * 2 * DFF + c0; float* co = cache_out + (size_t)row * 2 * DFF + c0;
#pragma unroll
        for (int j = 0; j < 8; ++j) { const float c0v = ci[j], c1v = ci[DFF + j]; const float y = bb[j] + w0[j] * c0v + w1[j] * c1v + w2[j] * gcur[j]; o[j] = silu_f(y) * vv[j];
            co[j] = c1v; co[DFF + j] = gcur[j]; }
        *(u32x4*)(HBd + (size_t)row * DFF + c0) = pack8(o);
    }
}

constexpr int GA_QS = 0, GA_KS = 17408, GA_VBT = 34816, GA_KBGT = 53248, GA_MS = 71680, GA_TS = 89088, GA_GC = 98304, GA_BT = 98560, GA_TL = 99328, GA_PB = 115712;
__device__ __forceinline__ void gdn_a_phase(LAS unsigned char* lds, const Args& A, int bid, int G, int tid_in) {
    const bf16_t* PROJ = (const bf16_t*)(A.ws + WS_PROJ);
    const float* BA = (const float*)(A.ws + WS_BA);
    float* EGL = (float*)(A.ws + WS_EGL);
    LAS unsigned* Qs = (LAS unsigned*)(lds + GA_QS); LAS unsigned* Ks = (LAS unsigned*)(lds + GA_KS);
    LAS float* Ms = (LAS float*)(lds + GA_MS); LAS bf16_t* Ts = (LAS bf16_t*)(lds + GA_TS);
    LAS float* gc = (LAS float*)(lds + GA_GC); LAS float* bt = (LAS float*)(lds + GA_BT);
    LAS float* Tl = (LAS float*)(lds + GA_TL); LAS float* Pb = (LAS float*)(lds + GA_PB);
    unsigned xw[3][11]; float pbr = 0.f, par = 0.f;
#define GA_IDS int tid = tid_in; asm volatile("" : "+v"(tid)); const int wid = tid >> 6, lane = tid & 63, fr = lane & 15, fq = lane >> 4, i0 = wid * 8, c = 2 * lane; (void)fr; (void)fq;
#define GA_LOAD(it) { const int _n = (it) & 31, _h = ((it) >> 5) & 7, _b = (it) >> 8; \
        _Pragma("unroll") for (int seg = 0; seg < 3; ++seg) _Pragma("unroll") for (int r = 0; r < 11; ++r) { const int t = _n * 64 + i0 + r - 3; \
            xw[seg][r] = *(const unsigned*)(PROJ + ((size_t)_b * SL + (t < 0 ? 0 : t)) * 4096 + seg * 1024 + _h * 128 + c); } \
        if (wid == 0) { const size_t _rb = (size_t)_b * SL + _n * 64 + lane; pbr = BA[_rb * 32 + _h]; par = BA[_rb * 32 + 8 + _h]; } }
    if (bid < 2048) { GA_IDS GA_LOAD(bid) }
    for (int item = bid; item < 2048; item += G) {
        GA_IDS
        const int n = item & 31, h = (item >> 5) & 7, b = item >> 8, chunk = (b * 8 + h) * 32 + n;
        bf16_t* UT = (bf16_t*)(A.ws + WS_UT) + (size_t)chunk * 8192; bf16_t* WN = (bf16_t*)(A.ws + WS_WN) + (size_t)chunk * 8192;
        bf16_t* QD = (bf16_t*)(A.ws + WS_QD) + (size_t)chunk * 8192; bf16_t* KDT = (bf16_t*)(A.ws + WS_KDT) + (size_t)chunk * 8192;
        bf16_t* QK = (bf16_t*)(A.ws + WS_QK) + (size_t)chunk * 4096;
        if (wid == 0) {
            const float g = -__expf(A.in[10][h]) * softplus_f(par + A.in[11][h]);
            const float gcum = wave_incl_scan(g, lane);
            gc[lane] = gcum; bt[lane] = sigmoid_f(pbr);
            if (lane == 63) EGL[chunk] = __expf(gcum);
        }
        lds_barrier();
        {
            const float glast = gc[63];
#pragma unroll
            for (int seg = 0; seg < 3; ++seg) {
                const int col = seg * 1024 + h * 128 + c;
                float w0[4], w1[4];
#pragma unroll
                for (int k = 0; k < 4; ++k) { const f32x2 t = *(const f32x2*)(A.in[8] + k * 3072 + col); w0[k] = t.x; w1[k] = t.y; }
                const f32x2 bb = *(const f32x2*)(A.in[9] + col);
                float x0[11], x1[11];
#pragma unroll
                for (int r = 0; r < 11; ++r) { const bool okr = (n * 64 + i0 + r - 3) >= 0; x0[r] = okr ? lo_f(xw[seg][r]) : 0.f; x1[r] = okr ? hi_f(xw[seg][r]) : 0.f; }
                if (n == 31 && wid == 7) {
#pragma unroll
                    for (int rr = 0; rr < 3; ++rr) *(f32x2*)(A.out + O_GCP + ((size_t)b * 3 + rr) * 3072 + col) = (f32x2){x0[8 + rr], x1[8 + rr]};
                }
                float y0[8], y1[8];
#pragma unroll
                for (int r = 0; r < 8; ++r) {
                    y0[r] = silu_f(bb.x + w0[0] * x0[r] + w0[1] * x0[r + 1] + w0[2] * x0[r + 2] + w0[3] * x0[r + 3]);
                    y1[r] = silu_f(bb.y + w1[0] * x1[r] + w1[1] * x1[r + 1] + w1[2] * x1[r + 2] + w1[3] * x1[r + 3]);
                }
                if (seg < 2) {
#pragma unroll
                    for (int r = 0; r < 8; ++r) { const float ss = wave_sum(y0[r] * y0[r] + y1[r] * y1[r]); const float rn = __builtin_amdgcn_rsqf(ss + 1e-6f) * (seg == 0 ? 0.08838834764831845f : 1.f); y0[r] *= rn; y1[r] *= rn; }
                }
                if (seg == 0) {
#pragma unroll
                    for (int r = 0; r < 8; ++r) { const int i = i0 + r; Qs[i * 68 + lane] = pack2(y0[r], y1[r]); const float eg = __expf(gc[i]);
                        *(unsigned*)(QD + i * 128 + c) = pack2(y0[r] * eg, y1[r] * eg); }
                } else if (seg == 1) {
                    float a0[8], a1[8], d0[8], d1[8];
#pragma unroll
                    for (int r = 0; r < 8; ++r) { const int i = i0 + r; Ks[i * 68 + lane] = pack2(y0[r], y1[r]); const float gi = gc[i], s1 = bt[i] * __expf(gi), s2 = __expf(glast - gi);
                        a0[r] = y0[r] * s1; a1[r] = y1[r] * s1; d0[r] = y0[r] * s2; d1[r] = y1[r] * s2; }
                    *(LAS u32x4*)(lds + GA_KBGT + (c * 72 + i0) * 2) = pack8(a0); *(LAS u32x4*)(lds + GA_KBGT + ((c + 1) * 72 + i0) * 2) = pack8(a1);
                    *(u32x4*)(KDT + c * 64 + i0) = pack8(d0); *(u32x4*)(KDT + (c + 1) * 64 + i0) = pack8(d1);
                } else {
                    float a0[8], a1[8];
#pragma unroll
                    for (int r = 0; r < 8; ++r) { const float be = bt[i0 + r]; a0[r] = y0[r] * be; a1[r] = y1[r] * be; }
                    *(LAS u32x4*)(lds + GA_VBT + (c * 72 + i0) * 2) = pack8(a0); *(LAS u32x4*)(lds + GA_VBT + ((c + 1) * 72 + i0) * 2) = pack8(a1);
                }
                __builtin_amdgcn_sched_barrier(0);
            }
        }
        lds_barrier();
        if (item + G < 2048) { GA_LOAD(item + G) }
        {
            const int ti = wid >> 1;
#pragma unroll
            for (int tjj = 0; tjj < 2; ++tjj) {
                const int tj = (wid & 1) * 2 + tjj;
                f32x4 ak = (f32x4){0.f, 0.f, 0.f, 0.f}, aq = (f32x4){0.f, 0.f, 0.f, 0.f};
                if (tj <= ti) {
#pragma unroll
                    for (int kk = 0; kk < 4; ++kk) {
                        const bf16x8 bk = *(const LAS bf16x8*)(lds + GA_KS + ((tj * 16 + fr) * 136 + kk * 32 + fq * 8) * 2);
                        const bf16x8 fk = *(const LAS bf16x8*)(lds + GA_KS + ((ti * 16 + fr) * 136 + kk * 32 + fq * 8) * 2);
                        const bf16x8 fqv = *(const LAS bf16x8*)(lds + GA_QS + ((ti * 16 + fr) * 136 + kk * 32 + fq * 8) * 2);
                        ak = mfma16(fk, bk, ak); aq = mfma16(fqv, bk, aq);
                    }
                }
                const int j = tj * 16 + fr; const float gj = gc[j];
#pragma unroll
                for (int r = 0; r < 4; ++r) { const int i = ti * 16 + fq * 4 + r; const float gi = gc[i];
                    const float e = (i >= j) ? __expf(gi - gj) : 0.f;
                    if (tj <= ti) Ms[i * 68 + j] = (i > j) ? bt[i] * ak[r] * e : 0.f;
                    QK[i * 64 + j] = (bf16_t)(pack2(aq[r] * e, 0.f) & 0xffffu); }
            }
        }
        lds_barrier();
        for (int ib = 0; ib < 4; ++ib) {
            if (ib > 0) {
                float p0 = 0.f, p1 = 0.f;
                const int ra = ib * 16 + 2 * wid;
                for (int j = 0; j < ib * 16; j += 4) {
                    const float t0 = Tl[j * 64 + lane], t1 = Tl[(j + 1) * 64 + lane], t2 = Tl[(j + 2) * 64 + lane], t3 = Tl[(j + 3) * 64 + lane];
                    const f32x4 m0 = *(const LAS f32x4*)(Ms + ra * 68 + j), m1 = *(const LAS f32x4*)(Ms + (ra + 1) * 68 + j);
                    p0 += (m0[0] * t0 + m0[1] * t1) + (m0[2] * t2 + m0[3] * t3);
                    p1 += (m1[0] * t0 + m1[1] * t1) + (m1[2] * t2 + m1[3] * t3);
                }
                Pb[(2 * wid) * 64 + lane] = p0; Pb[(2 * wid + 1) * 64 + lane] = p1;
                lds_barrier();
            }
            if (wid == 0) {
                float Tr[16];
#pragma unroll
                for (int r = 0; r < 16; ++r) {
                    float a = (ib > 0) ? -Pb[r * 64 + lane] : 0.f;
#pragma unroll
                    for (int q = 0; q < r; q += 4) {
                        const f32x4 m = *(const LAS f32x4*)(Ms + (ib * 16 + r) * 68 + ib * 16 + q);
                        a -= m[0] * Tr[q];
                        if (q + 1 < r) a -= m[1] * Tr[q + 1];
                        if (q + 2 < r) a -= m[2] * Tr[q + 2];
                        if (q + 3 < r) a -= m[3] * Tr[q + 3];
                    }
                    Tr[r] = a + ((lane == ib * 16 + r) ? 1.f : 0.f);
                    Tl[(ib * 16 + r) * 64 + lane] = Tr[r];
                    Ts[(ib * 16 + r) * 72 + lane] = (bf16_t)(pack2(Tr[r], 0.f) & 0xffffu);
                }
            }
            lds_barrier();
        }
        {
            const int td = wid;
            bf16x8 bv[2], bk[2];
#pragma unroll
            for (int kk = 0; kk < 2; ++kk) { bv[kk] = *(const LAS bf16x8*)(lds + GA_VBT + ((td * 16 + fr) * 72 + kk * 32 + fq * 8) * 2);
                bk[kk] = *(const LAS bf16x8*)(lds + GA_KBGT + ((td * 16 + fr) * 72 + kk * 32 + fq * 8) * 2); }
#pragma unroll
            for (int ti = 0; ti < 4; ++ti) {
                f32x4 au = (f32x4){0.f, 0.f, 0.f, 0.f}, aw = (f32x4){0.f, 0.f, 0.f, 0.f};
#pragma unroll
                for (int kk = 0; kk < 2; ++kk) { const bf16x8 ft = *(const LAS bf16x8*)(lds + GA_TS + ((ti * 16 + fr) * 72 + kk * 32 + fq * 8) * 2);
                    au = mfma16(ft, bv[kk], au);
                    aw = mfma16(bk[kk], ft, aw); }
                *(u32x2*)(UT + (td * 16 + fr) * 64 + ti * 16 + fq * 4) = pack4(au);
                *(u32x2*)(WN + (ti * 16 + fr) * 128 + td * 16 + fq * 4) = pack4(-aw);
            }
        }
        lds_barrier();
    }
#undef GA_LOAD
#undef GA_IDS
}

__device__ __forceinline__ void gdn_dec_item(LAS unsigned char* lds, const Args& A, int item, int tid_in) {
    const int tid = tid_in, wid = tid >> 6, lane = tid & 63;
    const int h = item & 7, b = item >> 3;
    const bf16_t* Pd = (const bf16_t*)(A.ws + WS_PROJD) + (size_t)b * NUP; const float* BAd = (const float*)(A.ws + WS_BAD) + b * 32;
    bf16_t* YBd = (bf16_t*)(A.ws + WS_YBD) + (size_t)b * DFF;
    LAS float* qs = (LAS float*)lds; LAS float* ks = qs + 128; LAS float* vs = qs + 256; LAS float* sc = qs + 384;
    LAS float* part = qs + 512;
    LAS float* os = qs + 512 + 1024;
    if (tid < 384) {
        const int seg = tid >> 7, d = tid & 127, col = seg * 1024 + h * 128 + d;
        const float* cin = A.in[2] + (size_t)b * 3 * 3072 + col;
        const float c0 = cin[0], c1 = cin[3072], c2 = cin[6144], nw = bf2f(Pd[col]);
        const float* cw = A.in[8] + col;
        const float y = A.in[9][col] + cw[0] * c0 + cw[3072] * c1 + cw[6144] * c2 + cw[9216] * nw;
        qs[tid] = silu_f(y);
        float* co = A.out + O_GCS + (size_t)b * 3 * 3072 + col; co[0] = c1; co[3072] = c2; co[6144] = nw;
    }
    __syncthreads();
    if (wid < 3) {
        const float q0 = qs[lane], q1 = qs[lane + 64], k0 = ks[lane], k1 = ks[lane + 64];
        const float v = (wid == 0) ? (q0 * q0 + q1 * q1) : (wid == 1) ? (k0 * k0 + k1 * k1) : (q0 * k0 + q1 * k1);
        const float s = wave_sum(v); if (lane == 0) sc[wid] = s;
    }
    __syncthreads();
    const float rq = __builtin_amdgcn_rsqf(sc[0] + 1e-6f) * 0.08838834764831845f, rk = __builtin_amdgcn_rsqf(sc[1] + 1e-6f), qk = sc[2] * rq * rk;
    const float g = -__expf(A.in[10][h]) * softplus_f(BAd[8 + h] + A.in[11][h]), eg = __expf(g), beta = sigmoid_f(BAd[h]);
    const int v = tid & 127, kg = tid >> 7;
    const float* Sin = A.in[3] + ((size_t)(b * 8 + h) * 128 + kg * 32) * 128 + v;
    float S[32]; float pk = 0.f, pq = 0.f;
#pragma unroll
    for (int k = 0; k < 32; ++k) S[k] = __builtin_nontemporal_load(Sin + k * 128);
#pragma unroll
    for (int k = 0; k < 32; ++k) { pk += ks[kg * 32 + k] * S[k]; pq += qs[kg * 32 + k] * S[k]; }
    part[kg * 128 + v] = pk * rk; part[512 + kg * 128 + v] = pq * rq;
    __syncthreads();
    const float kS = (part[v] + part[128 + v]) + (part[256 + v] + part[384 + v]);
    const float qS = (part[512 + v] + part[640 + v]) + (part[768 + v] + part[896 + v]);
    const float vnew = beta * (vs[v] - eg * kS);
    const float o = eg * qS + qk * vnew;
    float* Sout = A.out + O_GSS + ((size_t)(b * 8 + h) * 128 + kg * 32) * 128 + v;
#pragma unroll
    for (int k = 0; k < 32; ++k) __builtin_nontemporal_store(eg * S[k] + (ks[kg * 32 + k] * rk) * vnew, Sout + k * 128);
    if (kg == 0) os[v] = o;
    __syncthreads();
    if (wid == 0) {
        const float o0 = os[lane], o1 = os[lane + 64];
        const float rstd = __builtin_amdgcn_rsqf(wave_sum(o0 * o0 + o1 * o1) * (1.f / 128.f) + RMS_EPS);
        const float z0 = bf2f(Pd[3072 + h * 128 + lane]), z1 = bf2f(Pd[3072 + h * 128 + lane + 64]);
        const float r0 = o0 * rstd * A.in[12][lane] * silu_f(z0), r1 = o1 * rstd * A.in[12][lane + 64] * silu_f(z1);
        YBd[h * 128 + lane] = (bf16_t)(pack2(r0, 0.f) & 0xffffu); YBd[h * 128 + lane + 64] = (bf16_t)(pack2(r1, 0.f) & 0xffffu);
    }
    __syncthreads();
}

constexpr int GS_SB0 = 0, GS_SB1 = 8704, GS_VN = 17408;
__device__ __forceinline__ void gdn_scan_item(LAS unsigned char* lds, const Args& A, int item, int tid_in) {
    const int tid = tid_in, wid = tid >> 6, lane = tid & 63, fr = lane & 15, fq = lane >> 4;
    const int xcd = item & 7, slot = item >> 3, pair = xcd * 8 + (slot >> 2);
    const int vs = slot & 3, h = pair & 7, b = pair >> 3;
    const int ti = wid >> 1, tv = wid & 1;
    const bf16_t* UTb = (const bf16_t*)(A.ws + WS_UT); const bf16_t* WNb = (const bf16_t*)(A.ws + WS_WN);
    const bf16_t* QDb = (const bf16_t*)(A.ws + WS_QD); const bf16_t* KDTb = (const bf16_t*)(A.ws + WS_KDT);
    const bf16_t* QKb = (const bf16_t*)(A.ws + WS_QK); const float* EGL = (const float*)(A.ws + WS_EGL);
    float* O = (float*)(A.ws + WS_O);
    for (int e = tid; e < 8704 / 4; e += 512) ((LAS unsigned*)(lds + GS_SB0))[e] = 0u;
    f32x4 sacc[2]; sacc[0] = (f32x4){0.f, 0.f, 0.f, 0.f}; sacc[1] = sacc[0];
    __syncthreads();
    const int chunk0 = (b * 8 + h) * 32;
    bf16x8 nfw0[4], nfqd0[4], nfqk0[2], nfkd0[2]; u32x2 nuu0; float ndecay0;
    bf16x8 nfw1[4], nfqd1[4], nfqk1[2], nfkd1[2]; u32x2 nuu1; float ndecay1;
#define GS_LOAD(S, ch) { const size_t _c = (size_t)(ch); \
        _Pragma("unroll") for (int kk = 0; kk < 4; ++kk) { nfw##S[kk] = *(const bf16x8*)(WNb + _c * 8192 + (ti * 16 + fr) * 128 + kk * 32 + fq * 8); nfqd##S[kk] = *(const bf16x8*)(QDb + _c * 8192 + (ti * 16 + fr) * 128 + kk * 32 + fq * 8); } \
        _Pragma("unroll") for (int kk = 0; kk < 2; ++kk) { nfqk##S[kk] = *(const bf16x8*)(QKb + _c * 4096 + (ti * 16 + fr) * 64 + kk * 32 + fq * 8); nfkd##S[kk] = *(const bf16x8*)(KDTb + _c * 8192 + (wid * 16 + fr) * 64 + kk * 32 + fq * 8); } \
        nuu##S = *(const u32x2*)(UTb + _c * 8192 + (vs * 32 + tv * 16 + fr) * 64 + ti * 16 + fq * 4); ndecay##S = EGL[_c]; }
#define GS_STEP(S, nn, SBC, SBN, DOLOAD) { \
        bf16x8 fw[4], fqd[4], fqk[2], fkd[2]; \
        _Pragma("unroll") for (int kk = 0; kk < 4; ++kk) { fw[kk] = nfw##S[kk]; fqd[kk] = nfqd##S[kk]; } \
        _Pragma("unroll") for (int kk = 0; kk < 2; ++kk) { fqk[kk] = nfqk##S[kk]; fkd[kk] = nfkd##S[kk]; } \
        const u32x2 uu = nuu##S; const float decay = ndecay##S; \
        if (DOLOAD) { GS_LOAD(S, chunk0 + (nn) + 2) } \
        f32x4 acc = (f32x4){lo_f(uu.x), hi_f(uu.x), lo_f(uu.y), hi_f(uu.y)}; \
        bf16x8 fs[4]; \
        _Pragma("unroll") for (int kk = 0; kk < 4; ++kk) { fs[kk] = *(const LAS bf16x8*)(lds + (SBC) + ((tv * 16 + fr) * 136 + kk * 32 + fq * 8) * 2); acc = mfma16(fw[kk], fs[kk], acc); } \
        *(LAS u32x2*)(lds + GS_VN + ((tv * 16 + fr) * 72 + ti * 16 + fq * 4) * 2) = pack4(acc); \
        lds_barrier(); \
        f32x4 ao = (f32x4){0.f, 0.f, 0.f, 0.f}; \
        _Pragma("unroll") for (int kk = 0; kk < 4; ++kk) ao = mfma16(fs[kk], fqd[kk], ao); \
        bf16x8 fv[2][2]; \
        _Pragma("unroll") for (int t2 = 0; t2 < 2; ++t2) _Pragma("unroll") for (int kk = 0; kk < 2; ++kk) fv[t2][kk] = *(const LAS bf16x8*)(lds + GS_VN + ((t2 * 16 + fr) * 72 + kk * 32 + fq * 8) * 2); \
        _Pragma("unroll") for (int kk = 0; kk < 2; ++kk) { const bf16x8 fvo = *(const LAS bf16x8*)(lds + GS_VN + ((tv * 16 + fr) * 72 + kk * 32 + fq * 8) * 2); ao = mfma16(fvo, fqk[kk], ao); } \
        *(f32x4*)(O + ((size_t)b * SL + (nn) * 64 + ti * 16 + fr) * 1024 + h * 128 + vs * 32 + tv * 16 + fq * 4) = ao; \
        _Pragma("unroll") for (int t2 = 0; t2 < 2; ++t2) { sacc[t2] = sacc[t2] * decay; \
            _Pragma("unroll") for (int kk = 0; kk < 2; ++kk) sacc[t2] = mfma16(fkd[kk], fv[t2][kk], sacc[t2]); \
            *(LAS u32x2*)(lds + (SBN) + ((t2 * 16 + fr) * 136 + wid * 16 + fq * 4) * 2) = pack4(sacc[t2]); } \
        lds_barrier(); }
    GS_LOAD(0, chunk0) GS_LOAD(1, chunk0 + 1)
    for (int n = 0; n < 32; n += 8) {
        __builtin_amdgcn_s_waitcnt(0x0F70);
        GS_STEP(0, n, GS_SB0, GS_SB1, 1) GS_STEP(1, n + 1, GS_SB1, GS_SB0, 1) GS_STEP(0, n + 2, GS_SB0, GS_SB1, 1) GS_STEP(1, n + 3, GS_SB1, GS_SB0, 1)
        GS_STEP(0, n + 4, GS_SB0, GS_SB1, 1) GS_STEP(1, n + 5, GS_SB1, GS_SB0, 1) GS_STEP(0, n + 6, GS_SB0, GS_SB1, (n + 8 < 32)) GS_STEP(1, n + 7, GS_SB1, GS_SB0, (n + 9 < 32))
    }
#undef GS_STEP
#undef GS_LOAD
    float* So = A.out + O_GSP + (size_t)(b * 8 + h) * 16384;
#pragma unroll
    for (int t2 = 0; t2 < 2; ++t2)
#pragma unroll
        for (int r = 0; r < 4; ++r) So[(wid * 16 + fq * 4 + r) * 128 + vs * 32 + t2 * 16 + fr] = sacc[t2][r];
    __syncthreads();
}

__device__ __forceinline__ void gdn_gate_row(const Args& A, size_t row, int lane) {
    const float* O = (const float*)(A.ws + WS_O) + row * 1024 + lane * 16;
    const bf16_t* Z = (const bf16_t*)(A.ws + WS_PROJ) + row * 4096 + 3072 + lane * 16;
    bf16_t* Y = (bf16_t*)(A.ws + WS_YB) + row * 1024 + lane * 16;
    const float* nw = A.in[12] + (lane & 7) * 16;
    float o[16]; float ss = 0.f;
#pragma unroll
    for (int i = 0; i < 4; ++i) { const f32x4 v = ((const f32x4*)O)[i]; o[4 * i] = v[0]; o[4 * i + 1] = v[1]; o[4 * i + 2] = v[2]; o[4 * i + 3] = v[3]; ss += (v[0] * v[0] + v[1] * v[1]) + (v[2] * v[2] + v[3] * v[3]); }
    ss += __shfl_xor(ss, 1); ss += __shfl_xor(ss, 2); ss += __shfl_xor(ss, 4);
    const float rstd = __builtin_amdgcn_rsqf(ss * (1.f / 128.f) + RMS_EPS);
    float z[16]; { float t[8]; unpack8(((const u32x4*)Z)[0], t);
#pragma unroll
        for (int j = 0; j < 8; ++j) z[j] = t[j];
        unpack8(((const u32x4*)Z)[1], t);
#pragma unroll
        for (int j = 0; j < 8; ++j) z[8 + j] = t[j]; }
    float r[8];
#pragma unroll
    for (int hh = 0; hh < 2; ++hh) {
#pragma unroll
        for (int j = 0; j < 8; ++j) r[j] = o[hh * 8 + j] * rstd * nw[hh * 8 + j] * silu_f(z[hh * 8 + j]);
        ((u32x4*)Y)[hh] = pack8(r);
    }
}

__device__ __forceinline__ void ssd_conv_item(const Args& A, int item, int tid_in) {
    const int t = tid_in; if (t >= 384) return;
    const int c0 = t * 8, r0 = item * 16, tb = r0 & (SL - 1), b = r0 >> 11;
    const bf16_t* P = (const bf16_t*)(A.ws + WS_PROJ);
    bf16_t* XA = (bf16_t*)(A.ws + WS_XA); bf16_t* BCA = (bf16_t*)(A.ws + WS_BCA);
    u32x4 xq[19];
#pragma unroll
    for (int r = 0; r < 19; ++r) xq[r] = (tb == 0 && r < 3) ? (u32x4){0u, 0u, 0u, 0u} : __builtin_nontemporal_load((const u32x4*)(P + (size_t)(r0 + r - 3) * 5120 + 2048 + c0));
    float w[4][8], bb[8];
#pragma unroll
    for (int j = 0; j < 8; ++j) { bb[j] = A.in[16][c0 + j];
#pragma unroll
        for (int k = 0; k < 4; ++k) w[k][j] = A.in[15][k * 3072 + c0 + j]; }
    float p3[8], p2[8], p1[8];
    unpack8(xq[0], p3); unpack8(xq[1], p2); unpack8(xq[2], p1);
#pragma unroll
    for (int r = 0; r < 16; ++r) {
        const size_t row = (size_t)(r0 + r);
        float cur[8], o[8];
        unpack8(xq[r + 3], cur);
#pragma unroll
        for (int j = 0; j < 8; ++j) o[j] = silu_f(bb[j] + w[0][j] * p3[j] + w[1][j] * p2[j] + w[2][j] * p1[j] + w[3][j] * cur[j]);
        if (c0 < 2048) *(u32x4*)(XA + row * 2048 + c0) = pack8(o); else *(u32x4*)(BCA + row * 1024 + (c0 - 2048)) = pack8(o);
        const int tt = tb + r;
        if (tt >= SL - 3) { float* cp = A.out + O_SCP + ((size_t)b * 3 + (tt - (SL - 3))) * 3072 + c0;
#pragma unroll
            for (int j = 0; j < 8; ++j) cp[j] = cur[j]; }
#pragma unroll
        for (int j = 0; j < 8; ++j) { p3[j] = p2[j]; p2[j] = p1[j]; p1[j] = cur[j]; }
    }
}

__device__ __forceinline__ void ssd_dec_item(LAS unsigned char* lds, const Args& A, int item, int tid_in) {
    const int tid = tid_in, wid = tid >> 6, lane = tid & 63;
    const int g = item & 3, b = item >> 2;
    const bf16_t* Pd = (const bf16_t*)(A.ws + WS_PROJD) + (size_t)b * NUP; const float* BAd = (const float*)(A.ws + WS_BAD) + b * 32;
    bf16_t* YBd = (bf16_t*)(A.ws + WS_YBD) + (size_t)b * DFF;
    LAS float* xs = (LAS float*)lds; LAS float* Bs = xs + 512; LAS float* Cs = xs + 640; LAS float* ys = xs + 768; LAS float* dts = xs + 1280; LAS float* dAs = xs + 1288; LAS float* red = xs + 1296;
    for (int c = tid; c < 768; c += 512) {
        const int xc = (c < 512) ? (g * 512 + c) : (c < 640) ? (2048 + g * 128 + (c - 512)) : (2560 + g * 128 + (c - 640));
        const float* cin = A.in[(4)] + (size_t)b * 3 * 3072 + xc;
        const float c0 = cin[0], c1 = cin[3072], c2 = cin[6144], nw = bf2f(Pd[2048 + xc]);
        const float* cw = A.in[(15)] + xc;
        xs[c] = silu_f(A.in[(16)][xc] + cw[0] * c0 + cw[3072] * c1 + cw[6144] * c2 + cw[9216] * nw);
        float* co = A.out + O_SCS + (size_t)b * 3 * 3072 + xc; co[0] = c1; co[3072] = c2; co[6144] = nw;
    }
    if (tid < 8) { const int h = g * 8 + tid; const float dt = softplus_f(BAd[h] + A.in[(18)][h]); dts[tid] = dt; dAs[tid] = __expf(-__expf(A.in[(17)][h]) * dt); }
    __syncthreads();
    const int sl = tid & 31, pr = tid >> 5;
    const f32x4 B4 = *(const LAS f32x4*)(Bs + sl * 4), C4 = *(const LAS f32x4*)(Cs + sl * 4);
    const float* Sin0 = A.in[(5)] + ((size_t)(b * 32 + g * 8) * 64) * 128 + sl * 4;
    float* Sout0 = A.out + O_SSS + ((size_t)(b * 32 + g * 8) * 64) * 128 + sl * 4;
    f32x4 Snx[4];
#pragma unroll
    for (int it = 0; it < 4; ++it) Snx[it] = __builtin_nontemporal_load((const f32x4*)(Sin0 + (it * 16 + pr) * 128));
#pragma unroll
    for (int j = 0; j < 8; ++j) {
        const float dt = dts[j], dA = dAs[j];
        f32x4 S[4];
#pragma unroll
        for (int it = 0; it < 4; ++it) S[it] = Snx[it];
        if (j + 1 < 8) {
#pragma unroll
            for (int it = 0; it < 4; ++it) Snx[it] = __builtin_nontemporal_load((const f32x4*)(Sin0 + (size_t)(j + 1) * 8192 + (it * 16 + pr) * 128));
        }
#pragma unroll
        for (int it = 0; it < 4; ++it) { const int p = it * 16 + pr; const float xd = xs[j * 64 + p] * dt;
            const f32x4 Sn = S[it] * dA + B4 * xd; __builtin_nontemporal_store(Sn, (f32x4*)(Sout0 + (size_t)j * 8192 + p * 128));
            float y = (Sn[0] * C4[0] + Sn[1] * C4[1]) + (Sn[2] * C4[2] + Sn[3] * C4[3]);
            y += DPP_F(y, 0xB1, 0xf); y += DPP_F(y, 0x4E, 0xf); y += DPP_F(y, 0x141, 0xf); y += DPP_F(y, 0x140, 0xf); y += DPP_F(y, 0x142, 0xa);
            if (sl == 31) ys[j * 64 + p] = y; }
    }
    __syncthreads();
    {
        const int c = tid, h = g * 8 + (c >> 6);
        const float y = (ys[c] + A.in[(19)][h] * xs[c]) * silu_f(bf2f(Pd[g * 512 + c]));
        const float s = wave_sum(y * y); if (lane == 0) red[wid] = s;
        __syncthreads();
        float tot = 0.f;
#pragma unroll
        for (int w = 0; w < 8; ++w) tot += red[w];
        const float r = y * __builtin_amdgcn_rsqf(tot * (1.f / 512.f) + RMS_EPS) * A.in[(20)][g * 512 + c];
        YBd[g * 512 + c] = (bf16_t)(pack2(r, 0.f) & 0xffffu);
    }
    __syncthreads();
}

constexpr int SS_XT = 0, SS_XDT = 9216, SS_BT = 18432, SS_SC = 36864, SS_SB0 = 46080, SS_SB1 = 63488, SS_BS = 80896, SS_CS = 98304, SS_AC = 115712, SS_DT = 115968;
__device__ __forceinline__ void ssd_step(LAS unsigned char* lds, bf16_t* __restrict__ Y, const size_t t0, const int h, const int sbc, const int sbn,
                                         const u32x4 px, const u32x4 pb0, const u32x4 pb1, const u32x4 pc0, const u32x4 pc1, const float pdt,
                                         const float aneg, const float dtb, const float Dh, f32x4 (&sacc)[4], const int tid) {
    const int wid = tid >> 6, lane = tid & 63, fr = lane & 15, fq = lane >> 4, ti = wid >> 1;
    const int jx = tid >> 3, xm = tid & 7, jb0 = tid >> 4, jb1 = 32 + (tid >> 4), bm = tid & 15;
    LAS float* acum = (LAS float*)(lds + SS_AC); LAS float* dtv = (LAS float*)(lds + SS_DT);
        if (wid == 0) { const float dt = softplus_f(pdt + dtb); const float ac = wave_incl_scan(dt * aneg, lane); acum[lane] = ac; dtv[lane] = dt; }
        *(LAS u32x4*)(lds + SS_BS + (jb0 * 136 + bm * 8) * 2) = pb0; *(LAS u32x4*)(lds + SS_BS + (jb1 * 136 + bm * 8) * 2) = pb1;
        *(LAS u32x4*)(lds + SS_CS + (jb0 * 136 + bm * 8) * 2) = pc0; *(LAS u32x4*)(lds + SS_CS + (jb1 * 136 + bm * 8) * 2) = pc1;
        lds_barrier();
        const float alast = acum[63];
        {
            const float sx = dtv[jx] * __expf(alast - acum[jx]);
            const int colx = (((jx >> 3) ^ xm) * 8 + (jx & 7)) * 2;
            const unsigned wx[4] = {px.x, px.y, px.z, px.w};
#pragma unroll
            for (int q = 0; q < 8; ++q) { const unsigned w = wx[q >> 1]; const unsigned short raw = (q & 1) ? (unsigned short)(w >> 16) : (unsigned short)(w & 0xffffu);
                const float xv = bf2f(raw); const int rowb = (xm * 8 + q) * 144;
                *(LAS unsigned short*)(lds + SS_XT + rowb + colx) = raw;
                *(LAS unsigned short*)(lds + SS_XDT + rowb + colx) = (unsigned short)(pack2(xv * sx, 0.f) & 0xffffu); }
            const int colb0 = (((jb0 >> 3) ^ (bm & 7)) * 8 + (jb0 & 7)) * 2, colb1 = (((jb1 >> 3) ^ (bm & 7)) * 8 + (jb1 & 7)) * 2;
            const unsigned wb0[4] = {pb0.x, pb0.y, pb0.z, pb0.w}, wb1[4] = {pb1.x, pb1.y, pb1.z, pb1.w};
#pragma unroll
            for (int q = 0; q < 8; ++q) { const int rowb = (bm * 8 + q) * 144;
                *(LAS unsigned short*)(lds + SS_BT + rowb + colb0) = (q & 1) ? (unsigned short)(wb0[q >> 1] >> 16) : (unsigned short)(wb0[q >> 1] & 0xffffu);
                *(LAS unsigned short*)(lds + SS_BT + rowb + colb1) = (q & 1) ? (unsigned short)(wb1[q >> 1] >> 16) : (unsigned short)(wb1[q >> 1] & 0xffffu); }
        }
        bf16x8 fc[4];
#pragma unroll
        for (int kk = 0; kk < 4; ++kk) fc[kk] = *(const LAS bf16x8*)(lds + SS_CS + ((ti * 16 + fr) * 136 + kk * 32 + fq * 8) * 2);
#pragma unroll
        for (int tjj = 0; tjj < 2; ++tjj) {
            const int tj = (wid & 1) * 2 + tjj;
            f32x4 acc = (f32x4){0.f, 0.f, 0.f, 0.f};
            if (tj <= ti) {
#pragma unroll
                for (int kk = 0; kk < 4; ++kk) { const bf16x8 fb = *(const LAS bf16x8*)(lds + SS_BS + ((tj * 16 + fr) * 136 + kk * 32 + fq * 8) * 2); acc = mfma16(fb, fc[kk], acc); }
            }
            const int i = ti * 16 + fr; const float ai = acum[i]; f32x4 sc;
#pragma unroll
            for (int r = 0; r < 4; ++r) { const int j = tj * 16 + fq * 4 + r; sc[r] = (i >= j) ? acc[r] * __expf(ai - acum[j]) * dtv[j] : 0.f; }
            *(LAS u32x2*)(lds + SS_SC + (i * 72 + tj * 16 + fq * 4) * 2) = pack4(sc);
        }
        lds_barrier();
        {
            bf16x8 fsc[2];
#pragma unroll
            for (int kk = 0; kk < 2; ++kk) fsc[kk] = *(const LAS bf16x8*)(lds + SS_SC + ((ti * 16 + fr) * 72 + kk * 32 + fq * 8) * 2);
            const int i = ti * 16 + fr; const float ea = __expf(acum[i]);
#pragma unroll
            for (int tpp = 0; tpp < 2; ++tpp) {
                const int tp = (wid & 1) * 2 + tpp, prow = tp * 16 + fr, psw = (prow >> 3) & 7;
                f32x4 a1 = (f32x4){0.f, 0.f, 0.f, 0.f}, a2 = (f32x4){0.f, 0.f, 0.f, 0.f};
#pragma unroll
                for (int kk = 0; kk < 2; ++kk) { const bf16x8 fx = *(const LAS bf16x8*)(lds + SS_XT + (prow * 72 + (((kk * 4 + fq) ^ psw) * 8)) * 2); a1 = mfma16(fx, fsc[kk], a1); }
#pragma unroll
                for (int kk = 0; kk < 4; ++kk) { const bf16x8 fs = *(const LAS bf16x8*)(lds + sbc + (prow * 136 + kk * 32 + fq * 8) * 2); a2 = mfma16(fs, fc[kk], a2); }
                const int p0 = tp * 16 + fq * 4;
                const int xcol = (((i >> 3) ^ ((p0 >> 3) & 7)) * 8 + (i & 7)) * 2;
                f32x4 y = a1 + a2 * ea;
#pragma unroll
                for (int r = 0; r < 4; ++r) y[r] += Dh * bf2f(*(const LAS unsigned short*)(lds + SS_XT + (p0 + r) * 144 + xcol));
                *(u32x2*)(Y + (t0 + i) * 2048 + h * 64 + p0) = pack4(y);
            }
        }
        {
            const int tp = wid >> 1, prow = tp * 16 + fr, psw = (prow >> 3) & 7; const float el = __expf(alast);
            bf16x8 fxd[2];
#pragma unroll
            for (int kk = 0; kk < 2; ++kk) fxd[kk] = *(const LAS bf16x8*)(lds + SS_XDT + (prow * 72 + (((kk * 4 + fq) ^ psw) * 8)) * 2);
#pragma unroll
            for (int q = 0; q < 4; ++q) { const int ts = (wid & 1) * 4 + q, srow = ts * 16 + fr, ssw = (srow >> 3) & 7; sacc[q] = sacc[q] * el;
#pragma unroll
                for (int kk = 0; kk < 2; ++kk) { const bf16x8 fb = *(const LAS bf16x8*)(lds + SS_BT + (srow * 72 + (((kk * 4 + fq) ^ ssw) * 8)) * 2); sacc[q] = mfma16(fb, fxd[kk], sacc[q]); }
                *(LAS u32x2*)(lds + sbn + (prow * 136 + ts * 16 + fq * 4) * 2) = pack4(sacc[q]); }
        }
        lds_barrier();
}

__device__ __forceinline__ void ssd_scan_item(LAS unsigned char* lds, const Args& A, int item, int tid_in) {
    const int tid = tid_in, wid = tid >> 6, lane = tid & 63, fr = lane & 15, fq = lane >> 4;
    const int xcd = item & 7, slot = item >> 3, grp = xcd * 4 + (slot >> 3);
    const int b = grp >> 2, g = grp & 3, h = g * 8 + (slot & 7);
    const bf16_t* XA = (const bf16_t*)(A.ws + WS_XA); const bf16_t* BCA = (const bf16_t*)(A.ws + WS_BCA); const float* BA = (const float*)(A.ws + WS_BA);
    bf16_t* Y = (bf16_t*)(A.ws + WS_YB);
    LAS float* acum = (LAS float*)(lds + SS_AC); LAS float* dtv = (LAS float*)(lds + SS_DT);
    const float aneg = -__expf(A.in[17][h]), dtb = A.in[18][h], Dh = A.in[19][h];
    for (int e = tid; e < 17408 / 4; e += 512) ((LAS unsigned*)(lds + SS_SB0))[e] = 0u;
    f32x4 sacc[4];
#pragma unroll
    for (int q = 0; q < 4; ++q) sacc[q] = (f32x4){0.f, 0.f, 0.f, 0.f};
    int cur = 0;
    const int ti = wid >> 1;
    const int jx = tid >> 3, xm = tid & 7;
    const int jb0 = tid >> 4, jb1 = 32 + (tid >> 4), bm = tid & 15;
    u32x4 npx0, npb00, npb10, npc00, npc10; float npdt0 = 0.f;
    u32x4 npx1, npb01, npb11, npc01, npc11; float npdt1 = 0.f;
#define SS_LOAD(S, nn) { const size_t _t0 = (size_t)b * SL + (nn) * 64; \
        npx##S = *(const u32x4*)(XA + (_t0 + jx) * 2048 + h * 64 + xm * 8); \
        npb0##S = *(const u32x4*)(BCA + (_t0 + jb0) * 1024 + g * 128 + bm * 8); npb1##S = *(const u32x4*)(BCA + (_t0 + jb1) * 1024 + g * 128 + bm * 8); \
        npc0##S = *(const u32x4*)(BCA + (_t0 + jb0) * 1024 + 512 + g * 128 + bm * 8); npc1##S = *(const u32x4*)(BCA + (_t0 + jb1) * 1024 + 512 + g * 128 + bm * 8); \
        if (wid == 0) npdt##S = BA[(_t0 + lane) * 32 + h]; }
#define SS_STEP(S, nn, DOLOAD) { \
        const size_t t0 = (size_t)b * SL + (nn) * 64; \
        const int sbc = cur ? SS_SB1 : SS_SB0, sbn = cur ? SS_SB0 : SS_SB1; \
        const u32x4 px = npx##S, pb0 = npb0##S, pb1 = npb1##S, pc0 = npc0##S, pc1 = npc1##S; const float pdt = npdt##S; \
        if (DOLOAD) { SS_LOAD(S, (nn) + 2) } \
        ssd_step(lds, Y, t0, h, sbc, sbn, px, pb0, pb1, pc0, pc1, pdt, aneg, dtb, Dh, sacc, tid); \
        cur ^= 1; }
    SS_LOAD(0, 0) SS_LOAD(1, 1)
    __syncthreads();
    for (int n = 0; n < 28; n += 4) {
        __builtin_amdgcn_s_waitcnt(0x0F70);
        SS_STEP(0, n, 1) SS_STEP(1, n + 1, 1) SS_STEP(0, n + 2, 1) SS_STEP(1, n + 3, 1)
    }
    __builtin_amdgcn_s_waitcnt(0x0F70);
    SS_STEP(0, 28, 1) SS_STEP(1, 29, 1) SS_STEP(0, 30, 0) SS_STEP(1, 31, 0)
#undef SS_STEP
#undef SS_LOAD
    {
        const int tp = wid >> 1; float* So = A.out + O_SSP + (size_t)(b * 32 + h) * 8192;
#pragma unroll
        for (int q = 0; q < 4; ++q) { const int ts = (wid & 1) * 4 + q; *(f32x4*)(So + (tp * 16 + fr) * 128 + ts * 16 + fq * 4) = sacc[q]; }
    }
    __syncthreads();
}

__device__ __forceinline__ void ssd_gate_row(const Args& A, size_t row, int lane) {
    bf16_t* Y = (bf16_t*)(A.ws + WS_YB) + row * 2048; const bf16_t* Z = (const bf16_t*)(A.ws + WS_PROJ) + row * 5120;
    u32x4 yq[4], zq[4];
#pragma unroll
    for (int g = 0; g < 4; ++g) { yq[g] = __builtin_nontemporal_load((const u32x4*)(Y + g * 512 + lane * 8)); zq[g] = __builtin_nontemporal_load((const u32x4*)(Z + g * 512 + lane * 8)); }
#pragma unroll
    for (int g = 0; g < 4; ++g) {
        const int c0 = g * 512 + lane * 8; float y[8], z[8];
        unpack8(yq[g], y); unpack8(zq[g], z);
        float ss = 0.f;
#pragma unroll
        for (int j = 0; j < 8; ++j) { y[j] *= silu_f(z[j]); ss += y[j] * y[j]; }
        const float rstd = __builtin_amdgcn_rsqf(wave_sum(ss) * (1.f / 512.f) + RMS_EPS);
        const float* nw = A.in[20] + c0;
#pragma unroll
        for (int j = 0; j < 8; ++j) y[j] = y[j] * rstd * nw[j];
        *(u32x4*)(Y + c0) = pack8(y);
    }
}


__constant__ int P0_BASE[8] = {0, 544, 672, 1344, 1600, 2304, 3008, 3360};
__constant__ int P0_IN[8] = {7, 13, 14, 21, 22, 22, 25, 25};
__constant__ unsigned P0_INOFF[8] = {0, 0, 0, 0, 0, 1024u * 5632u, 0, 2816u * 1024u};
__constant__ unsigned P0_WOFS[8] = {(unsigned)WS_WGI, (unsigned)WS_WGO, (unsigned)WS_WSI, (unsigned)WS_WSO, (unsigned)WS_WUP0, (unsigned)WS_WUP1, (unsigned)WS_WDN0, (unsigned)WS_WDN1};
__constant__ int P0_K[8] = {1024, 1024, 1024, 2048, 1024, 1024, 2816, 2816};
__constant__ int P0_N[8] = {4112, 1024, 5152, 1024, 5632, 5632, 1024, 1024};

#define XB_TMO      128
#define XB_XCNT(j)  (256  + 64 * (j))
#define XB_XSUB(j)  (1280 + 64 * (j))
#define XB_XGEN(j)  (2304 + 64 * (j))
#define XB_TOP      3328
#define XB_TOPGEN   3392
#define XCD_BAR_WORDS 3456
#define XB_SPIN_CAP (1u << 18)
__device__ __forceinline__ unsigned xb_ld(unsigned* p)              { return __hip_atomic_load(p, __ATOMIC_RELAXED, __HIP_MEMORY_SCOPE_AGENT); }
__device__ __forceinline__ unsigned xb_add(unsigned* p, unsigned v) { return __hip_atomic_fetch_add(p, v, __ATOMIC_RELAXED, __HIP_MEMORY_SCOPE_AGENT); }
__device__ __forceinline__ unsigned xb_xcc_id() { return (unsigned)__builtin_amdgcn_s_getreg((3 << 11) | 20) & 0xFu; }
#define XB_SPIN(cond, bar) do { unsigned _sp = 0; while (cond) { __builtin_amdgcn_s_sleep(1); \
    if ((++_sp & 255u) == 0u) { if (xb_ld(&(bar)[XB_TMO])) break; if (_sp > XB_SPIN_CAP) { atomicAdd(&(bar)[XB_TMO], 1u); break; } } } } while (0)
struct XcdBarrier { unsigned* bar; unsigned x; volatile LAS unsigned* st; };
__device__ __forceinline__ XcdBarrier xcd_barrier_post(unsigned* bar, volatile LAS unsigned* st) {
    XcdBarrier b; b.bar = bar; b.x = xb_xcc_id(); b.st = st;
    if (threadIdx.x == 0) (void)xb_add(&bar[XB_XCNT(b.x)], 1u);
    return b;
}
__device__ __forceinline__ void xcd_barrier_complete(unsigned* bar, unsigned x, unsigned& nloc, unsigned& nx) {
    const unsigned G = gridDim.x * gridDim.y * gridDim.z;
    unsigned sum, cnt, mine, sp = 0u;
    for (;;) {
        sum = 0u; cnt = 0u; mine = 0u;
#pragma unroll
        for (unsigned j = 0; j < 16; ++j) { const unsigned c = xb_ld(&bar[XB_XCNT(j)]); sum += c; cnt += (c > 0u) ? 1u : 0u; mine = (j == x) ? c : mine; }
        if (sum == G) break;
        __builtin_amdgcn_s_sleep(1);
        if ((++sp & 255u) == 0u) { if (xb_ld(&bar[XB_TMO])) break; if (sp > XB_SPIN_CAP) { atomicAdd(&bar[XB_TMO], 1u); break; } }
    }
    nloc = mine > 0u ? mine : 1u; nx = cnt > 0u ? cnt : 1u;
}
__device__ __forceinline__ void xcd_barrier(const XcdBarrier& b, int tid) {
    asm volatile("s_waitcnt vmcnt(0)" ::: "memory");
    __syncthreads();
    if (tid == 0) {
        unsigned* bar = b.bar;
        __builtin_amdgcn_s_waitcnt(0);
        unsigned nloc = b.st[0], nx = b.st[1];
        if (nloc == 0u) { xcd_barrier_complete(bar, b.x, nloc, nx); b.st[0] = nloc; b.st[1] = nx; }
        const unsigned old = xb_add(&bar[XB_XSUB(b.x)], 1u);
        const unsigned gen = old / nloc;
        if (old + 1u == (gen + 1u) * nloc) {
            __builtin_amdgcn_fence(__ATOMIC_RELEASE, "agent");
            asm volatile("s_waitcnt vmcnt(0)" ::: "memory");
            const unsigned og = xb_add(&bar[XB_TOP], 1u);
            const unsigned tg = og / nx;
            if (og + 1u == (tg + 1u) * nx) xb_add(&bar[XB_TOPGEN], 1u);
            else XB_SPIN(xb_ld(&bar[XB_TOPGEN]) == tg, bar);
            __builtin_amdgcn_fence(__ATOMIC_ACQUIRE, "agent");
            xb_add(&bar[XB_XGEN(b.x)], 1u);
            asm volatile("s_waitcnt vmcnt(0)" ::: "memory");
        } else {
            XB_SPIN(xb_ld(&bar[XB_XGEN(b.x)]) == gen, bar);
            __builtin_amdgcn_fence(__ATOMIC_ACQUIRE, "agent");
            asm volatile("s_waitcnt vmcnt(0)" ::: "memory");
        }
    }
    __syncthreads();
}

#ifndef PHMASK
#define PHMASK 0xffffff
#endif
#define EN(k) ((PHMASK >> (k)) & 1)
constexpr int NPHASE = 21;
__global__ void __launch_bounds__(512, 2) fwd_kernel(Args A) {
    __shared__ __attribute__((aligned(16))) unsigned char lds_raw[LDS_BYTES];
    LAS unsigned char* lds = (LAS unsigned char*)lds_raw;
    const int wave_s = __builtin_amdgcn_readfirstlane((int)threadIdx.x >> 6);
#define TID make_tid(wave_s)
    if (threadIdx.x < 4) ((LAS unsigned*)(lds + 131072))[threadIdx.x] = 0u;
    __syncthreads();
    (void)xcd_barrier_post((unsigned*)(A.ws + WS_BARR), (volatile LAS unsigned*)(lds + 131072));
    if (A.ph_hi > NPHASE) cg::this_grid().sync();
#ifndef REPMASK
#define REPMASK 0
#endif
    const int ph_end = __builtin_amdgcn_readfirstlane(A.ph_hi);
    int rep_done = 0;
    for (int ph = __builtin_amdgcn_readfirstlane(A.ph_lo); ph < ph_end; ) {
        {
        int G = gridDim.x, bid = blockIdx.x; asm volatile("" : "+s"(G), "+s"(bid));
        unsigned long long zoff = 0; asm volatile("" : "+s"(zoff));
        unsigned char* ws = A.ws + zoff;
        const bool is_gemm = (ph == 1) | (ph == 5) | (ph == 7) | (ph == 9) | (ph == 11) | (ph == 15) | (ph == 17) | (ph == 19);
        const bool is_ln = (ph == 6) | (ph == 10) | (ph == 16) | (ph == 20);
        if (EN(1) && is_gemm) {
            const bf16_t* Ap = (const bf16_t*)(ws + WS_XB); const bf16_t* Ad = (const bf16_t*)(ws + WS_XBD); int ldad = 1024;
            size_t wofs = WS_WGI, oofs = WS_PROJ, dofs = WS_PROJD; int N = 4096, K = 1024, ldo = 4096, nbf = 4096, nf = 16, ncg = 65, ldp = NUP;
            if (ph == 5) { Ap = (const bf16_t*)(ws + WS_YB); Ad = (const bf16_t*)(ws + WS_YBD); ldad = DFF; wofs = WS_WGO; N = 1024; K = 1024; }
            else if (ph == 7 || ph == 17) { wofs = (ph == 7) ? WS_WUP0 : WS_WUP1; N = NUP; K = 1024; ldo = NUP; nbf = NUP; nf = 0; ncg = 88; }
            else if (ph == 9 || ph == 19) { Ap = (const bf16_t*)(ws + WS_YB); Ad = (const bf16_t*)(ws + WS_YBD); ldad = DFF; wofs = (ph == 9) ? WS_WDN0 : WS_WDN1; N = 1024; K = DFF; }
            else if (ph == 11) { wofs = WS_WSI; N = 5120; K = 1024; ldo = 5120; nbf = 5120; nf = 32; ncg = 81; }
            else if (ph == 15) { Ap = (const bf16_t*)(ws + WS_YB); Ad = (const bf16_t*)(ws + WS_YBD); ldad = DFF; wofs = WS_WSO; N = 1024; K = 2048; }
            if (N == 1024) { oofs = WS_H; dofs = WS_HD; ldo = 1024; nbf = 1024; nf = 0; ncg = 16; ldp = 1024; }
            const bf16_t* Bt = (const bf16_t*)(ws + wofs);
            pg8::Gemm g{Ap, Bt, MP, N, K}; pg8::StaticOrder S; S.init(MP, N, G, bid);
            const bool gated = (ph == 7) | (ph == 17); const int lyr = (ph == 17);
            if (gated) oofs = WS_YB;
            pg8::EpiUni E{gated ? 2 : 1, (bf16_t*)(ws + oofs), ldo,
                          A.in[23] + (size_t)lyr * 3 * DFF, A.in[24] + (size_t)lyr * DFF, (float*)(ws + WS_XF), A.out + O_FCP + (size_t)lyr * 8 * 2 * DFF};
            pg8::gemm_phase(lds, g, S, E, TID);
            DecStore st{ldp, nbf, nf, (bf16_t*)(ws + dofs), (float*)(ws + WS_BAD)};
            {
                const int rxt = S.nwg % G, nfree = G - rxt;
                if (bid >= rxt) for (int it = bid - rxt; it < 8 * ncg; it += nfree) small_gemm_item(lds, Ad, ldad, Bt, K, it, st, TID);
            }
            if (ph == 1) { for (int it = bid; it < MP / 128; it += G) narrow_item<1>(Ap, Bt + (size_t)4096 * 1024, 1024, (float*)(ws + WS_BA), it, TID); }
            if (ph == 11) { for (int it = bid; it < MP / 128; it += G) narrow_item<2>(Ap, Bt + (size_t)5120 * 1024, 1024, (float*)(ws + WS_BA), it, TID); }
        } else if (EN(6) && is_ln) {
            const int tid = TID, wid = tid >> 6, lane = tid & 63; (void)tid;
            const int layer = (ph >= 16); const bool fin = (ph == 20), is2 = (ph == 10) | (ph == 20);
            const float* gam = A.in[is2 ? 28 : 26] + layer * 1024; const float* bet = A.in[is2 ? 29 : 27] + layer * 1024;
            bf16_t* XB = (bf16_t*)(ws + WS_XB); bf16_t* XBd = (bf16_t*)(ws + WS_XBD);
            const bf16_t* H = (const bf16_t*)(ws + WS_H); const bf16_t* Hd = (const bf16_t*)(ws + WS_HD);
            for (int it = bid; it < (MP + DB) / 16; it += G) { const int row = it * 16 + wid * 2;
                if (row < MP) { const size_t o0 = (size_t)row * 1024, o1 = o0 + 1024;
                    ln_row2(XB + o0, H + o0, XB + o1, H + o1, gam, bet, fin ? A.out + O_YP + o0 : (float*)nullptr, fin ? (bf16_t*)nullptr : XB + o0, fin ? A.out + O_YP + o1 : (float*)nullptr, fin ? (bf16_t*)nullptr : XB + o1, lane); }
                else { const size_t o0 = (size_t)(row - MP) * 1024, o1 = o0 + 1024;
                    ln_row2(XBd + o0, Hd + o0, XBd + o1, Hd + o1, gam, bet, fin ? A.out + O_YS + o0 : (float*)nullptr, fin ? (bf16_t*)nullptr : XBd + o0, fin ? A.out + O_YS + o1 : (float*)nullptr, fin ? (bf16_t*)nullptr : XBd + o1, lane); } }
        } else if (EN(0) && ph == 0) {
            const int tid = TID, wid = tid >> 6, lane = tid & 63; (void)tid; (void)wid; (void)lane;
#define P0_DESC(it) \
            int mi = 0; \
            _Pragma("unroll") for (int q = 1; q < 8; ++q) mi += ((it) >= P0_BASE[q]) ? 1 : 0; \
            const float* W = A.in[P0_IN[mi]] + P0_INOFF[mi]; bf16_t* Wt = (bf16_t*)(ws + P0_WOFS[mi]); const int K = P0_K[mi], N = P0_N[mi]; \
            const int idx = (it) - P0_BASE[mi], nk = K / 128, k0 = (idx % nk) * 128, n0 = (idx / nk) * 64; \
            const int ns0 = (mi == 4 || mi == 5) ? (((n0 >> 7) & 1) * DFF + (n0 >> 8) * 128 + (n0 & 127)) : n0;
            for (int it = bid; it < 1032; it += G) {
                if (it < 1024) convert_rows16(A.in[0] + (size_t)it * 16 * 1024, (bf16_t*)(ws + WS_XB) + (size_t)it * 16 * 1024, TID);
                else convert_rows16(A.in[1] + (size_t)(it - 1024) * 16 * 1024, (bf16_t*)(ws + WS_XBD) + (size_t)(it - 1024) * 16 * 1024, TID);
            }
            LAS float* s = (LAS float*)lds;
            float rr[16];
            if (bid < 3712) { P0_DESC(bid)
#pragma unroll
                for (int i = 0; i < 16; ++i) { const int e = i * 512 + tid, kk = e >> 6, nn = e & 63, n = ns0 + nn; rr[i] = (n < N) ? __builtin_nontemporal_load(W + (size_t)(k0 + kk) * N + n) : 0.f; } }
            for (int it = bid; it < 3712; it += G) {
#pragma unroll
                for (int i = 0; i < 16; ++i) { const int e = i * 512 + tid, kk = e >> 6, nn = e & 63; s[nn * 129 + kk] = rr[i]; }
                __syncthreads();
                if (it + G < 3712) { P0_DESC(it + G)
#pragma unroll
                    for (int i = 0; i < 16; ++i) { const int e = i * 512 + tid, kk = e >> 6, nn = e & 63, n = ns0 + nn; rr[i] = (n < N) ? __builtin_nontemporal_load(W + (size_t)(k0 + kk) * N + n) : 0.f; } }
                { P0_DESC(it)
#pragma unroll
                    for (int i = 0; i < 8; ++i) { const int e = i * 512 + tid, nn = e >> 6, kp = e & 63;
                        *(unsigned*)(Wt + (size_t)(n0 + nn) * K + k0 + 2 * kp) = pack2(s[nn * 129 + 2 * kp], s[nn * 129 + 2 * kp + 1]); } }
                __syncthreads();
            }
#undef P0_DESC
        } else if (EN(2) && ph == 2) {
            gdn_a_phase(lds, A, bid, G, TID);
#ifndef NO_DEC
            for (int it = bid; it < 1024; it += G) gdn_dec_item(lds, A, it, TID);
#endif
        } else if (EN(3) && ph == 3) {
            for (int it = bid; it < 256; it += G) gdn_scan_item(lds, A, it, TID);
        } else if (EN(4) && ph == 4) {
            const int tid = TID, wid = tid >> 6, lane = tid & 63; (void)tid; (void)wid; (void)lane;
            for (int it = bid; it < MP / 8; it += G) gdn_gate_row(A, (size_t)it * 8 + wid, lane);
        } else if (EN(8) && (ph == 8 || ph == 18)) {
            const int layer = (ph == 18);
            const float* cw = A.in[23] + (size_t)layer * 3 * DFF; const float* cb = A.in[24] + (size_t)layer * DFF;
            for (int it = bid; it < 256 + 8; it += G) {
                if (it < 256) ffn_fixup_item((const float*)(ws + WS_XF), (const float*)(ws + WS_XF) + (size_t)256 * 2 * DFF, (bf16_t*)(ws + WS_YB), cw, it, TID);
                else ffn_gate_dec_item((const bf16_t*)(ws + WS_PROJD), (bf16_t*)(ws + WS_YBD), cw, cb, A.in[6] + (size_t)layer * 128 * 2 * DFF, A.out + O_FCS + (size_t)layer * 128 * 2 * DFF, it - 256, TID); }
        } else if (EN(12) && ph == 12) {
            for (int it = bid; it < MP / 16; it += G) ssd_conv_item(A, it, TID);
            __syncthreads();
            for (int it = bid; it < 512; it += G) ssd_dec_item(lds, A, it, TID);
        } else if (EN(13) && ph == 13) {
            for (int it = bid; it < 256; it += G) ssd_scan_item(lds, A, it, TID);
        } else if (EN(14) && ph == 14) {
            const int tid = TID, wid = tid >> 6, lane = tid & 63; (void)tid; (void)wid; (void)lane;
            for (int it = bid; it < MP / 8; it += G) ssd_gate_row(A, (size_t)it * 8 + wid, lane);
        }
        }
        const bool again = (((unsigned)REPMASK >> ph) & 1u) && !rep_done;
        rep_done = again ? 1 : 0;
        const int phn = __builtin_amdgcn_readfirstlane(again ? ph : ph + 1);
        if (phn < ph_end) {
            { XcdBarrier xbar; xbar.bar = (unsigned*)(A.ws + WS_BARR); xbar.x = xb_xcc_id(); xbar.st = (volatile LAS unsigned*)(lds + 131072); xcd_barrier(xbar, TID); }
        }
        ph = phn;
    }
}

extern "C" void kernel_launch(void* const* d_in, const int* in_sizes, int n_in, void* d_out, int out_size, void* d_ws, size_t ws_size, hipStream_t stream) {
    static int grid = 0;
    if (grid == 0) {
        if (n_in != 30 || ws_size < WS_END) { fprintf(stderr, "kernel_launch: need 30 inputs and >= %zu bytes of workspace (got %d, %zu)\n", (size_t)WS_END, n_in, ws_size); grid = -1; return; }
        int dev = 0, cus = 0, per_cu = 0;
        (void)hipGetDevice(&dev); (void)hipDeviceGetAttribute(&cus, hipDeviceAttributeMultiprocessorCount, dev);
        if (hipOccupancyMaxActiveBlocksPerMultiprocessor(&per_cu, (const void*)fwd_kernel, 512, 0) != hipSuccess || per_cu < 1) { fprintf(stderr, "kernel_launch: occupancy query failed (%d)\n", per_cu); per_cu = 1; (void)hipGetLastError(); }
        grid = cus * per_cu;
    }
    if (grid < 0) return;
    if (hipMemsetAsync((char*)d_ws + WS_BARR, 0, 16384, stream) != hipSuccess) { fprintf(stderr, "kernel_launch: memset of barrier words failed\n"); return; }
    Args a{};
    for (int i = 0; i < 30; ++i) a.in[i] = (const float*)d_in[i];
    a.out = (float*)d_out; a.ws = (unsigned char*)d_ws;
#if ONE_LAUNCH
    a.ph_lo = 0; a.ph_hi = NPHASE;
    void* args[] = {&a};
    hipError_t e = hipLaunchCooperativeKernel((const void*)fwd_kernel, dim3(grid), dim3(512), args, 0, stream);
    if (e != hipSuccess) fprintf(stderr, "cooperative launch failed: %s (grid %d)\n", hipGetErrorString(e), grid);
#else
#ifndef NPH_RUN
#define NPH_RUN NPHASE
#endif
    for (int p = 0; p < NPH_RUN; ++p) { a.ph_lo = p; a.ph_hi = p + 1; hipLaunchKernelGGL(fwd_kernel, dim3(grid), dim3(512), 0, stream, a); }
#endif
}
```

```cpp
#include <hip/hip_runtime.h>
#include <hip/hip_cooperative_groups.h>
#include <cstdio>
namespace cg = cooperative_groups;

#ifndef ONE_LAUNCH
#define ONE_LAUNCH 1
#endif

#define LAS __attribute__((address_space(3)))
typedef unsigned short bf16_t;
typedef short bf16x8 __attribute__((ext_vector_type(8)));
typedef float f32x4 __attribute__((ext_vector_type(4)));
typedef float f32x2 __attribute__((ext_vector_type(2)));
typedef unsigned u32x4 __attribute__((ext_vector_type(4)));
typedef unsigned u32x2 __attribute__((ext_vector_type(2)));

constexpr int D = 1024, BP = 8, SL = 2048, MP = BP * SL, DB = 128;
constexpr int GH = 8, GIN = 4112, GINP = 4352;
constexpr int SIN = 5152, SINP = 5376, SINNER = 2048, SHEADS = 32;
constexpr int DFF = 2816, NUP = 5632;
constexpr float DN_ALPHA = 1.4142135623730951f;
constexpr float LN_EPS = 1e-5f, RMS_EPS = 1e-6f;

constexpr size_t MB = 1u << 20;
constexpr size_t WS_WGI = 0, WS_WGO = 17 * MB / 2, WS_WSI = 21 * MB / 2, WS_WSO = 21 * MB, WS_WUP0 = 25 * MB, WS_WUP1 = 36 * MB,
                 WS_WDN0 = 47 * MB, WS_WDN1 = 105 * MB / 2, WS_XB = 58 * MB, WS_XF = 90 * MB, WS_PROJ = 154 * MB, WS_H = 330 * MB,
                 WS_YB = 394 * MB, WS_BA = 482 * MB, WS_DEC = 484 * MB;
constexpr size_t WS_XBD = WS_DEC, WS_XFD = WS_XBD + 256 * 1024, WS_PROJD = WS_XFD + 512 * 1024, WS_BAD = WS_PROJD + 1441792,
                 WS_HD = WS_BAD + 16384, WS_YBD = WS_HD + 512 * 1024, WS_EGL = WS_YBD + 720896, WS_BARR = WS_EGL + 8192, WS_END = WS_BARR + 16384;
constexpr size_t WS_UT = WS_YB, WS_WN = WS_YB + 32 * MB, WS_QK = WS_YB + 64 * MB, WS_QD = WS_PROJ + 128 * MB, WS_KDT = WS_XF;
constexpr size_t WS_O = WS_H, WS_XA = WS_H, WS_BCA = WS_XF;

constexpr size_t O_YP = 0, O_YS = 16777216, O_GCP = 16908288, O_GCS = 16982016, O_GSP = 18161664, O_GSS = 19210240, O_SCP = 35987456,
                 O_SCS = 36061184, O_SSP = 37240832, O_SSS = 39337984, O_FCP = 72892416, O_FCS = 72982528;

constexpr int LDS_BYTES = 131072 + 2048 + 16384;

__device__ __forceinline__ int make_tid(int wave_s) { unsigned ones = ~0u; asm volatile("" : "+s"(ones)); int t = wave_s * 64 + (int)__builtin_amdgcn_mbcnt_hi(ones, __builtin_amdgcn_mbcnt_lo(ones, 0u)); asm volatile("" : "+v"(t)); return t; }
__device__ __forceinline__ float bf2f(unsigned b) { return __uint_as_float(b << 16); }
typedef __bf16 bf16x2_t __attribute__((ext_vector_type(2)));
__device__ __forceinline__ unsigned pack2(float lo, float hi) { const f32x2 v = {lo, hi}; const bf16x2_t b = __builtin_convertvector(v, bf16x2_t); return __builtin_bit_cast(unsigned, b); }
__device__ __forceinline__ float lo_f(unsigned w) { return __uint_as_float(w << 16); }
__device__ __forceinline__ float hi_f(unsigned w) { return __uint_as_float(w & 0xffff0000u); }
__device__ __forceinline__ float silu_f(float x) { return x * __builtin_amdgcn_rcpf(1.f + __expf(-x)); }
__device__ __forceinline__ float sigmoid_f(float x) { return __builtin_amdgcn_rcpf(1.f + __expf(-x)); }
__device__ __forceinline__ float softplus_f(float x) { return x > 20.f ? x : log1pf(__expf(x)); }
#define DPP_F(x, ctrl, rmask) __builtin_bit_cast(float, __builtin_amdgcn_update_dpp(0, __builtin_bit_cast(int, (x)), (ctrl), (rmask), 0xf, false))
__device__ __forceinline__ float wave_sum(float v) {
    v += DPP_F(v, 0xB1, 0xf);
    v += DPP_F(v, 0x4E, 0xf);
    v += DPP_F(v, 0x141, 0xf);
    v += DPP_F(v, 0x140, 0xf);
    v += DPP_F(v, 0x142, 0xa);
    v += DPP_F(v, 0x143, 0xc);
    return __builtin_bit_cast(float, __builtin_amdgcn_readlane(__builtin_bit_cast(int, v), 63));
}
__device__ __forceinline__ float wave_incl_scan(float v, int lane) {
#pragma unroll
    for (int o = 1; o < 64; o <<= 1) { float t = __shfl_up(v, o); if (lane >= o) v += t; }
    return v;
}
__device__ __forceinline__ f32x4 mfma16(bf16x8 a, bf16x8 b, f32x4 c) { return __builtin_amdgcn_mfma_f32_16x16x32_bf16(a, b, c, 0, 0, 0); }
__device__ __forceinline__ void lds_barrier() { asm volatile("s_waitcnt lgkmcnt(0)" ::: "memory"); __builtin_amdgcn_s_barrier(); asm volatile("" ::: "memory"); }
__device__ __forceinline__ u32x2 pack4(f32x4 v) { u32x2 r; r.x = pack2(v[0], v[1]); r.y = pack2(v[2], v[3]); return r; }

namespace pg8 {
constexpr int BM = 256, BK = 64, HALF = 128, HTB = HALF * BK * 2, STAGE_BYTES = 8 * HTB, NXCD = 8, WGM = 8;
__device__ __forceinline__ int lds_byte(int r, int c) { const int st = (r >> 4) * 2 + (c >> 5), rr = r & 15, cc = c & 31, ob = rr * 64 + cc * 2; return st * 1024 + (ob ^ (((ob >> 9) & 1) << 5)); }
__device__ __forceinline__ void stage_rc(int b, int& R, int& C) { const int st = b / 1024, sb = b % 1024, swz = sb ^ (((sb >> 9) & 1) << 5); R = (st >> 1) * 16 + swz / 64; C = (st & 1) * 32 + (swz % 64) / 2; }
__device__ __forceinline__ int perm32(int rho) { const int n = rho >> 4, i = rho & 15; return 8 * (i >> 2) + 4 * n + (i & 3); }
struct Unit { int pm, pn; };
struct Gemm { const bf16_t* A; const bf16_t* Bt; int M, N, K; };
struct StaticOrder {
    int nM, nN, nwg, G, c;
    __device__ void init(int M, int N, int G_, int c_) { nM = M / BM; nN = N / BM; nwg = nM * nN; G = G_; c = c_; }
    __device__ bool next(int i, Unit& u) const {
        const long L = (long)i * G + c; if (L >= nwg) return false;
        int wgid = (int)L; { const int q = nwg / NXCD, r = nwg % NXCD, xcd = wgid % NXCD, off = wgid / NXCD; wgid = (xcd < r ? xcd * (q + 1) : r * (q + 1) + (xcd - r) * q) + off; }
        const int nig = WGM * nN, gid = wgid / nig, fm = gid * WGM, gsz = (nM - fm) < WGM ? (nM - fm) : WGM;
        u.pm = fm + ((wgid % nig) % gsz); u.pn = (wgid % nig) / gsz; return true;
    }
};
struct EpiF32 {
    static constexpr bool PERM = false;
    float* C; int ldc;
    __device__ __forceinline__ void operator()(const f32x4 (&acc)[2][2][4][2], const Unit& u, int wr, int wc, int fr, int fq) const {
        const int row0 = u.pm * BM + wr * 64 + fr, col0 = u.pn * BM + wc * 32 + 4 * fq;
#pragma unroll
        for (int ai = 0; ai < 2; ++ai)
#pragma unroll
            for (int m = 0; m < 4; ++m) { float* rowp = C + (size_t)(row0 + ai * HALF + m * 16) * ldc + col0;
#pragma unroll
                for (int bj = 0; bj < 2; ++bj)
#pragma unroll
                    for (int n = 0; n < 2; ++n) *(f32x4*)(rowp + bj * HALF + n * 16) = acc[ai][bj][m][n]; }
    }
};
struct EpiBf16 {
    static constexpr bool PERM = true;
    bf16_t* O; int ldo;
    __device__ __forceinline__ void operator()(const f32x4 (&acc)[2][2][4][2], const Unit& u, int wr, int wc, int fr, int fq) const {
        const int row0 = u.pm * BM + wr * 64 + fr, col0 = u.pn * BM + wc * 32 + 8 * fq;
#pragma unroll
        for (int ai = 0; ai < 2; ++ai)
#pragma unroll
            for (int m = 0; m < 4; ++m) { bf16_t* rowp = O + (size_t)(row0 + ai * HALF + m * 16) * ldo + col0;
#pragma unroll
                for (int bj = 0; bj < 2; ++bj) { const f32x4 v0 = acc[ai][bj][m][0], v1 = acc[ai][bj][m][1];
                    u32x4 w; w.x = pack2(v0[0], v0[1]); w.y = pack2(v0[2], v0[3]); w.z = pack2(v1[0], v1[1]); w.w = pack2(v1[2], v1[3]);
                    *(u32x4*)(rowp + bj * HALF) = w; } }
    }
};
__device__ __forceinline__ float dpp_ror1(float x) { return __builtin_bit_cast(float, __builtin_amdgcn_update_dpp(0, __builtin_bit_cast(int, x), 0x121, 0xf, 0xf, false)); }
__device__ __forceinline__ float dpp_ror2(float x) { return __builtin_bit_cast(float, __builtin_amdgcn_update_dpp(0, __builtin_bit_cast(int, x), 0x122, 0xf, 0xf, false)); }
struct EpiGate {
    bf16_t* HB; const float* cw; const float* cb; float* edge; float* first; float* cache;
    __device__ __forceinline__ void operator()(const f32x4 (&acc)[2][2][4][2], const Unit& u, int wr, int wc, int fr_, int fq_) const {
        int fr = fr_, fq = fq_; asm volatile("" : "+v"(fr), "+v"(fq));
#pragma unroll
        for (int n = 0; n < 2; ++n) {
            const int ch = u.pn * 128 + wc * 32 + 8 * fq + 4 * n;
            const f32x4 w0 = *(const f32x4*)(cw + ch), w1 = *(const f32x4*)(cw + DFF + ch), w2 = *(const f32x4*)(cw + 2 * DFF + ch), bb = *(const f32x4*)(cb + ch);
#pragma unroll
            for (int ai = 0; ai < 2; ++ai) {
                const int strip = u.pm * 4 + ai * 2 + wr;
                f32x4 pr1 = (f32x4){0.f, 0.f, 0.f, 0.f}, pr2 = pr1;
#pragma unroll
                for (int m = 0; m < 4; ++m) {
                    const f32x4 g = acc[ai][0][m][n], v = acc[ai][1][m][n];
                    f32x4 c1, c2;
#pragma unroll
                    for (int j = 0; j < 4; ++j) { c1[j] = dpp_ror1(g[j]); c2[j] = dpp_ror2(g[j]); }
                    const f32x4 p1 = (m == 0 || fr >= 1) ? c1 : pr1;
                    const f32x4 p2 = (m == 0 || fr >= 2) ? c2 : pr2;
                    pr1 = c1; pr2 = c2;
                    const size_t row = (size_t)u.pm * 256 + ai * 128 + wr * 64 + m * 16 + fr;
                    if (m == 0 && fr < 2) {
                        const f32x4 pa = (fr == 0) ? (bb + w2 * g) : (bb + w1 * p1 + w2 * g);
                        float* fp = first + ((size_t)strip * 2 + fr) * (2 * DFF) + ch;
                        *(f32x4*)fp = pa; *(f32x4*)(fp + DFF) = v;
                    } else {
                        const f32x4 y = bb + w0 * p2 + w1 * p1 + w2 * g; f32x4 o;
#pragma unroll
                        for (int j = 0; j < 4; ++j) o[j] = silu_f(y[j]) * v[j];
                        *(u32x2*)(HB + row * DFF + ch) = pack4(o);
                    }
                    if (m == 3 && fr >= 14) {
                        *(f32x4*)(edge + ((size_t)strip * 2 + (fr - 14)) * DFF + ch) = g;
                        if ((strip & 31) == 31) *(f32x4*)(cache + ((size_t)(strip >> 5) * 2 + (fr - 14)) * DFF + ch) = g;
                    }
                }
            }
        }
    }
};
struct EpiUni {
    int mode; bf16_t* O; int ldo; const float* cw; const float* cb; float* aux; float* cache;
    __device__ __forceinline__ void operator()(const f32x4 (&acc)[2][2][4][2], const Unit& u, int wr, int wc, int fr_, int fq_) const {
        (void)fr_; (void)fq_;
        unsigned ones = ~0u; asm volatile("" : "+s"(ones));
        const int lane_e = (int)__builtin_amdgcn_mbcnt_hi(ones, __builtin_amdgcn_mbcnt_lo(ones, 0u)), fr = lane_e & 15, fq = lane_e >> 4;
        if (mode == 2) { EpiGate e{O, cw, cb, aux, aux + (size_t)256 * 2 * DFF, cache}; e(acc, u, wr, wc, fr, fq); }
        else { EpiBf16 e{O, ldo}; e(acc, u, wr, wc, fr, fq); }
    }
};

template <class Epi, class Sched>
__device__ __forceinline__ void gemm_phase(LAS unsigned char* lds, const Gemm g, const Sched& S, const Epi& E, int tid_in) {
    const int tid = tid_in, wid = __builtin_amdgcn_readfirstlane(tid >> 6), lane = tid & 63, wr = wid >> 2, wc = wid & 3, fr = lane & 15, fq = lane >> 4;
    const int K = g.K, nt = K / BK;
    unsigned voffA[2], voffB[2];
#pragma unroll
    for (int i = 0; i < 2; ++i) { int R, C; stage_rc(tid * 16 + i * 8192, R, C); const int Rb = (E.mode != 0) ? ((R & ~31) + perm32(R & 31)) : R;
        voffA[i] = (unsigned)(R * K + C) * 2u; voffB[i] = (unsigned)(Rb * K + C) * 2u; }
    const size_t kstep = (size_t)(BK * 2);
    const size_t hstep = (size_t)HALF * K * 2;
    const size_t tstep = 2 * hstep;
    const unsigned ldsw = (unsigned)wid * 1024u;
    const int aoff = lds_byte(wr * 64 + fr, fq * 8), boff = lds_byte(wc * 32 + fr, fq * 8);
#define PG8_SA(b, h) (((b) * 2 + (h)) * HTB)
#define PG8_SB(b, h) ((4 + (b) * 2 + (h)) * HTB)
#define PG8_STAGE(bufoff, gbase, voff) do { _Pragma("unroll") for (int _i = 0; _i < 2; ++_i) \
        __builtin_amdgcn_global_load_lds((const unsigned*)((const char*)(gbase) + (voff)[_i]), (LAS unsigned*)(lds + (bufoff) + ldsw + _i * 8192), 16, 0, 0); } while (0)
#define PG8_LDA(dst, b, h) do { _Pragma("unroll") for (int m = 0; m < 4; ++m) _Pragma("unroll") for (int k = 0; k < 2; ++k) dst[m][k] = *(const LAS bf16x8*)(lds + PG8_SA(b, h) + aoff + m * 2048 + k * 1024); } while (0)
#define PG8_LDB(dst, b, h) do { _Pragma("unroll") for (int n = 0; n < 2; ++n) _Pragma("unroll") for (int k = 0; k < 2; ++k) dst[n][k] = *(const LAS bf16x8*)(lds + PG8_SB(b, h) + boff + n * 2048 + k * 1024); } while (0)
#define PG8_MMA(ai, bj, At, Bt) do { __builtin_amdgcn_s_setprio(1); _Pragma("unroll") for (int m = 0; m < 4; ++m) _Pragma("unroll") for (int n = 0; n < 2; ++n) _Pragma("unroll") for (int k = 0; k < 2; ++k) \
        acc[ai][bj][m][n] = __builtin_amdgcn_mfma_f32_16x16x32_bf16(Bt[n][k], At[m][k], acc[ai][bj][m][n], 0, 0, 0); __builtin_amdgcn_s_setprio(0); } while (0)
#define PG8_WAIT_V(n) asm volatile("s_waitcnt vmcnt(" #n ")" ::: "memory")
#define PG8_WAIT_L(n) asm volatile("s_waitcnt lgkmcnt(" #n ")" ::: "memory")
#define PG8_BAR __builtin_amdgcn_s_barrier()
#define PG8_SCHED __builtin_amdgcn_sched_barrier(0)
    Unit cur, nxt; int ui = 0;
    if (!S.next(0, cur)) return;
    f32x4 acc[2][2][4][2];
#pragma unroll
    for (int a = 0; a < 2; ++a)
#pragma unroll
        for (int b = 0; b < 2; ++b)
#pragma unroll
            for (int m = 0; m < 4; ++m)
#pragma unroll
                for (int n = 0; n < 2; ++n) acc[a][b][m][n] = (f32x4){0.f, 0.f, 0.f, 0.f};
    bf16x8 At[4][2], B0[2][2], B1[2][2];
    const char* cA = (const char*)g.A + (size_t)cur.pm * tstep; const char* cB = (const char*)g.Bt + (size_t)cur.pn * tstep;
    PG8_STAGE(PG8_SB(0, 0), cB, voffB); PG8_STAGE(PG8_SA(0, 0), cA, voffA); PG8_STAGE(PG8_SB(0, 1), cB + hstep, voffB); PG8_STAGE(PG8_SA(0, 1), cA + hstep, voffA);
    if (wr == 1) PG8_BAR;
    PG8_WAIT_V(4); PG8_BAR;
    PG8_STAGE(PG8_SB(1, 0), cB + kstep, voffB); PG8_STAGE(PG8_SA(1, 0), cA + kstep, voffA); PG8_STAGE(PG8_SB(1, 1), cB + hstep + kstep, voffB);
    PG8_WAIT_V(6); PG8_BAR;
    for (;;) {
        const bool has_next = S.next(ui + 1, nxt);
        const char* nA = has_next ? (const char*)g.A + (size_t)nxt.pm * tstep : cA; const char* nB = has_next ? (const char*)g.Bt + (size_t)nxt.pn * tstep : cB;
        for (int t = 0; t < nt; t += 2) {
            const bool last = (t == nt - 2);
            const char* a1 = cA + (size_t)(t + 1) * kstep;
            const char* a2 = last ? nA : cA + (size_t)(t + 2) * kstep; const char* b2 = last ? nB : cB + (size_t)(t + 2) * kstep;
            const char* a3 = a2 + kstep; const char* b3 = b2 + kstep;
            PG8_LDB(B0, 0, 0); PG8_SCHED; PG8_LDA(At, 0, 0); PG8_STAGE(PG8_SA(1, 1), a1 + hstep, voffA);
            PG8_WAIT_L(8); PG8_BAR; PG8_WAIT_L(0); PG8_MMA(0, 0, At, B0); PG8_BAR; PG8_SCHED;
            PG8_LDB(B1, 0, 1); PG8_STAGE(PG8_SB(0, 0), b2, voffB);
            PG8_BAR; PG8_WAIT_L(0); PG8_MMA(0, 1, At, B1); PG8_BAR;
            PG8_LDA(At, 0, 1); PG8_STAGE(PG8_SA(0, 0), a2, voffA);
            PG8_BAR; PG8_WAIT_L(0); PG8_MMA(1, 0, At, B0); PG8_BAR; PG8_SCHED;
            PG8_STAGE(PG8_SB(0, 1), b2 + hstep, voffB);
            PG8_WAIT_V(6); PG8_BAR; PG8_MMA(1, 1, At, B1); PG8_BAR;
            PG8_LDB(B0, 1, 0); PG8_SCHED; PG8_LDA(At, 1, 0); PG8_STAGE(PG8_SA(0, 1), a2 + hstep, voffA);
            PG8_WAIT_L(8); PG8_BAR; PG8_WAIT_L(0); PG8_MMA(0, 0, At, B0); PG8_BAR; PG8_SCHED;
            PG8_LDB(B1, 1, 1); PG8_STAGE(PG8_SB(1, 0), b3, voffB);
            PG8_BAR; PG8_WAIT_L(0); PG8_MMA(0, 1, At, B1); PG8_BAR;
            PG8_LDA(At, 1, 1); PG8_STAGE(PG8_SA(1, 0), a3, voffA);
            PG8_BAR; PG8_WAIT_L(0); PG8_MMA(1, 0, At, B0); PG8_BAR; PG8_SCHED;
            PG8_STAGE(PG8_SB(1, 1), b3 + hstep, voffB);
            PG8_WAIT_V(6); PG8_BAR; PG8_MMA(1, 1, At, B1); PG8_BAR;
        }
        E(acc, cur, wr, wc, fr, fq);
        if (!has_next) break;
#pragma unroll
        for (int a = 0; a < 2; ++a)
#pragma unroll
            for (int b = 0; b < 2; ++b)
#pragma unroll
                for (int m = 0; m < 4; ++m)
#pragma unroll
                    for (int n = 0; n < 2; ++n) acc[a][b][m][n] = (f32x4){0.f, 0.f, 0.f, 0.f};
        cur = nxt; cA = nA; cB = nB; ++ui;
    }
    PG8_WAIT_V(0);
    if (wr == 0) PG8_BAR;
    PG8_BAR;
#undef PG8_SA
#undef PG8_SB
#undef PG8_STAGE
#undef PG8_LDA
#undef PG8_LDB
#undef PG8_MMA
#undef PG8_WAIT_V
#undef PG8_WAIT_L
#undef PG8_BAR
#undef PG8_SCHED
}
}

struct Args {
    const float* in[30];
    float* out;
    unsigned char* ws;
    int ph_lo, ph_hi;
};

struct DecStore {
    int ldp, nbf, nf; bf16_t* Pd; float* BAd;
    __device__ __forceinline__ void operator()(int row, int col, float v0, float v1) const {
        if (col < nbf) { *(unsigned*)(Pd + (size_t)row * ldp + col) = pack2(v0, v1); }
        else if (col < nbf + nf) { BAd[row * 32 + col - nbf] = v0; BAd[row * 32 + col - nbf + 1] = v1; }
    }
};
__device__ __forceinline__ void small_gemm_item(LAS unsigned char* lds, const bf16_t* __restrict__ A, int lda, const bf16_t* __restrict__ Bt, int K, int item, const DecStore& st, int tid_in) {
    const int tid = tid_in, wid = tid >> 6, lane = tid & 63, fr = lane & 15, fq = lane >> 4;
    const int rg = item & 7, cgp = item >> 3;
    const int kw = K >> 3;
    const bf16_t* ap = A + (size_t)(rg * 16 + fr) * lda + wid * kw + fq * 8;
    const bf16_t* bp = Bt + (size_t)(cgp * 64 + fr) * K + wid * kw + fq * 8;
    f32x4 acc[4];
#pragma unroll
    for (int n = 0; n < 4; ++n) acc[n] = (f32x4){0.f, 0.f, 0.f, 0.f};
    int k0 = 0;
    for (; k0 + 128 <= kw; k0 += 128) {
        bf16x8 a[4], bq[4][4];
#pragma unroll
        for (int q = 0; q < 4; ++q) { a[q] = *(const bf16x8*)(ap + k0 + 32 * q);
#pragma unroll
            for (int n = 0; n < 4; ++n) bq[q][n] = *(const bf16x8*)(bp + (size_t)n * 16 * K + k0 + 32 * q); }
#pragma unroll
        for (int q = 0; q < 4; ++q)
#pragma unroll
            for (int n = 0; n < 4; ++n) acc[n] = mfma16(a[q], bq[q][n], acc[n]);
    }
    for (; k0 < kw; k0 += 32) {
        const bf16x8 a = *(const bf16x8*)(ap + k0);
#pragma unroll
        for (int n = 0; n < 4; ++n) { const bf16x8 b = *(const bf16x8*)(bp + (size_t)n * 16 * K + k0); acc[n] = mfma16(a, b, acc[n]); }
    }
    LAS float* red = (LAS float*)lds;
#pragma unroll
    for (int n = 0; n < 4; ++n)
#pragma unroll
        for (int r = 0; r < 4; ++r) red[wid * 1024 + (fq * 4 + r) * 64 + n * 16 + fr] = acc[n][r];
    __syncthreads();
    {
        const int row = tid >> 5, c2 = (tid & 31) * 2; float v0 = 0.f, v1 = 0.f;
#pragma unroll
        for (int w = 0; w < 8; ++w) { v0 += red[w * 1024 + row * 64 + c2]; v1 += red[w * 1024 + row * 64 + c2 + 1]; }
        st(rg * 16 + row, cgp * 64 + c2, v0, v1);
    }
    __syncthreads();
}

template <int NT>
__device__ __forceinline__ void narrow_item(const bf16_t* __restrict__ A, const bf16_t* __restrict__ Bt, int K, float* __restrict__ BAo, int item, int tid_in) {
    const int tid = tid_in, wid = tid >> 6, lane = tid & 63, fr = lane & 15, fq = lane >> 4;
    const int row0 = item * 128 + wid * 16;
    const bf16_t* ap = A + (size_t)(row0 + fr) * K + fq * 8;
    const bf16_t* bp = Bt + (size_t)fr * K + fq * 8;
    f32x4 acc[NT];
#pragma unroll
    for (int n = 0; n < NT; ++n) acc[n] = (f32x4){0.f, 0.f, 0.f, 0.f};
#pragma unroll 4
    for (int k = 0; k < K; k += 32) {
        const bf16x8 a = *(const bf16x8*)(ap + k);
#pragma unroll
        for (int n = 0; n < NT; ++n) { const bf16x8 bfr = *(const bf16x8*)(bp + (size_t)n * 16 * K + k); acc[n] = mfma16(bfr, a, acc[n]); }
    }
#pragma unroll
    for (int n = 0; n < NT; ++n) *(f32x4*)(BAo + (size_t)(row0 + fr) * 32 + n * 16 + fq * 4) = acc[n];
}

__device__ __forceinline__ void convert_rows16(const float* __restrict__ src, bf16_t* __restrict__ dst, int tid_in) {
#pragma unroll
    for (int i = 0; i < 8; ++i) { const int e = i * 512 + tid_in; const f32x4 v = __builtin_nontemporal_load((const f32x4*)src + e);
        u32x2 w; w.x = pack2(v[0], v[1]); w.y = pack2(v[2], v[3]); ((u32x2*)dst)[e] = w; }
}

__device__ __forceinline__ void unpack8(const u32x4 w, float (&f)[8]) {
    f[0] = lo_f(w.x); f[1] = hi_f(w.x); f[2] = lo_f(w.y); f[3] = hi_f(w.y); f[4] = lo_f(w.z); f[5] = hi_f(w.z); f[6] = lo_f(w.w); f[7] = hi_f(w.w);
}
__device__ __forceinline__ u32x4 pack8(const float (&f)[8]) { u32x4 w; w.x = pack2(f[0], f[1]); w.y = pack2(f[2], f[3]); w.z = pack2(f[4], f[5]); w.w = pack2(f[6], f[7]); return w; }
__device__ __forceinline__ void ln_row(const bf16_t* __restrict__ xres, const bf16_t* __restrict__ h, const float* __restrict__ gam, const float* __restrict__ bet,
                                       float* __restrict__ outF, bf16_t* __restrict__ outB, int lane) {
    float v[2][8]; float s = 0.f;
#pragma unroll
    for (int i = 0; i < 2; ++i) { float a[8], b[8]; unpack8(((const u32x4*)xres)[i * 64 + lane], a); unpack8(((const u32x4*)h)[i * 64 + lane], b);
#pragma unroll
        for (int j = 0; j < 8; ++j) { v[i][j] = a[j] * DN_ALPHA + b[j]; s += v[i][j]; } }
    const float mu = wave_sum(s) * (1.f / 1024.f); float q = 0.f;
#pragma unroll
    for (int i = 0; i < 2; ++i)
#pragma unroll
        for (int j = 0; j < 8; ++j) { v[i][j] -= mu; q += v[i][j] * v[i][j]; }
    const float rstd = __builtin_amdgcn_rsqf(wave_sum(q) * (1.f / 1024.f) + LN_EPS);
#pragma unroll
    for (int i = 0; i < 2; ++i) { float o[8];
#pragma unroll
        for (int hh = 0; hh < 2; ++hh) { const f32x4 g = ((const f32x4*)gam)[i * 128 + lane * 2 + hh], b = ((const f32x4*)bet)[i * 128 + lane * 2 + hh];
#pragma unroll
            for (int j = 0; j < 4; ++j) o[hh * 4 + j] = v[i][hh * 4 + j] * rstd * g[j] + b[j]; }
        if (outB) ((u32x4*)outB)[i * 64 + lane] = pack8(o);
        if (outF) { ((f32x4*)outF)[i * 128 + lane * 2] = (f32x4){o[0], o[1], o[2], o[3]}; ((f32x4*)outF)[i * 128 + lane * 2 + 1] = (f32x4){o[4], o[5], o[6], o[7]}; } }
}

__device__ __forceinline__ void ln_row2(const bf16_t* __restrict__ x0, const bf16_t* __restrict__ h0, const bf16_t* __restrict__ x1, const bf16_t* __restrict__ h1,
                                        const float* __restrict__ gam, const float* __restrict__ bet, float* oF0, bf16_t* oB0, float* oF1, bf16_t* oB1, int lane) {
    u32x4 xa[2][2], ha[2][2];
#pragma unroll
    for (int i = 0; i < 2; ++i) { xa[0][i] = ((const u32x4*)x0)[i * 64 + lane]; ha[0][i] = ((const u32x4*)h0)[i * 64 + lane]; xa[1][i] = ((const u32x4*)x1)[i * 64 + lane]; ha[1][i] = ((const u32x4*)h1)[i * 64 + lane]; }
#pragma unroll
    for (int rr = 0; rr < 2; ++rr) {
        float v[2][8]; float s = 0.f;
#pragma unroll
        for (int i = 0; i < 2; ++i) { float a[8], b[8]; unpack8(xa[rr][i], a); unpack8(ha[rr][i], b);
#pragma unroll
            for (int j = 0; j < 8; ++j) { v[i][j] = a[j] * DN_ALPHA + b[j]; s += v[i][j]; } }
        const float mu = wave_sum(s) * (1.f / 1024.f); float q = 0.f;
#pragma unroll
        for (int i = 0; i < 2; ++i)
#pragma unroll
            for (int j = 0; j < 8; ++j) { v[i][j] -= mu; q += v[i][j] * v[i][j]; }
        const float rstd = __builtin_amdgcn_rsqf(wave_sum(q) * (1.f / 1024.f) + LN_EPS);
        float* outF = rr ? oF1 : oF0; bf16_t* outB = rr ? oB1 : oB0;
#pragma unroll
        for (int i = 0; i < 2; ++i) { float o[8];
#pragma unroll
            for (int hh = 0; hh < 2; ++hh) { const f32x4 g = ((const f32x4*)gam)[i * 128 + lane * 2 + hh], b = ((const f32x4*)bet)[i * 128 + lane * 2 + hh];
#pragma unroll
                for (int j = 0; j < 4; ++j) o[hh * 4 + j] = v[i][hh * 4 + j] * rstd * g[j] + b[j]; }
            if (outB) ((u32x4*)outB)[i * 64 + lane] = pack8(o);
            if (outF) { __builtin_nontemporal_store((f32x4){o[0], o[1], o[2], o[3]}, (f32x4*)outF + i * 128 + lane * 2); __builtin_nontemporal_store((f32x4){o[4], o[5], o[6], o[7]}, (f32x4*)outF + i * 128 + lane * 2 + 1); } }
    }
}

__device__ __forceinline__ void ffn_fixup_item(const float* __restrict__ edge, const float* __restrict__ first, bf16_t* __restrict__ HB, const float* __restrict__ cw, int strip, int tid_in) {
    const int t = tid_in; if (t >= 352) return;
    const int c0 = t * 8;
    const bool has_hist = (strip & 31) != 0;
#pragma unroll
    for (int hh = 0; hh < 2; ++hh) {
        const int ch = c0 + 4 * hh;
        const f32x4 w0 = *(const f32x4*)(cw + ch), w1 = *(const f32x4*)(cw + DFF + ch);
        f32x4 e0 = (f32x4){0.f, 0.f, 0.f, 0.f}, e1 = e0;
        if (has_hist) { e0 = *(const f32x4*)(edge + ((size_t)(strip - 1) * 2 + 0) * DFF + ch); e1 = *(const f32x4*)(edge + ((size_t)(strip - 1) * 2 + 1) * DFF + ch); }
#pragma unroll
        for (int rr = 0; rr < 2; ++rr) {
            const float* fp = first + ((size_t)strip * 2 + rr) * (2 * DFF) + ch;
            const f32x4 pa = *(const f32x4*)fp, v = *(const f32x4*)(fp + DFF);
            const f32x4 y = (rr == 0) ? (pa + w0 * e0 + w1 * e1) : (pa + w0 * e1); f32x4 o;
#pragma unroll
            for (int j = 0; j < 4; ++j) o[j] = silu_f(y[j]) * v[j];
            *(u32x2*)(HB + ((size_t)strip * 64 + rr) * DFF + ch) = pack4(o);
        }
    }
}
__device__ __forceinline__ void ffn_gate_dec_item(const bf16_t* __restrict__ GVd, bf16_t* __restrict__ HBd, const float* __restrict__ cw, const float* __restrict__ cb,
                                                  const float* __restrict__ cache_in  , float* __restrict__ cache_out, int item, int tid_in) {
    const int t = tid_in; if (t >= 352) return;
    const int c0 = t * 8;
    float w0[8], w1[8], w2[8], bb[8];
#pragma unroll
    for (int j = 0; j < 8; ++j) { w0[j] = cw[c0 + j]; w1[j] = cw[DFF + c0 + j]; w2[j] = cw[2 * DFF + c0 + j]; bb[j] = cb[c0 + j]; }
    for (int r = 0; r < 16; ++r) {
        const int row = item * 16 + r;
        float gcur[8], vv[8], o[8];
        const int cp = 256 * (c0 >> 7) + (c0 & 127);
        unpack8(*(const u32x4*)(GVd + (size_t)row * NUP + cp), gcur); unpack8(*(const u32x4*)(GVd + (size_t)row * NUP + cp + 128), vv);
        const float* ci = cache_in + (size_t)row * 2 * DFF + c0; float* co = cache_out + (size_t)row * 2 * DFF + c0;
#pragma unroll
        for (int j = 0; j < 8; ++j) { const float c0v = ci[j], c1v = ci[DFF + j]; const float y = bb[j] + w0[j] * c0v + w1[j] * c1v + w2[j] * gcur[j]; o[j] = silu_f(y) * vv[j];
            co[j] = c1v; co[DFF + j] = gcur[j]; }
        *(u32x4*)(HBd + (size_t)row * DFF + c0) = pack8(o);
    }
}

constexpr int GA_QS = 0, GA_KS = 17408, GA_VBT = 34816, GA_KBGT = 53248, GA_MS = 71680, GA_TS = 89088, GA_GC = 98304, GA_BT = 98560, GA_TL = 99328, GA_PB = 115712;
__device__ __forceinline__ void gdn_a_phase(LAS unsigned char* lds, const Args& A, int bid, int G, int tid_in) {
    const bf16_t* PROJ = (const bf16_t*)(A.ws + WS_PROJ);
    const float* BA = (const float*)(A.ws + WS_BA);
    float* EGL = (float*)(A.ws + WS_EGL);
    LAS unsigned* Qs = (LAS unsigned*)(lds + GA_QS); LAS unsigned* Ks = (LAS unsigned*)(lds + GA_KS);
    LAS float* Ms = (LAS float*)(lds + GA_MS); LAS bf16_t* Ts = (LAS bf16_t*)(lds + GA_TS);
    LAS float* gc = (LAS float*)(lds + GA_GC); LAS float* bt = (LAS float*)(lds + GA_BT);
    LAS float* Tl = (LAS float*)(lds + GA_TL); LAS float* Pb = (LAS float*)(lds + GA_PB);
    unsigned xw[3][11]; float pbr = 0.f, par = 0.f;
#define GA_IDS int tid = tid_in; asm volatile("" : "+v"(tid)); const int wid = tid >> 6, lane = tid & 63, fr = lane & 15, fq = lane >> 4, i0 = wid * 8, c = 2 * lane; (void)fr; (void)fq;
#define GA_LOAD(it) { const int _n = (it) & 31, _h = ((it) >> 5) & 7, _b = (it) >> 8; \
        _Pragma("unroll") for (int seg = 0; seg < 3; ++seg) _Pragma("unroll") for (int r = 0; r < 11; ++r) { const int t = _n * 64 + i0 + r - 3; \
            xw[seg][r] = *(const unsigned*)(PROJ + ((size_t)_b * SL + (t < 0 ? 0 : t)) * 4096 + seg * 1024 + _h * 128 + c); } \
        if (wid == 0) { const size_t _rb = (size_t)_b * SL + _n * 64 + lane; pbr = BA[_rb * 32 + _h]; par = BA[_rb * 32 + 8 + _h]; } }
    if (bid < 2048) { GA_IDS GA_LOAD(bid) }
    for (int item = bid; item < 2048; item += G) {
        GA_IDS
        const int n = item & 31, h = (item >> 5) & 7, b = item >> 8, chunk = (b * 8 + h) * 32 + n;
        bf16_t* UT = (bf16_t*)(A.ws + WS_UT) + (size_t)chunk * 8192; bf16_t* WN = (bf16_t*)(A.ws + WS_WN) + (size_t)chunk * 8192;
        bf16_t* QD = (bf16_t*)(A.ws + WS_QD) + (size_t)chunk * 8192; bf16_t* KDT = (bf16_t*)(A.ws + WS_KDT) + (size_t)chunk * 8192;
        bf16_t* QK = (bf16_t*)(A.ws + WS_QK) + (size_t)chunk * 4096;
        if (wid == 0) {
            const float g = -__expf(A.in[10][h]) * softplus_f(par + A.in[11][h]);
            const float gcum = wave_incl_scan(g, lane);
            gc[lane] = gcum; bt[lane] = sigmoid_f(pbr);
            if (lane == 63) EGL[chunk] = __expf(gcum);
        }
        lds_barrier();
        {
            const float glast = gc[63];
#pragma unroll
            for (int seg = 0; seg < 3; ++seg) {
                const int col = seg * 1024 + h * 128 + c;
                float w0[4], w1[4];
#pragma unroll
                for (int k = 0; k < 4; ++k) { const f32x2 t = *(const f32x2*)(A.in[8] + k * 3072 + col); w0[k] = t.x; w1[k] = t.y; }
                const f32x2 bb = *(const f32x2*)(A.in[9] + col);
                float x0[11], x1[11];
#pragma unroll
                for (int r = 0; r < 11; ++r) { const bool okr = (n * 64 + i0 + r - 3) >= 0; x0[r] = okr ? lo_f(xw[seg][r]) : 0.f; x1[r] = okr ? hi_f(xw[seg][r]) : 0.f; }
                if (n == 31 && wid == 7) {
#pragma unroll
                    for (int rr = 0; rr < 3; ++rr) *(f32x2*)(A.out + O_GCP + ((size_t)b * 3 + rr) * 3072 + col) = (f32x2){x0[8 + rr], x1[8 + rr]};
                }
                float y0[8], y1[8];
#pragma unroll
                for (int r = 0; r < 8; ++r) {
                    y0[r] = silu_f(bb.x + w0[0] * x0[r] + w0[1] * x0[r + 1] + w0[2] * x0[r + 2] + w0[3] * x0[r + 3]);
                    y1[r] = silu_f(bb.y + w1[0] * x1[r] + w1[1] * x1[r + 1] + w1[2] * x1[r + 2] + w1[3] * x1[r + 3]);
                }
                if (seg < 2) {
#pragma unroll
                    for (int r = 0; r < 8; ++r) { const float ss = wave_sum(y0[r] * y0[r] + y1[r] * y1[r]); const float rn = __builtin_amdgcn_rsqf(ss + 1e-6f) * (seg == 0 ? 0.08838834764831845f : 1.f); y0[r] *= rn; y1[r] *= rn; }
                }
                if (seg == 0) {
#pragma unroll
                    for (int r = 0; r < 8; ++r) { const int i = i0 + r; Qs[i * 68 + lane] = pack2(y0[r], y1[r]); const float eg = __expf(gc[i]);
                        *(unsigned*)(QD + i * 128 + c) = pack2(y0[r] * eg, y1[r] * eg); }
                } else if (seg == 1) {
                    float a0[8], a1[8], d0[8], d1[8];
#pragma unroll
                    for (int r = 0; r < 8; ++r) { const int i = i0 + r; Ks[i * 68 + lane] = pack2(y0[r], y1[r]); const float gi = gc[i], s1 = bt[i] * __expf(gi), s2 = __expf(glast - gi);
                        a0[r] = y0[r] * s1; a1[r] = y1[r] * s1; d0[r] = y0[r] * s2; d1[r] = y1[r] * s2; }
                    *(LAS u32x4*)(lds + GA_KBGT + (c * 72 + i0) * 2) = pack8(a0); *(LAS u32x4*)(lds + GA_KBGT + ((c + 1) * 72 + i0) * 2) = pack8(a1);
                    *(u32x4*)(KDT + c * 64 + i0) = pack8(d0); *(u32x4*)(KDT + (c + 1) * 64 + i0) = pack8(d1);
                } else {
                    float a0[8], a1[8];
#pragma unroll
                    for (int r = 0; r < 8; ++r) { const float be = bt[i0 + r]; a0[r] = y0[r] * be; a1[r] = y1[r] * be; }
                    *(LAS u32x4*)(lds + GA_VBT + (c * 72 + i0) * 2) = pack8(a0); *(LAS u32x4*)(lds + GA_VBT + ((c + 1) * 72 + i0) * 2) = pack8(a1);
                }
                __builtin_amdgcn_sched_barrier(0);
            }
        }
        lds_barrier();
        if (item + G < 2048) { GA_LOAD(item + G) }
        {
            const int ti = wid >> 1;
#pragma unroll
            for (int tjj = 0; tjj < 2; ++tjj) {
                const int tj = (wid & 1) * 2 + tjj;
                f32x4 ak = (f32x4){0.f, 0.f, 0.f, 0.f}, aq = (f32x4){0.f, 0.f, 0.f, 0.f};
                if (tj <= ti) {
#pragma unroll
                    for (int kk = 0; kk < 4; ++kk) {
                        const bf16x8 bk = *(const LAS bf16x8*)(lds + GA_KS + ((tj * 16 + fr) * 136 + kk * 32 + fq * 8) * 2);
                        const bf16x8 fk = *(const LAS bf16x8*)(lds + GA_KS + ((ti * 16 + fr) * 136 + kk * 32 + fq * 8) * 2);
                        const bf16x8 fqv = *(const LAS bf16x8*)(lds + GA_QS + ((ti * 16 + fr) * 136 + kk * 32 + fq * 8) * 2);
                        ak = mfma16(fk, bk, ak); aq = mfma16(fqv, bk, aq);
                    }
                }
                const int j = tj * 16 + fr; const float gj = gc[j];
#pragma unroll
                for (int r = 0; r < 4; ++r) { const int i = ti * 16 + fq * 4 + r; const float gi = gc[i];
                    const float e = (i >= j) ? __expf(gi - gj) : 0.f;
                    if (tj <= ti) Ms[i * 68 + j] = (i > j) ? bt[i] * ak[r] * e : 0.f;
                    QK[i * 64 + j] = (bf16_t)(pack2(aq[r] * e, 0.f) & 0xffffu); }
            }
        }
        lds_barrier();
        for (int ib = 0; ib < 4; ++ib) {
            if (ib > 0) {
                float p0 = 0.f, p1 = 0.f;
                const int ra = ib * 16 + 2 * wid;
                for (int j = 0; j < ib * 16; j += 4) {
                    const float t0 = Tl[j * 64 + lane], t1 = Tl[(j + 1) * 64 + lane], t2 = Tl[(j + 2) * 64 + lane], t3 = Tl[(j + 3) * 64 + lane];
                    const f32x4 m0 = *(const LAS f32x4*)(Ms + ra * 68 + j), m1 = *(const LAS f32x4*)(Ms + (ra + 1) * 68 + j);
                    p0 += (m0[0] * t0 + m0[1] * t1) + (m0[2] * t2 + m0[3] * t3);
                    p1 += (m1[0] * t0 + m1[1] * t1) + (m1[2] * t2 + m1[3] * t3);
                }
                Pb[(2 * wid) * 64 + lane] = p0; Pb[(2 * wid + 1) * 64 + lane] = p1;
                lds_barrier();
            }
            if (wid == 0) {
                float Tr[16];
#pragma unroll
                for (int r = 0; r < 16; ++r) {
                    float a = (ib > 0) ? -Pb[r * 64 + lane] : 0.f;
#pragma unroll
                    for (int q = 0; q < r; q += 4) {
                        const f32x4 m = *(const LAS f32x4*)(Ms + (ib * 16 + r) * 68 + ib * 16 + q);
                        a -= m[0] * Tr[q];
                        if (q + 1 < r) a -= m[1] * Tr[q + 1];
                        if (q + 2 < r) a -= m[2] * Tr[q + 2];
                        if (q + 3 < r) a -= m[3] * Tr[q + 3];
                    }
                    Tr[r] = a + ((lane == ib * 16 + r) ? 1.f : 0.f);
                    Tl[(ib * 16 + r) * 64 + lane] = Tr[r];
                    Ts[(ib * 16 + r) * 72 + lane] = (bf16_t)(pack2(Tr[r], 0.f) & 0xffffu);
                }
            }
            lds_barrier();
        }
        {
            const int td = wid;
            bf16x8 bv[2], bk[2];
#pragma unroll
            for (int kk = 0; kk < 2; ++kk) { bv[kk] = *(const LAS bf16x8*)(lds + GA_VBT + ((td * 16 + fr) * 72 + kk * 32 + fq * 8) * 2);
                bk[kk] = *(const LAS bf16x8*)(lds + GA_KBGT + ((td * 16 + fr) * 72 + kk * 32 + fq * 8) * 2); }
#pragma unroll
            for (int ti = 0; ti < 4; ++ti) {
                f32x4 au = (f32x4){0.f, 0.f, 0.f, 0.f}, aw = (f32x4){0.f, 0.f, 0.f, 0.f};
#pragma unroll
                for (int kk = 0; kk < 2; ++kk) { const bf16x8 ft = *(const LAS bf16x8*)(lds + GA_TS + ((ti * 16 + fr) * 72 + kk * 32 + fq * 8) * 2);
                    au = mfma16(ft, bv[kk], au);
                    aw = mfma16(bk[kk], ft, aw); }
                *(u32x2*)(UT + (td * 16 + fr) * 64 + ti * 16 + fq * 4) = pack4(au);
                *(u32x2*)(WN + (ti * 16 + fr) * 128 + td * 16 + fq * 4) = pack4(-aw);
            }
        }
        lds_barrier();
    }
#undef GA_LOAD
#undef GA_IDS
}

__device__ __forceinline__ void gdn_dec_item(LAS unsigned char* lds, const Args& A, int item, int tid_in) {
    const int tid = tid_in, wid = tid >> 6, lane = tid & 63;
    const int h = item & 7, b = item >> 3;
    const bf16_t* Pd = (const bf16_t*)(A.ws + WS_PROJD) + (size_t)b * NUP; const float* BAd = (const float*)(A.ws + WS_BAD) + b * 32;
    bf16_t* YBd = (bf16_t*)(A.ws + WS_YBD) + (size_t)b * DFF;
    LAS float* qs = (LAS float*)lds; LAS float* ks = qs + 128; LAS float* vs = qs + 256; LAS float* sc = qs + 384;
    LAS float* part = qs + 512;
    LAS float* os = qs + 512 + 1024;
    if (tid < 384) {
        const int seg = tid >> 7, d = tid & 127, col = seg * 1024 + h * 128 + d;
        const float* cin = A.in[2] + (size_t)b * 3 * 3072 + col;
        const float c0 = cin[0], c1 = cin[3072], c2 = cin[6144], nw = bf2f(Pd[col]);
        const float* cw = A.in[8] + col;
        const float y = A.in[9][col] + cw[0] * c0 + cw[3072] * c1 + cw[6144] * c2 + cw[9216] * nw;
        qs[tid] = silu_f(y);
        float* co = A.out + O_GCS + (size_t)b * 3 * 3072 + col; co[0] = c1; co[3072] = c2; co[6144] = nw;
    }
    __syncthreads();
    if (wid < 3) {
        const float q0 = qs[lane], q1 = qs[lane + 64], k0 = ks[lane], k1 = ks[lane + 64];
        const float v = (wid == 0) ? (q0 * q0 + q1 * q1) : (wid == 1) ? (k0 * k0 + k1 * k1) : (q0 * k0 + q1 * k1);
        const float s = wave_sum(v); if (lane == 0) sc[wid] = s;
    }
    __syncthreads();
    const float rq = __builtin_amdgcn_rsqf(sc[0] + 1e-6f) * 0.08838834764831845f, rk = __builtin_amdgcn_rsqf(sc[1] + 1e-6f), qk = sc[2] * rq * rk;
    const float g = -__expf(A.in[10][h]) * softplus_f(BAd[8 + h] + A.in[11][h]), eg = __expf(g), beta = sigmoid_f(BAd[h]);
    const int v = tid & 127, kg = tid >> 7;
    const float* Sin = A.in[3] + ((size_t)(b * 8 + h) * 128 + kg * 32) * 128 + v;
    float S[32]; float pk = 0.f, pq = 0.f;
#pragma unroll
    for (int k = 0; k < 32; ++k) S[k] = __builtin_nontemporal_load(Sin + k * 128);
#pragma unroll
    for (int k = 0; k < 32; ++k) { pk += ks[kg * 32 + k] * S[k]; pq += qs[kg * 32 + k] * S[k]; }
    part[kg * 128 + v] = pk * rk; part[512 + kg * 128 + v] = pq * rq;
    __syncthreads();
    const float kS = (part[v] + part[128 + v]) + (part[256 + v] + part[384 + v]);
    const float qS = (part[512 + v] + part[640 + v]) + (part[768 + v] + part[896 + v]);
    const float vnew = beta * (vs[v] - eg * kS);
    const float o = eg * qS + qk * vnew;
    float* Sout = A.out + O_GSS + ((size_t)(b * 8 + h) * 128 + kg * 32) * 128 + v;
#pragma unroll
    for (int k = 0; k < 32; ++k) __builtin_nontemporal_store(eg * S[k] + (ks[kg * 32 + k] * rk) * vnew, Sout + k * 128);
    if (kg == 0) os[v] = o;
    __syncthreads();
    if (wid == 0) {
        const float o0 = os[lane], o1 = os[lane + 64];
        const float rstd = __builtin_amdgcn_rsqf(wave_sum(o0 * o0 + o1 * o1) * (1.f / 128.f) + RMS_EPS);
        const float z0 = bf2f(Pd[3072 + h * 128 + lane]), z1 = bf2f(Pd[3072 + h * 128 + lane + 64]);
        const float r0 = o0 * rstd * A.in[12][lane] * silu_f(z0), r1 = o1 * rstd * A.in[12][lane + 64] * silu_f(z1);
        YBd[h * 128 + lane] = (bf16_t)(pack2(r0, 0.f) & 0xffffu); YBd[h * 128 + lane + 64] = (bf16_t)(pack2(r1, 0.f) & 0xffffu);
    }
    __syncthreads();
}

constexpr int GS_SB0 = 0, GS_SB1 = 8704, GS_VN = 17408;
__device__ __forceinline__ void gdn_scan_item(LAS unsigned char* lds, const Args& A, int item, int tid_in) {
    const int tid = tid_in, wid = tid >> 6, lane = tid & 63, fr = lane & 15, fq = lane >> 4;
    const int xcd = item & 7, slot = item >> 3, pair = xcd * 8 + (slot >> 2);
    const int vs = slot & 3, h = pair & 7, b = pair >> 3;
    const int ti = wid >> 1, tv = wid & 1;
    const bf16_t* UTb = (const bf16_t*)(A.ws + WS_UT); const bf16_t* WNb = (const bf16_t*)(A.ws + WS_WN);
    const bf16_t* QDb = (const bf16_t*)(A.ws + WS_QD); const bf16_t* KDTb = (const bf16_t*)(A.ws + WS_KDT);
    const bf16_t* QKb = (const bf16_t*)(A.ws + WS_QK); const float* EGL = (const float*)(A.ws + WS_EGL);
    float* O = (float*)(A.ws + WS_O);
    for (int e = tid; e < 8704 / 4; e += 512) ((LAS unsigned*)(lds + GS_SB0))[e] = 0u;
    f32x4 sacc[2]; sacc[0] = (f32x4){0.f, 0.f, 0.f, 0.f}; sacc[1] = sacc[0];
    __syncthreads();
    const int chunk0 = (b * 8 + h) * 32;
    bf16x8 nfw0[4], nfqd0[4], nfqk0[2], nfkd0[2]; u32x2 nuu0; float ndecay0;
    bf16x8 nfw1[4], nfqd1[4], nfqk1[2], nfkd1[2]; u32x2 nuu1; float ndecay1;
#define GS_LOAD(S, ch) { const size_t _c = (size_t)(ch); \
        _Pragma("unroll") for (int kk = 0; kk < 4; ++kk) { nfw##S[kk] = *(const bf16x8*)(WNb + _c * 8192 + (ti * 16 + fr) * 128 + kk * 32 + fq * 8); nfqd##S[kk] = *(const bf16x8*)(QDb + _c * 8192 + (ti * 16 + fr) * 128 + kk * 32 + fq * 8); } \
        _Pragma("unroll") for (int kk = 0; kk < 2; ++kk) { nfqk##S[kk] = *(const bf16x8*)(QKb + _c * 4096 + (ti * 16 + fr) * 64 + kk * 32 + fq * 8); nfkd##S[kk] = *(const bf16x8*)(KDTb + _c * 8192 + (wid * 16 + fr) * 64 + kk * 32 + fq * 8); } \
        nuu##S = *(const u32x2*)(UTb + _c * 8192 + (vs * 32 + tv * 16 + fr) * 64 + ti * 16 + fq * 4); ndecay##S = EGL[_c]; }
#define GS_STEP(S, nn, SBC, SBN, DOLOAD) { \
        bf16x8 fw[4], fqd[4], fqk[2], fkd[2]; \
        _Pragma("unroll") for (int kk = 0; kk < 4; ++kk) { fw[kk] = nfw##S[kk]; fqd[kk] = nfqd##S[kk]; } \
        _Pragma("unroll") for (int kk = 0; kk < 2; ++kk) { fqk[kk] = nfqk##S[kk]; fkd[kk] = nfkd##S[kk]; } \
        const u32x2 uu = nuu##S; const float decay = ndecay##S; \
        if (DOLOAD) { GS_LOAD(S, chunk0 + (nn) + 2) } \
        f32x4 acc = (f32x4){lo_f(uu.x), hi_f(uu.x), lo_f(uu.y), hi_f(uu.y)}; \
        bf16x8 fs[4]; \
        _Pragma("unroll") for (int kk = 0; kk < 4; ++kk) { fs[kk] = *(const LAS bf16x8*)(lds + (SBC) + ((tv * 16 + fr) * 136 + kk * 32 + fq * 8) * 2); acc = mfma16(fw[kk], fs[kk], acc); } \
        *(LAS u32x2*)(lds + GS_VN + ((tv * 16 + fr) * 72 + ti * 16 + fq * 4) * 2) = pack4(acc); \
        lds_barrier(); \
        f32x4 ao = (f32x4){0.f, 0.f, 0.f, 0.f}; \
        _Pragma("unroll") for (int kk = 0; kk < 4; ++kk) ao = mfma16(fs[kk], fqd[kk], ao); \
        bf16x8 fv[2][2]; \
        _Pragma("unroll") for (int t2 = 0; t2 < 2; ++t2) _Pragma("unroll") for (int kk = 0; kk < 2; ++kk) fv[t2][kk] = *(const LAS bf16x8*)(lds + GS_VN + ((t2 * 16 + fr) * 72 + kk * 32 + fq * 8) * 2); \
        _Pragma("unroll") for (int kk = 0; kk < 2; ++kk) { const bf16x8 fvo = *(const LAS bf16x8*)(lds + GS_VN + ((tv * 16 + fr) * 72 + kk * 32 + fq * 8) * 2); ao = mfma16(fvo, fqk[kk], ao); } \
        *(f32x4*)(O + ((size_t)b * SL + (nn) * 64 + ti * 16 + fr) * 1024 + h * 128 + vs * 32 + tv * 16 + fq * 4) = ao; \
        _Pragma("unroll") for (int t2 = 0; t2 < 2; ++t2) { sacc[t2] = sacc[t2] * decay; \
            _Pragma("unroll") for (int kk = 0; kk < 2; ++kk) sacc[t2] = mfma16(fkd[kk], fv[t2][kk], sacc[t2]); \
            *(LAS u32x2*)(lds + (SBN) + ((t2 * 16 + fr) * 136 + wid * 16 + fq * 4) * 2) = pack4(sacc[t2]); } \
        lds_barrier(); }
    GS_LOAD(0, chunk0) GS_LOAD(1, chunk0 + 1)
    for (int n = 0; n < 32; n += 8) {
        __builtin_amdgcn_s_waitcnt(0x0F70);
        GS_STEP(0, n, GS_SB0, GS_SB1, 1) GS_STEP(1, n + 1, GS_SB1, GS_SB0, 1) GS_STEP(0, n + 2, GS_SB0, GS_SB1, 1) GS_STEP(1, n + 3, GS_SB1, GS_SB0, 1)
        GS_STEP(0, n + 4, GS_SB0, GS_SB1, 1) GS_STEP(1, n + 5, GS_SB1, GS_SB0, 1) GS_STEP(0, n + 6, GS_SB0, GS_SB1, (n + 8 < 32)) GS_STEP(1, n + 7, GS_SB1, GS_SB0, (n + 9 < 32))
    }
#undef GS_STEP
#undef GS_LOAD
    float* So = A.out + O_GSP + (size_t)(b * 8 + h) * 16384;
#pragma unroll
    for (int t2 = 0; t2 < 2; ++t2)
#pragma unroll
        for (int r = 0; r < 4; ++r) So[(wid * 16 + fq * 4 + r) * 128 + vs * 32 + t2 * 16 + fr] = sacc[t2][r];
    __syncthreads();
}

__device__ __forceinline__ void gdn_gate_row(const Args& A, size_t row, int lane) {
    const float* O = (const float*)(A.ws + WS_O) + row * 1024 + lane * 16;
    const bf16_t* Z = (const bf16_t*)(A.ws + WS_PROJ) + row * 4096 + 3072 + lane * 16;
    bf16_t* Y = (bf16_t*)(A.ws + WS_YB) + row * 1024 + lane * 16;
    const float* nw = A.in[12] + (lane & 7) * 16;
    float o[16]; float ss = 0.f;
#pragma unroll
    for (int i = 0; i < 4; ++i) { const f32x4 v = ((const f32x4*)O)[i]; o[4 * i] = v[0]; o[4 * i + 1] = v[1]; o[4 * i + 2] = v[2]; o[4 * i + 3] = v[3]; ss += (v[0] * v[0] + v[1] * v[1]) + (v[2] * v[2] + v[3] * v[3]); }
    ss += __shfl_xor(ss, 1); ss += __shfl_xor(ss, 2); ss += __shfl_xor(ss, 4);
    const float rstd = __builtin_amdgcn_rsqf(ss * (1.f / 128.f) + RMS_EPS);
    float z[16]; { float t[8]; unpack8(((const u32x4*)Z)[0], t);
#pragma unroll
        for (int j = 0; j < 8; ++j) z[j] = t[j];
        unpack8(((const u32x4*)Z)[1], t);
#pragma unroll
        for (int j = 0; j < 8; ++j) z[8 + j] = t[j]; }
    float r[8];
#pragma unroll
    for (int hh = 0; hh < 2; ++hh) {
#pragma unroll
        for (int j = 0; j < 8; ++j) r[j] = o[hh * 8 + j] * rstd * nw[hh * 8 + j] * silu_f(z[hh * 8 + j]);
        ((u32x4*)Y)[hh] = pack8(r);
    }
}

__device__ __forceinline__ void ssd_conv_item(const Args& A, int item, int tid_in) {
    const int t = tid_in; if (t >= 384) return;
    const int c0 = t * 8, r0 = item * 16, tb = r0 & (SL - 1), b = r0 >> 11;
    const bf16_t* P = (const bf16_t*)(A.ws + WS_PROJ);
    bf16_t* XA = (bf16_t*)(A.ws + WS_XA); bf16_t* BCA = (bf16_t*)(A.ws + WS_BCA);
    u32x4 xq[19];
#pragma unroll
    for (int r = 0; r < 19; ++r) xq[r] = (tb == 0 && r < 3) ? (u32x4){0u, 0u, 0u, 0u} : *(const u32x4*)(P + (size_t)(r0 + r - 3) * 5120 + 2048 + c0);
    float w[4][8], bb[8];
#pragma unroll
    for (int j = 0; j < 8; ++j) { bb[j] = A.in[16][c0 + j];
#pragma unroll
        for (int k = 0; k < 4; ++k) w[k][j] = A.in[15][k * 3072 + c0 + j]; }
    float p3[8], p2[8], p1[8];
    unpack8(xq[0], p3); unpack8(xq[1], p2); unpack8(xq[2], p1);
#pragma unroll
    for (int r = 0; r < 16; ++r) {
        const size_t row = (size_t)(r0 + r);
        float cur[8], o[8];
        unpack8(xq[r + 3], cur);
#pragma unroll
        for (int j = 0; j < 8; ++j) o[j] = silu_f(bb[j] + w[0][j] * p3[j] + w[1][j] * p2[j] + w[2][j] * p1[j] + w[3][j] * cur[j]);
        if (c0 < 2048) *(u32x4*)(XA + row * 2048 + c0) = pack8(o); else *(u32x4*)(BCA + row * 1024 + (c0 - 2048)) = pack8(o);
        const int tt = tb + r;
        if (tt >= SL - 3) { float* cp = A.out + O_SCP + ((size_t)b * 3 + (tt - (SL - 3))) * 3072 + c0;
#pragma unroll
            for (int j = 0; j < 8; ++j) cp[j] = cur[j]; }
#pragma unroll
        for (int j = 0; j < 8; ++j) { p3[j] = p2[j]; p2[j] = p1[j]; p1[j] = cur[j]; }
    }
}

__device__ __forceinline__ void ssd_dec_item(LAS unsigned char* lds, const Args& A, int item, int tid_in) {
    const int tid = tid_in, wid = tid >> 6, lane = tid & 63;
    const int g = item & 3, b = item >> 2;
    const bf16_t* Pd = (const bf16_t*)(A.ws + WS_PROJD) + (size_t)b * NUP; const float* BAd = (const float*)(A.ws + WS_BAD) + b * 32;
    bf16_t* YBd = (bf16_t*)(A.ws + WS_YBD) + (size_t)b * DFF;
    LAS float* xs = (LAS float*)lds; LAS float* Bs = xs + 512; LAS float* Cs = xs + 640; LAS float* ys = xs + 768; LAS float* dts = xs + 1280; LAS float* dAs = xs + 1288; LAS float* red = xs + 1296;
    for (int c = tid; c < 768; c += 512) {
        const int xc = (c < 512) ? (g * 512 + c) : (c < 640) ? (2048 + g * 128 + (c - 512)) : (2560 + g * 128 + (c - 640));
        const float* cin = A.in[(4)] + (size_t)b * 3 * 3072 + xc;
        const float c0 = cin[0], c1 = cin[3072], c2 = cin[6144], nw = bf2f(Pd[2048 + xc]);
        const float* cw = A.in[(15)] + xc;
        xs[c] = silu_f(A.in[(16)][xc] + cw[0] * c0 + cw[3072] * c1 + cw[6144] * c2 + cw[9216] * nw);
        float* co = A.out + O_SCS + (size_t)b * 3 * 3072 + xc; co[0] = c1; co[3072] = c2; co[6144] = nw;
    }
    if (tid < 8) { const int h = g * 8 + tid; const float dt = softplus_f(BAd[h] + A.in[(18)][h]); dts[tid] = dt; dAs[tid] = __expf(-__expf(A.in[(17)][h]) * dt); }
    __syncthreads();
    const int sl = tid & 31, pr = tid >> 5;
    const f32x4 B4 = *(const LAS f32x4*)(Bs + sl * 4), C4 = *(const LAS f32x4*)(Cs + sl * 4);
    const float* Sin0 = A.in[(5)] + ((size_t)(b * 32 + g * 8) * 64) * 128 + sl * 4;
    float* Sout0 = A.out + O_SSS + ((size_t)(b * 32 + g * 8) * 64) * 128 + sl * 4;
    f32x4 Snx[4];
#pragma unroll
    for (int it = 0; it < 4; ++it) Snx[it] = __builtin_nontemporal_load((const f32x4*)(Sin0 + (it * 16 + pr) * 128));
#pragma unroll
    for (int j = 0; j < 8; ++j) {
        const float dt = dts[j], dA = dAs[j];
        f32x4 S[4];
#pragma unroll
        for (int it = 0; it < 4; ++it) S[it] = Snx[it];
        if (j + 1 < 8) {
#pragma unroll
            for (int it = 0; it < 4; ++it) Snx[it] = __builtin_nontemporal_load((const f32x4*)(Sin0 + (size_t)(j + 1) * 8192 + (it * 16 + pr) * 128));
        }
#pragma unroll
        for (int it = 0; it < 4; ++it) { const int p = it * 16 + pr; const float xd = xs[j * 64 + p] * dt;
            const f32x4 Sn = S[it] * dA + B4 * xd; __builtin_nontemporal_store(Sn, (f32x4*)(Sout0 + (size_t)j * 8192 + p * 128));
            float y = (Sn[0] * C4[0] + Sn[1] * C4[1]) + (Sn[2] * C4[2] + Sn[3] * C4[3]);
            y += DPP_F(y, 0xB1, 0xf); y += DPP_F(y, 0x4E, 0xf); y += DPP_F(y, 0x141, 0xf); y += DPP_F(y, 0x140, 0xf); y += DPP_F(y, 0x142, 0xa);
            if (sl == 31) ys[j * 64 + p] = y; }
    }
    __syncthreads();
    {
        const int c = tid, h = g * 8 + (c >> 6);
        const float y = (ys[c] + A.in[(19)][h] * xs[c]) * silu_f(bf2f(Pd[g * 512 + c]));
        const float s = wave_sum(y * y); if (lane == 0) red[wid] = s;
        __syncthreads();
        float tot = 0.f;
#pragma unroll
        for (int w = 0; w < 8; ++w) tot += red[w];
        const float r = y * __builtin_amdgcn_rsqf(tot * (1.f / 512.f) + RMS_EPS) * A.in[(20)][g * 512 + c];
        YBd[g * 512 + c] = (bf16_t)(pack2(r, 0.f) & 0xffffu);
    }
    __syncthreads();
}

constexpr int SS_XT = 0, SS_XDT = 9216, SS_BT = 18432, SS_SC = 36864, SS_SB0 = 46080, SS_SB1 = 63488, SS_BS = 80896, SS_CS = 98304, SS_AC = 115712, SS_DT = 115968, SS_ACALL = 133120, SS_DTALL = 141312;
__device__ __forceinline__ void ssd_step(LAS unsigned char* lds, bf16_t* __restrict__ Y, const size_t t0, const int h, const int sbc, const int sbn,
                                         const u32x4 px, const u32x4 pb0, const u32x4 pb1, const u32x4 pc0, const u32x4 pc1, const int nchunk,
                                         const float Dh, f32x4 (&sacc)[4], const int tid) {
    const int wid = tid >> 6, lane = tid & 63, fr = lane & 15, fq = lane >> 4, ti = wid >> 1;
    const int jx = tid >> 3, xm = tid & 7, jb0 = tid >> 4, jb1 = 32 + (tid >> 4), bm = tid & 15;
    LAS float* acum = (LAS float*)(lds + SS_ACALL) + nchunk * 64; LAS float* dtv = (LAS float*)(lds + SS_DTALL) + nchunk * 64;
        *(LAS u32x4*)(lds + SS_BS + (jb0 * 136 + bm * 8) * 2) = pb0; *(LAS u32x4*)(lds + SS_BS + (jb1 * 136 + bm * 8) * 2) = pb1;
        *(LAS u32x4*)(lds + SS_CS + (jb0 * 136 + bm * 8) * 2) = pc0; *(LAS u32x4*)(lds + SS_CS + (jb1 * 136 + bm * 8) * 2) = pc1;
        lds_barrier();
        const float alast = acum[63];
        {
            const float sx = dtv[jx] * __expf(alast - acum[jx]);
            const int colx = (((jx >> 3) ^ xm) * 8 + (jx & 7)) * 2;
            const unsigned wx[4] = {px.x, px.y, px.z, px.w};
#pragma unroll
            for (int q = 0; q < 8; ++q) { const unsigned w = wx[q >> 1]; const unsigned short raw = (q & 1) ? (unsigned short)(w >> 16) : (unsigned short)(w & 0xffffu);
                const float xv = bf2f(raw); const int rowb = (xm * 8 + q) * 144;
                *(LAS unsigned short*)(lds + SS_XT + rowb + colx) = raw;
                *(LAS unsigned short*)(lds + SS_XDT + rowb + colx) = (unsigned short)(pack2(xv * sx, 0.f) & 0xffffu); }
            const int colb0 = (((jb0 >> 3) ^ (bm & 7)) * 8 + (jb0 & 7)) * 2, colb1 = (((jb1 >> 3) ^ (bm & 7)) * 8 + (jb1 & 7)) * 2;
            const unsigned wb0[4] = {pb0.x, pb0.y, pb0.z, pb0.w}, wb1[4] = {pb1.x, pb1.y, pb1.z, pb1.w};
#pragma unroll
            for (int q = 0; q < 8; ++q) { const int rowb = (bm * 8 + q) * 144;
                *(LAS unsigned short*)(lds + SS_BT + rowb + colb0) = (q & 1) ? (unsigned short)(wb0[q >> 1] >> 16) : (unsigned short)(wb0[q >> 1] & 0xffffu);
                *(LAS unsigned short*)(lds + SS_BT + rowb + colb1) = (q & 1) ? (unsigned short)(wb1[q >> 1] >> 16) : (unsigned short)(wb1[q >> 1] & 0xffffu); }
        }
        bf16x8 fc[4];
#pragma unroll
        for (int kk = 0; kk < 4; ++kk) fc[kk] = *(const LAS bf16x8*)(lds + SS_CS + ((ti * 16 + fr) * 136 + kk * 32 + fq * 8) * 2);
#pragma unroll
        for (int tjj = 0; tjj < 2; ++tjj) {
            const int tj = (wid & 1) * 2 + tjj;
            f32x4 acc = (f32x4){0.f, 0.f, 0.f, 0.f};
            if (tj <= ti) {
#pragma unroll
                for (int kk = 0; kk < 4; ++kk) { const bf16x8 fb = *(const LAS bf16x8*)(lds + SS_BS + ((tj * 16 + fr) * 136 + kk * 32 + fq * 8) * 2); acc = mfma16(fb, fc[kk], acc); }
            }
            const int i = ti * 16 + fr; const float ai = acum[i]; f32x4 sc;
#pragma unroll
            for (int r = 0; r < 4; ++r) { const int j = tj * 16 + fq * 4 + r; sc[r] = (i >= j) ? acc[r] * __expf(ai - acum[j]) * dtv[j] : 0.f; }
            *(LAS u32x2*)(lds + SS_SC + (i * 72 + tj * 16 + fq * 4) * 2) = pack4(sc);
        }
        lds_barrier();
        {
            bf16x8 fsc[2];
#pragma unroll
            for (int kk = 0; kk < 2; ++kk) fsc[kk] = *(const LAS bf16x8*)(lds + SS_SC + ((ti * 16 + fr) * 72 + kk * 32 + fq * 8) * 2);
            const int i = ti * 16 + fr; const float ea = __expf(acum[i]);
#pragma unroll
            for (int tpp = 0; tpp < 2; ++tpp) {
                const int tp = (wid & 1) * 2 + tpp, prow = tp * 16 + fr, psw = (prow >> 3) & 7;
                f32x4 a1 = (f32x4){0.f, 0.f, 0.f, 0.f}, a2 = (f32x4){0.f, 0.f, 0.f, 0.f};
#pragma unroll
                for (int kk = 0; kk < 2; ++kk) { const bf16x8 fx = *(const LAS bf16x8*)(lds + SS_XT + (prow * 72 + (((kk * 4 + fq) ^ psw) * 8)) * 2); a1 = mfma16(fx, fsc[kk], a1); }
#pragma unroll
                for (int kk = 0; kk < 4; ++kk) { const bf16x8 fs = *(const LAS bf16x8*)(lds + sbc + (prow * 136 + kk * 32 + fq * 8) * 2); a2 = mfma16(fs, fc[kk], a2); }
                const int p0 = tp * 16 + fq * 4;
                const int xcol = (((i >> 3) ^ ((p0 >> 3) & 7)) * 8 + (i & 7)) * 2;
                f32x4 y = a1 + a2 * ea;
#pragma unroll
                for (int r = 0; r < 4; ++r) y[r] += Dh * bf2f(*(const LAS unsigned short*)(lds + SS_XT + (p0 + r) * 144 + xcol));
                *(u32x2*)(Y + (t0 + i) * 2048 + h * 64 + p0) = pack4(y);
            }
        }
        {
            const int tp = wid >> 1, prow = tp * 16 + fr, psw = (prow >> 3) & 7; const float el = __expf(alast);
            bf16x8 fxd[2];
#pragma unroll
            for (int kk = 0; kk < 2; ++kk) fxd[kk] = *(const LAS bf16x8*)(lds + SS_XDT + (prow * 72 + (((kk * 4 + fq) ^ psw) * 8)) * 2);
#pragma unroll
            for (int q = 0; q < 4; ++q) { const int ts = (wid & 1) * 4 + q, srow = ts * 16 + fr, ssw = (srow >> 3) & 7; sacc[q] = sacc[q] * el;
#pragma unroll
                for (int kk = 0; kk < 2; ++kk) { const bf16x8 fb = *(const LAS bf16x8*)(lds + SS_BT + (srow * 72 + (((kk * 4 + fq) ^ ssw) * 8)) * 2); sacc[q] = mfma16(fb, fxd[kk], sacc[q]); }
                *(LAS u32x2*)(lds + sbn + (prow * 136 + ts * 16 + fq * 4) * 2) = pack4(sacc[q]); }
        }
        lds_barrier();
}

__device__ __forceinline__ void ssd_scan_item(LAS unsigned char* lds, const Args& A, int item, int tid_in) {
    const int tid = tid_in, wid = tid >> 6, lane = tid & 63, fr = lane & 15, fq = lane >> 4;
    const int xcd = item & 7, slot = item >> 3, grp = xcd * 4 + (slot >> 3);
    const int b = grp >> 2, g = grp & 3, h = g * 8 + (slot & 7);
    const bf16_t* XA = (const bf16_t*)(A.ws + WS_XA); const bf16_t* BCA = (const bf16_t*)(A.ws + WS_BCA); const float* BA = (const float*)(A.ws + WS_BA);
    bf16_t* Y = (bf16_t*)(A.ws + WS_YB);
    LAS float* acum = (LAS float*)(lds + SS_AC); LAS float* dtv = (LAS float*)(lds + SS_DT);
    const float aneg = -__expf(A.in[17][h]), dtb = A.in[18][h], Dh = A.in[19][h];
    for (int e = tid; e < 17408 / 4; e += 512) ((LAS unsigned*)(lds + SS_SB0))[e] = 0u;
    f32x4 sacc[4];
#pragma unroll
    for (int q = 0; q < 4; ++q) sacc[q] = (f32x4){0.f, 0.f, 0.f, 0.f};
    int cur = 0;
    const int ti = wid >> 1;
    const int jx = tid >> 3, xm = tid & 7;
    const int jb0 = tid >> 4, jb1 = 32 + (tid >> 4), bm = tid & 15;
    u32x4 npx0, npb00, npb10, npc00, npc10;
    u32x4 npx1, npb01, npb11, npc01, npc11;
#define SS_LOAD(S, nn) { const size_t _t0 = (size_t)b * SL + (nn) * 64; \
        npx##S = *(const u32x4*)(XA + (_t0 + jx) * 2048 + h * 64 + xm * 8); \
        npb0##S = *(const u32x4*)(BCA + (_t0 + jb0) * 1024 + g * 128 + bm * 8); npb1##S = *(const u32x4*)(BCA + (_t0 + jb1) * 1024 + g * 128 + bm * 8); \
        npc0##S = *(const u32x4*)(BCA + (_t0 + jb0) * 1024 + 512 + g * 128 + bm * 8); npc1##S = *(const u32x4*)(BCA + (_t0 + jb1) * 1024 + 512 + g * 128 + bm * 8); \
        }
#define SS_STEP(S, nn, DOLOAD) { \
        const size_t t0 = (size_t)b * SL + (nn) * 64; \
        const int sbc = cur ? SS_SB1 : SS_SB0, sbn = cur ? SS_SB0 : SS_SB1; \
        const u32x4 px = npx##S, pb0 = npb0##S, pb1 = npb1##S, pc0 = npc0##S, pc1 = npc1##S; \
        if (DOLOAD) { SS_LOAD(S, (nn) + 2) } \
        ssd_step(lds, Y, t0, h, sbc, sbn, px, pb0, pb1, pc0, pc1, (nn), Dh, sacc, tid); \
        cur ^= 1; }
    for (int cch = wid; cch < 32; cch += 8) { const float dt = softplus_f(BA[((size_t)b * SL + cch * 64 + lane) * 32 + h] + dtb); const float ac = wave_incl_scan(dt * aneg, lane);
        ((LAS float*)(lds + SS_ACALL))[cch * 64 + lane] = ac; ((LAS float*)(lds + SS_DTALL))[cch * 64 + lane] = dt; }
    SS_LOAD(0, 0) SS_LOAD(1, 1)
    __syncthreads();
    for (int n = 0; n < 28; n += 4) {
        __builtin_amdgcn_s_waitcnt(0x0F70);
        SS_STEP(0, n, 1) SS_STEP(1, n + 1, 1) SS_STEP(0, n + 2, 1) SS_STEP(1, n + 3, 1)
    }
    __builtin_amdgcn_s_waitcnt(0x0F70);
    SS_STEP(0, 28, 1) SS_STEP(1, 29, 1) SS_STEP(0, 30, 0) SS_STEP(1, 31, 0)
#undef SS_STEP
#undef SS_LOAD
    {
        const int tp = wid >> 1; float* So = A.out + O_SSP + (size_t)(b * 32 + h) * 8192;
#pragma unroll
        for (int q = 0; q < 4; ++q) { const int ts = (wid & 1) * 4 + q; *(f32x4*)(So + (tp * 16 + fr) * 128 + ts * 16 + fq * 4) = sacc[q]; }
    }
    __syncthreads();
}

__device__ __forceinline__ void ssd_gate_row(const Args& A, size_t row, int lane) {
    bf16_t* Y = (bf16_t*)(A.ws + WS_YB) + row * 2048; const bf16_t* Z = (const bf16_t*)(A.ws + WS_PROJ) + row * 5120;
    u32x4 yq[4], zq[4];
#pragma unroll
    for (int g = 0; g < 4; ++g) { yq[g] = *(const u32x4*)(Y + g * 512 + lane * 8); zq[g] = *(const u32x4*)(Z + g * 512 + lane * 8); }
#pragma unroll
    for (int g = 0; g < 4; ++g) {
        const int c0 = g * 512 + lane * 8; float y[8], z[8];
        unpack8(yq[g], y); unpack8(zq[g], z);
        float ss = 0.f;
#pragma unroll
        for (int j = 0; j < 8; ++j) { y[j] *= silu_f(z[j]); ss += y[j] * y[j]; }
        const float rstd = __builtin_amdgcn_rsqf(wave_sum(ss) * (1.f / 512.f) + RMS_EPS);
        const float* nw = A.in[20] + c0;
#pragma unroll
        for (int j = 0; j < 8; ++j) y[j] = y[j] * rstd * nw[j];
        *(u32x4*)(Y + c0) = pack8(y);
    }
}


__constant__ int P0_BASE[8] = {0, 544, 672, 1344, 1600, 2304, 3008, 3360};
__constant__ int P0_IN[8] = {7, 13, 14, 21, 22, 22, 25, 25};
__constant__ unsigned P0_INOFF[8] = {0, 0, 0, 0, 0, 1024u * 5632u, 0, 2816u * 1024u};
__constant__ unsigned P0_WOFS[8] = {(unsigned)WS_WGI, (unsigned)WS_WGO, (unsigned)WS_WSI, (unsigned)WS_WSO, (unsigned)WS_WUP0, (unsigned)WS_WUP1, (unsigned)WS_WDN0, (unsigned)WS_WDN1};
__constant__ int P0_K[8] = {1024, 1024, 1024, 2048, 1024, 1024, 2816, 2816};
__constant__ int P0_N[8] = {4112, 1024, 5152, 1024, 5632, 5632, 1024, 1024};

#define XB_TMO      128
#define XB_XCNT(j)  (256  + 64 * (j))
#define XB_XSUB(j)  (1280 + 64 * (j))
#define XB_XGEN(j)  (2304 + 64 * (j))
#define XB_TOP      3328
#define XB_TOPGEN   3392
#define XCD_BAR_WORDS 3456
#define XB_SPIN_CAP (1u << 18)
__device__ __forceinline__ unsigned xb_ld(unsigned* p)              { return __hip_atomic_load(p, __ATOMIC_RELAXED, __HIP_MEMORY_SCOPE_AGENT); }
__device__ __forceinline__ unsigned xb_add(unsigned* p, unsigned v) { return __hip_atomic_fetch_add(p, v, __ATOMIC_RELAXED, __HIP_MEMORY_SCOPE_AGENT); }
__device__ __forceinline__ unsigned xb_xcc_id() { return (unsigned)__builtin_amdgcn_s_getreg((3 << 11) | 20) & 0xFu; }
#define XB_SPIN(cond, bar) do { unsigned _sp = 0; while (cond) { __builtin_amdgcn_s_sleep(1); \
    if ((++_sp & 255u) == 0u) { if (xb_ld(&(bar)[XB_TMO])) break; if (_sp > XB_SPIN_CAP) { atomicAdd(&(bar)[XB_TMO], 1u); break; } } } } while (0)
struct XcdBarrier { unsigned* bar; unsigned x; volatile LAS unsigned* st; };
__device__ __forceinline__ XcdBarrier xcd_barrier_post(unsigned* bar, volatile LAS unsigned* st) {
    XcdBarrier b; b.bar = bar; b.x = xb_xcc_id(); b.st = st;
    if (threadIdx.x == 0) (void)xb_add(&bar[XB_XCNT(b.x)], 1u);
    return b;
}
__device__ __forceinline__ void xcd_barrier_complete(unsigned* bar, unsigned x, unsigned& nloc, unsigned& nx) {
    const unsigned G = gridDim.x * gridDim.y * gridDim.z;
    unsigned sum, cnt, mine, sp = 0u;
    for (;;) {
        sum = 0u; cnt = 0u; mine = 0u;
#pragma unroll
        for (unsigned j = 0; j < 16; ++j) { const unsigned c = xb_ld(&bar[XB_XCNT(j)]); sum += c; cnt += (c > 0u) ? 1u : 0u; mine = (j == x) ? c : mine; }
        if (sum == G) break;
        __builtin_amdgcn_s_sleep(1);
        if ((++sp & 255u) == 0u) { if (xb_ld(&bar[XB_TMO])) break; if (sp > XB_SPIN_CAP) { atomicAdd(&bar[XB_TMO], 1u); break; } }
    }
    nloc = mine > 0u ? mine : 1u; nx = cnt > 0u ? cnt : 1u;
}
__device__ __forceinline__ void xcd_barrier(const XcdBarrier& b, int tid) {
    asm volatile("s_waitcnt vmcnt(0)" ::: "memory");
    __syncthreads();
    if (tid == 0) {
        unsigned* bar = b.bar;
        __builtin_amdgcn_s_waitcnt(0);
        unsigned nloc = b.st[0], nx = b.st[1];
        if (nloc == 0u) { xcd_barrier_complete(bar, b.x, nloc, nx); b.st[0] = nloc; b.st[1] = nx; }
        const unsigned old = xb_add(&bar[XB_XSUB(b.x)], 1u);
        const unsigned gen = old / nloc;
        if (old + 1u == (gen + 1u) * nloc) {
            __builtin_amdgcn_fence(__ATOMIC_RELEASE, "agent");
            asm volatile("s_waitcnt vmcnt(0)" ::: "memory");
            const unsigned og = xb_add(&bar[XB_TOP], 1u);
            const unsigned tg = og / nx;
            if (og + 1u == (tg + 1u) * nx) xb_add(&bar[XB_TOPGEN], 1u);
            else XB_SPIN(xb_ld(&bar[XB_TOPGEN]) == tg, bar);
            __builtin_amdgcn_fence(__ATOMIC_ACQUIRE, "agent");
            xb_add(&bar[XB_XGEN(b.x)], 1u);
            asm volatile("s_waitcnt vmcnt(0)" ::: "memory");
        } else {
            XB_SPIN(xb_ld(&bar[XB_XGEN(b.x)]) == gen, bar);
            __builtin_amdgcn_fence(__ATOMIC_ACQUIRE, "agent");
            asm volatile("s_waitcnt vmcnt(0)" ::: "memory");
        }
    }
    __syncthreads();
}

#ifndef PHMASK
#define PHMASK 0xffffff
#endif
#define EN(k) ((PHMASK >> (k)) & 1)
constexpr int NPHASE = 21;
__global__ void __launch_bounds__(512, 2) fwd_kernel(Args A) {
    __shared__ __attribute__((aligned(16))) unsigned char lds_raw[LDS_BYTES];
    LAS unsigned char* lds = (LAS unsigned char*)lds_raw;
    const int wave_s = __builtin_amdgcn_readfirstlane((int)threadIdx.x >> 6);
#define TID make_tid(wave_s)
    if (threadIdx.x < 4) ((LAS unsigned*)(lds + 131072))[threadIdx.x] = 0u;
    __syncthreads();
    (void)xcd_barrier_post((unsigned*)(A.ws + WS_BARR), (volatile LAS unsigned*)(lds + 131072));
    if (A.ph_hi > NPHASE) cg::this_grid().sync();
#ifndef REPMASK
#define REPMASK 0
#endif
    const int ph_end = __builtin_amdgcn_readfirstlane(A.ph_hi);
    int rep_done = 0;
    for (int ph = __builtin_amdgcn_readfirstlane(A.ph_lo); ph < ph_end; ) {
        {
        int G = gridDim.x, bid = blockIdx.x; asm volatile("" : "+s"(G), "+s"(bid));
        unsigned long long zoff = 0; asm volatile("" : "+s"(zoff));
        unsigned char* ws = A.ws + zoff;
        const bool is_gemm = (ph == 1) | (ph == 5) | (ph == 7) | (ph == 9) | (ph == 11) | (ph == 15) | (ph == 17) | (ph == 19);
        const bool is_ln = (ph == 6) | (ph == 10) | (ph == 16) | (ph == 20);
        if (EN(1) && is_gemm) {
            const bf16_t* Ap = (const bf16_t*)(ws + WS_XB); const bf16_t* Ad = (const bf16_t*)(ws + WS_XBD); int ldad = 1024;
            size_t wofs = WS_WGI, oofs = WS_PROJ, dofs = WS_PROJD; int N = 4096, K = 1024, ldo = 4096, nbf = 4096, nf = 16, ncg = 65, ldp = NUP;
            if (ph == 5) { Ap = (const bf16_t*)(ws + WS_YB); Ad = (const bf16_t*)(ws + WS_YBD); ldad = DFF; wofs = WS_WGO; N = 1024; K = 1024; }
            else if (ph == 7 || ph == 17) { wofs = (ph == 7) ? WS_WUP0 : WS_WUP1; N = NUP; K = 1024; ldo = NUP; nbf = NUP; nf = 0; ncg = 88; }
            else if (ph == 9 || ph == 19) { Ap = (const bf16_t*)(ws + WS_YB); Ad = (const bf16_t*)(ws + WS_YBD); ldad = DFF; wofs = (ph == 9) ? WS_WDN0 : WS_WDN1; N = 1024; K = DFF; }
            else if (ph == 11) { wofs = WS_WSI; N = 5120; K = 1024; ldo = 5120; nbf = 5120; nf = 32; ncg = 81; }
            else if (ph == 15) { Ap = (const bf16_t*)(ws + WS_YB); Ad = (const bf16_t*)(ws + WS_YBD); ldad = DFF; wofs = WS_WSO; N = 1024; K = 2048; }
            if (N == 1024) { oofs = WS_H; dofs = WS_HD; ldo = 1024; nbf = 1024; nf = 0; ncg = 16; ldp = 1024; }
            const bf16_t* Bt = (const bf16_t*)(ws + wofs);
            pg8::Gemm g{Ap, Bt, MP, N, K}; pg8::StaticOrder S; S.init(MP, N, G, bid);
            const bool gated = (ph == 7) | (ph == 17); const int lyr = (ph == 17);
            if (gated) oofs = WS_YB;
            pg8::EpiUni E{gated ? 2 : 1, (bf16_t*)(ws + oofs), ldo,
                          A.in[23] + (size_t)lyr * 3 * DFF, A.in[24] + (size_t)lyr * DFF, (float*)(ws + WS_XF), A.out + O_FCP + (size_t)lyr * 8 * 2 * DFF};
            pg8::gemm_phase(lds, g, S, E, TID);
            DecStore st{ldp, nbf, nf, (bf16_t*)(ws + dofs), (float*)(ws + WS_BAD)};
            {
                const int rxt = S.nwg % G, nfree = G - rxt;
                if (bid >= rxt) for (int it = bid - rxt; it < 8 * ncg; it += nfree) small_gemm_item(lds, Ad, ldad, Bt, K, it, st, TID);
            }
            if (ph == 1) { for (int it = bid; it < MP / 128; it += G) narrow_item<1>(Ap, Bt + (size_t)4096 * 1024, 1024, (float*)(ws + WS_BA), it, TID); }
            if (ph == 11) { for (int it = bid; it < MP / 128; it += G) narrow_item<2>(Ap, Bt + (size_t)5120 * 1024, 1024, (float*)(ws + WS_BA), it, TID); }
        } else if (EN(6) && is_ln) {
            const int tid = TID, wid = tid >> 6, lane = tid & 63; (void)tid;
            const int layer = (ph >= 16); const bool fin = (ph == 20), is2 = (ph == 10) | (ph == 20);
            const float* gam = A.in[is2 ? 28 : 26] + layer * 1024; const float* bet = A.in[is2 ? 29 : 27] + layer * 1024;
            bf16_t* XB = (bf16_t*)(ws + WS_XB); bf16_t* XBd = (bf16_t*)(ws + WS_XBD);
            const bf16_t* H = (const bf16_t*)(ws + WS_H); const bf16_t* Hd = (const bf16_t*)(ws + WS_HD);
            for (int it = bid; it < (MP + DB) / 16; it += G) { const int row = it * 16 + wid * 2;
                if (row < MP) { const size_t o0 = (size_t)row * 1024, o1 = o0 + 1024;
                    ln_row2(XB + o0, H + o0, XB + o1, H + o1, gam, bet, fin ? A.out + O_YP + o0 : (float*)nullptr, fin ? (bf16_t*)nullptr : XB + o0, fin ? A.out + O_YP + o1 : (float*)nullptr, fin ? (bf16_t*)nullptr : XB + o1, lane); }
                else { const size_t o0 = (size_t)(row - MP) * 1024, o1 = o0 + 1024;
                    ln_row2(XBd + o0, Hd + o0, XBd + o1, Hd + o1, gam, bet, fin ? A.out + O_YS + o0 : (float*)nullptr, fin ? (bf16_t*)nullptr : XBd + o0, fin ? A.out + O_YS + o1 : (float*)nullptr, fin ? (bf16_t*)nullptr : XBd + o1, lane); } }
        } else if (EN(0) && ph == 0) {
            const int tid = TID, wid = tid >> 6, lane = tid & 63; (void)tid; (void)wid; (void)lane;
#define P0_DESC(it) \
            int mi = 0; \
            _Pragma("unroll") for (int q = 1; q < 8; ++q) mi += ((it) >= P0_BASE[q]) ? 1 : 0; \
            const float* W = A.in[P0_IN[mi]] + P0_INOFF[mi]; bf16_t* Wt = (bf16_t*)(ws + P0_WOFS[mi]); const int K = P0_K[mi], N = P0_N[mi]; \
            const int idx = (it) - P0_BASE[mi], nk = K / 128, k0 = (idx % nk) * 128, n0 = (idx / nk) * 64; \
            const int ns0 = (mi == 4 || mi == 5) ? (((n0 >> 7) & 1) * DFF + (n0 >> 8) * 128 + (n0 & 127)) : n0;
            for (int it = bid; it < 1032; it += G) {
                if (it < 1024) convert_rows16(A.in[0] + (size_t)it * 16 * 1024, (bf16_t*)(ws + WS_XB) + (size_t)it * 16 * 1024, TID);
                else convert_rows16(A.in[1] + (size_t)(it - 1024) * 16 * 1024, (bf16_t*)(ws + WS_XBD) + (size_t)(it - 1024) * 16 * 1024, TID);
            }
            LAS float* s = (LAS float*)lds;
            float rr[16];
            if (bid < 3712) { P0_DESC(bid)
#pragma unroll
                for (int i = 0; i < 16; ++i) { const int e = i * 512 + tid, kk = e >> 6, nn = e & 63, n = ns0 + nn; rr[i] = (n < N) ? __builtin_nontemporal_load(W + (size_t)(k0 + kk) * N + n) : 0.f; } }
            for (int it = bid; it < 3712; it += G) {
#pragma unroll
                for (int i = 0; i < 16; ++i) { const int e = i * 512 + tid, kk = e >> 6, nn = e & 63; s[nn * 129 + kk] = rr[i]; }
                __syncthreads();
                if (it + G < 3712) { P0_DESC(it + G)
#pragma unroll
                    for (int i = 0; i < 16; ++i) { const int e = i * 512 + tid, kk = e >> 6, nn = e & 63, n = ns0 + nn; rr[i] = (n < N) ? __builtin_nontemporal_load(W + (size_t)(k0 + kk) * N + n) : 0.f; } }
                { P0_DESC(it)
#pragma unroll
                    for (int i = 0; i < 8; ++i) { const int e = i * 512 + tid, nn = e >> 6, kp = e & 63;
                        *(unsigned*)(Wt + (size_t)(n0 + nn) * K + k0 + 2 * kp) = pack2(s[nn * 129 + 2 * kp], s[nn * 129 + 2 * kp + 1]); } }
                __syncthreads();
            }
#undef P0_DESC
        } else if (EN(2) && ph == 2) {
            gdn_a_phase(lds, A, bid, G, TID);
#ifndef NO_DEC
            for (int it = bid; it < 1024; it += G) gdn_dec_item(lds, A, it, TID);
#endif
        } else if (EN(3) && ph == 3) {
            for (int it = bid; it < 256; it += G) gdn_scan_item(lds, A, it, TID);
        } else if (EN(4) && ph == 4) {
            const int tid = TID, wid = tid >> 6, lane = tid & 63; (void)tid; (void)wid; (void)lane;
            for (int it = bid; it < MP / 8; it += G) gdn_gate_row(A, (size_t)it * 8 + wid, lane);
        } else if (EN(8) && (ph == 8 || ph == 18)) {
            const int layer = (ph == 18);
            const float* cw = A.in[23] + (size_t)layer * 3 * DFF; const float* cb = A.in[24] + (size_t)layer * DFF;
            for (int it = bid; it < 256 + 8; it += G) {
                if (it < 256) ffn_fixup_item((const float*)(ws + WS_XF), (const float*)(ws + WS_XF) + (size_t)256 * 2 * DFF, (bf16_t*)(ws + WS_YB), cw, it, TID);
                else ffn_gate_dec_item((const bf16_t*)(ws + WS_PROJD), (bf16_t*)(ws + WS_YBD), cw, cb, A.in[6] + (size_t)layer * 128 * 2 * DFF, A.out + O_FCS + (size_t)layer * 128 * 2 * DFF, it - 256, TID); }
        } else if (EN(12) && ph == 12) {
            for (int it = bid; it < MP / 16; it += G) ssd_conv_item(A, it, TID);
            __syncthreads();
            for (int it = bid; it < 512; it += G) ssd_dec_item(lds, A, it, TID);
        } else if (EN(13) && ph == 13) {
            for (int it = bid; it < 256; it += G) ssd_scan_item(lds, A, it, TID);
        } else if (EN(14) && ph == 14) {
            const int tid = TID, wid = tid >> 6, lane = tid & 63; (void)tid; (void)wid; (void)lane;
            for (int it = bid; it < MP / 8; it += G) ssd_gate_row(A, (size_t)it * 8 + wid, lane);
        }
        }
        const bool again = (((unsigned)REPMASK >> ph) & 1u) && !rep_done;
        rep_done = again ? 1 : 0;
        const int phn = __builtin_amdgcn_readfirstlane(again ? ph : ph + 1);
        if (phn < ph_end) {
            { XcdBarrier xbar; xbar.bar = (unsigned*)(A.ws + WS_BARR); xbar.x = xb_xcc_id(); xbar.st = (volatile LAS unsigned*)(lds + 131072); xcd_barrier(xbar, TID); }
        }
        ph = phn;
    }
}

extern "C" void kernel_launch(void* const* d_in, const int* in_sizes, int n_in, void* d_out, int out_size, void* d_ws, size_t ws_size, hipStream_t stream) {
    static int grid = 0;
    if (grid == 0) {
        if (n_in != 30 || ws_size < WS_END) { fprintf(stderr, "kernel_launch: need 30 inputs and >= %zu bytes of workspace (got %d, %zu)\n", (size_t)WS_END, n_in, ws_size); grid = -1; return; }
        int dev = 0, cus = 0, per_cu = 0;
        (void)hipGetDevice(&dev); (void)hipDeviceGetAttribute(&cus, hipDeviceAttributeMultiprocessorCount, dev);
        if (hipOccupancyMaxActiveBlocksPerMultiprocessor(&per_cu, (const void*)fwd_kernel, 512, 0) != hipSuccess || per_cu < 1) { fprintf(stderr, "kernel_launch: occupancy query failed (%d)\n", per_cu); per_cu = 1; (void)hipGetLastError(); }
        grid = cus * per_cu;
    }
    if (grid < 0) return;
    if (hipMemsetAsync((char*)d_ws + WS_BARR, 0, 16384, stream) != hipSuccess) { fprintf(stderr, "kernel_launch: memset of barrier words failed\n"); return; }
    Args a{};
    for (int i = 0; i < 30; ++i) a.in[i] = (const float*)d_in[i];
    a.out = (float*)d_out; a.ws = (unsigned char*)d_ws;
#if ONE_LAUNCH
    a.ph_lo = 0; a.ph_hi = NPHASE;
    void* args[] = {&a};
    hipError_t e = hipLaunchCooperativeKernel((const void*)fwd_kernel, dim3(grid), dim3(512), args, 0, stream);
    if (e != hipSuccess) fprintf(stderr, "cooperative launch failed: %s (grid %d)\n", hipGetErrorString(e), grid);
#else
#ifndef NPH_RUN
#define NPH_RUN NPHASE
#endif
    for (int p = 0; p < NPH_RUN; ++p) { a.ph_lo = p; a.ph_hi = p + 1; hipLaunchKernelGGL(fwd_kernel, dim3(grid), dim3(512), 0, stream, a); }
#endif
}
```

```cpp
#include <hip/hip_runtime.h>
#include <hip/hip_cooperative_groups.h>
#include <cstdio>
namespace cg = cooperative_groups;

#ifndef ONE_LAUNCH
#define ONE_LAUNCH 1
#endif

#define LAS __attribute__((address_space(3)))
typedef unsigned short bf16_t;
typedef short bf16x8 __attribute__((ext_vector_type(8)));
typedef float f32x4 __attribute__((ext_vector_type(4)));
typedef float f32x2 __attribute__((ext_vector_type(2)));
typedef unsigned u32x4 __attribute__((ext_vector_type(4)));
typedef unsigned u32x2 __attribute__((ext_vector_type(2)));

constexpr int D = 1024, BP = 8, SL = 2048, MP = BP * SL, DB = 128;
constexpr int GH = 8, GIN = 4112, GINP = 4352;
constexpr int SIN = 5152, SINP = 5376, SINNER = 2048, SHEADS = 32;
constexpr int DFF = 2816, NUP = 5632;
constexpr float DN_ALPHA = 1.4142135623730951f;
constexpr float LN_EPS = 1e-5f, RMS_EPS = 1e-6f;

constexpr size_t MB = 1u << 20;
constexpr size_t WS_WGI = 0, WS_WGO = 17 * MB / 2, WS_WSI = 21 * MB / 2, WS_WSO = 21 * MB, WS_WUP0 = 25 * MB, WS_WUP1 = 36 * MB,
                 WS_WDN0 = 47 * MB, WS_WDN1 = 105 * MB / 2, WS_XB = 58 * MB, WS_XF = 90 * MB, WS_PROJ = 154 * MB, WS_H = 330 * MB,
                 WS_YB = 394 * MB, WS_BA = 482 * MB, WS_DEC = 484 * MB;
constexpr size_t WS_XBD = WS_DEC, WS_XFD = WS_XBD + 256 * 1024, WS_PROJD = WS_XFD + 512 * 1024, WS_BAD = WS_PROJD + 1441792,
                 WS_HD = WS_BAD + 16384, WS_YBD = WS_HD + 512 * 1024, WS_EGL = WS_YBD + 720896, WS_BARR = WS_EGL + 8192, WS_END = WS_BARR + 16384;
constexpr size_t WS_UT = WS_YB, WS_WN = WS_YB + 32 * MB, WS_QK = WS_YB + 64 * MB, WS_QD = WS_PROJ + 128 * MB, WS_KDT = WS_XF;
constexpr size_t WS_O = WS_H, WS_XA = WS_H, WS_BCA = WS_XF;

constexpr size_t O_YP = 0, O_YS = 16777216, O_GCP = 16908288, O_GCS = 16982016, O_GSP = 18161664, O_GSS = 19210240, O_SCP = 35987456,
                 O_SCS = 36061184, O_SSP = 37240832, O_SSS = 39337984, O_FCP = 72892416, O_FCS = 72982528;

constexpr int LDS_BYTES = 131072 + 2048;

__device__ __forceinline__ int make_tid(int wave_s) { unsigned ones = ~0u; asm volatile("" : "+s"(ones)); int t = wave_s * 64 + (int)__builtin_amdgcn_mbcnt_hi(ones, __builtin_amdgcn_mbcnt_lo(ones, 0u)); asm volatile("" : "+v"(t)); return t; }
__device__ __forceinline__ float bf2f(unsigned b) { return __uint_as_float(b << 16); }
typedef __bf16 bf16x2_t __attribute__((ext_vector_type(2)));
__device__ __forceinline__ unsigned pack2(float lo, float hi) { const f32x2 v = {lo, hi}; const bf16x2_t b = __builtin_convertvector(v, bf16x2_t); return __builtin_bit_cast(unsigned, b); }
__device__ __forceinline__ float lo_f(unsigned w) { return __uint_as_float(w << 16); }
__device__ __forceinline__ float hi_f(unsigned w) { return __uint_as_float(w & 0xffff0000u); }
__device__ __forceinline__ float silu_f(float x) { return x * __builtin_amdgcn_rcpf(1.f + __expf(-x)); }
__device__ __forceinline__ float sigmoid_f(float x) { return __builtin_amdgcn_rcpf(1.f + __expf(-x)); }
__device__ __forceinline__ float softplus_f(float x) { return x > 20.f ? x : log1pf(__expf(x)); }
#define DPP_F(x, ctrl, rmask) __builtin_bit_cast(float, __builtin_amdgcn_update_dpp(0, __builtin_bit_cast(int, (x)), (ctrl), (rmask), 0xf, false))
__device__ __forceinline__ float wave_sum(float v) {
    v += DPP_F(v, 0xB1, 0xf);
    v += DPP_F(v, 0x4E, 0xf);
    v += DPP_F(v, 0x141, 0xf);
    v += DPP_F(v, 0x140, 0xf);
    v += DPP_F(v, 0x142, 0xa);
    v += DPP_F(v, 0x143, 0xc);
    return __builtin_bit_cast(float, __builtin_amdgcn_readlane(__builtin_bit_cast(int, v), 63));
}
__device__ __forceinline__ float wave_incl_scan(float v, int lane) {
#pragma unroll
    for (int o = 1; o < 64; o <<= 1) { float t = __shfl_up(v, o); if (lane >= o) v += t; }
    return v;
}
__device__ __forceinline__ f32x4 mfma16(bf16x8 a, bf16x8 b, f32x4 c) { return __builtin_amdgcn_mfma_f32_16x16x32_bf16(a, b, c, 0, 0, 0); }
__device__ __forceinline__ void lds_barrier() { asm volatile("s_waitcnt lgkmcnt(0)" ::: "memory"); __builtin_amdgcn_s_barrier(); asm volatile("" ::: "memory"); }
__device__ __forceinline__ u32x2 pack4(f32x4 v) { u32x2 r; r.x = pack2(v[0], v[1]); r.y = pack2(v[2], v[3]); return r; }

namespace pg8 {
constexpr int BM = 256, BK = 64, HALF = 128, HTB = HALF * BK * 2, STAGE_BYTES = 8 * HTB, NXCD = 8, WGM = 8;
__device__ __forceinline__ int lds_byte(int r, int c) { const int st = (r >> 4) * 2 + (c >> 5), rr = r & 15, cc = c & 31, ob = rr * 64 + cc * 2; return st * 1024 + (ob ^ (((ob >> 9) & 1) << 5)); }
__device__ __forceinline__ void stage_rc(int b, int& R, int& C) { const int st = b / 1024, sb = b % 1024, swz = sb ^ (((sb >> 9) & 1) << 5); R = (st >> 1) * 16 + swz / 64; C = (st & 1) * 32 + (swz % 64) / 2; }
__device__ __forceinline__ int perm32(int rho) { const int n = rho >> 4, i = rho & 15; return 8 * (i >> 2) + 4 * n + (i & 3); }
struct Unit { int pm, pn; };
struct Gemm { const bf16_t* A; const bf16_t* Bt; int M, N, K; };
struct StaticOrder {
    int nM, nN, nwg, G, c;
    __device__ void init(int M, int N, int G_, int c_) { nM = M / BM; nN = N / BM; nwg = nM * nN; G = G_; c = c_; }
    __device__ bool next(int i, Unit& u) const {
        const long L = (long)i * G + c; if (L >= nwg) return false;
        int wgid = (int)L; { const int q = nwg / NXCD, r = nwg % NXCD, xcd = wgid % NXCD, off = wgid / NXCD; wgid = (xcd < r ? xcd * (q + 1) : r * (q + 1) + (xcd - r) * q) + off; }
        const int nig = WGM * nN, gid = wgid / nig, fm = gid * WGM, gsz = (nM - fm) < WGM ? (nM - fm) : WGM;
        u.pm = fm + ((wgid % nig) % gsz); u.pn = (wgid % nig) / gsz; return true;
    }
};
struct EpiF32 {
    static constexpr bool PERM = false;
    float* C; int ldc;
    __device__ __forceinline__ void operator()(const f32x4 (&acc)[2][2][4][2], const Unit& u, int wr, int wc, int fr, int fq) const {
        const int row0 = u.pm * BM + wr * 64 + fr, col0 = u.pn * BM + wc * 32 + 4 * fq;
#pragma unroll
        for (int ai = 0; ai < 2; ++ai)
#pragma unroll
            for (int m = 0; m < 4; ++m) { float* rowp = C + (size_t)(row0 + ai * HALF + m * 16) * ldc + col0;
#pragma unroll
                for (int bj = 0; bj < 2; ++bj)
#pragma unroll
                    for (int n = 0; n < 2; ++n) *(f32x4*)(rowp + bj * HALF + n * 16) = acc[ai][bj][m][n]; }
    }
};
struct EpiBf16 {
    static constexpr bool PERM = true;
    bf16_t* O; int ldo;
    __device__ __forceinline__ void operator()(const f32x4 (&acc)[2][2][4][2], const Unit& u, int wr, int wc, int fr, int fq) const {
        const int row0 = u.pm * BM + wr * 64 + fr, col0 = u.pn * BM + wc * 32 + 8 * fq;
#pragma unroll
        for (int ai = 0; ai < 2; ++ai)
#pragma unroll
            for (int m = 0; m < 4; ++m) { bf16_t* rowp = O + (size_t)(row0 + ai * HALF + m * 16) * ldo + col0;
#pragma unroll
                for (int bj = 0; bj < 2; ++bj) { const f32x4 v0 = acc[ai][bj][m][0], v1 = acc[ai][bj][m][1];
                    u32x4 w; w.x = pack2(v0[0], v0[1]); w.y = pack2(v0[2], v0[3]); w.z = pack2(v1[0], v1[1]); w.w = pack2(v1[2], v1[3]);
                    *(u32x4*)(rowp + bj * HALF) = w; } }
    }
};
__device__ __forceinline__ float dpp_ror1(float x) { return __builtin_bit_cast(float, __builtin_amdgcn_update_dpp(0, __builtin_bit_cast(int, x), 0x121, 0xf, 0xf, false)); }
__device__ __forceinline__ float dpp_ror2(float x) { return __builtin_bit_cast(float, __builtin_amdgcn_update_dpp(0, __builtin_bit_cast(int, x), 0x122, 0xf, 0xf, false)); }
struct EpiGate {
    bf16_t* HB; const float* cw; const float* cb; float* edge; float* first; float* cache;
    __device__ __forceinline__ void operator()(const f32x4 (&acc)[2][2][4][2], const Unit& u, int wr, int wc, int fr_, int fq_) const {
        int fr = fr_, fq = fq_; asm volatile("" : "+v"(fr), "+v"(fq));
#pragma unroll
        for (int n = 0; n < 2; ++n) {
            const int ch = u.pn * 128 + wc * 32 + 8 * fq + 4 * n;
            const f32x4 w0 = *(const f32x4*)(cw + ch), w1 = *(const f32x4*)(cw + DFF + ch), w2 = *(const f32x4*)(cw + 2 * DFF + ch), bb = *(const f32x4*)(cb + ch);
#pragma unroll
            for (int ai = 0; ai < 2; ++ai) {
                const int strip = u.pm * 4 + ai * 2 + wr;
                f32x4 pr1 = (f32x4){0.f, 0.f, 0.f, 0.f}, pr2 = pr1;
#pragma unroll
                for (int m = 0; m < 4; ++m) {
                    const f32x4 g = acc[ai][0][m][n], v = acc[ai][1][m][n];
                    f32x4 c1, c2;
#pragma unroll
                    for (int j = 0; j < 4; ++j) { c1[j] = dpp_ror1(g[j]); c2[j] = dpp_ror2(g[j]); }
                    const f32x4 p1 = (m == 0 || fr >= 1) ? c1 : pr1;
                    const f32x4 p2 = (m == 0 || fr >= 2) ? c2 : pr2;
                    pr1 = c1; pr2 = c2;
                    const size_t row = (size_t)u.pm * 256 + ai * 128 + wr * 64 + m * 16 + fr;
                    if (m == 0 && fr < 2) {
                        const f32x4 pa = (fr == 0) ? (bb + w2 * g) : (bb + w1 * p1 + w2 * g);
                        float* fp = first + ((size_t)strip * 2 + fr) * (2 * DFF) + ch;
                        *(f32x4*)fp = pa; *(f32x4*)(fp + DFF) = v;
                    } else {
                        const f32x4 y = bb + w0 * p2 + w1 * p1 + w2 * g; f32x4 o;
#pragma unroll
                        for (int j = 0; j < 4; ++j) o[j] = silu_f(y[j]) * v[j];
                        *(u32x2*)(HB + row * DFF + ch) = pack4(o);
                    }
                    if (m == 3 && fr >= 14) {
                        *(f32x4*)(edge + ((size_t)strip * 2 + (fr - 14)) * DFF + ch) = g;
                        if ((strip & 31) == 31) *(f32x4*)(cache + ((size_t)(strip >> 5) * 2 + (fr - 14)) * DFF + ch) = g;
                    }
                }
            }
        }
    }
};
struct EpiUni {
    int mode; bf16_t* O; int ldo; const float* cw; const float* cb; float* aux; float* cache;
    __device__ __forceinline__ void operator()(const f32x4 (&acc)[2][2][4][2], const Unit& u, int wr, int wc, int fr_, int fq_) const {
        (void)fr_; (void)fq_;
        unsigned ones = ~0u; asm volatile("" : "+s"(ones));
        const int lane_e = (int)__builtin_amdgcn_mbcnt_hi(ones, __builtin_amdgcn_mbcnt_lo(ones, 0u)), fr = lane_e & 15, fq = lane_e >> 4;
        if (mode == 2) { EpiGate e{O, cw, cb, aux, aux + (size_t)256 * 2 * DFF, cache}; e(acc, u, wr, wc, fr, fq); }
        else { EpiBf16 e{O, ldo}; e(acc, u, wr, wc, fr, fq); }
    }
};

template <class Epi, class Sched>
__device__ __forceinline__ void gemm_phase(LAS unsigned char* lds, const Gemm g, const Sched& S, const Epi& E, int tid_in) {
    const int tid = tid_in, wid = __builtin_amdgcn_readfirstlane(tid >> 6), lane = tid & 63, wr = wid >> 2, wc = wid & 3, fr = lane & 15, fq = lane >> 4;
    const int K = g.K, nt = K / BK;
    unsigned voffA[2], voffB[2];
#pragma unroll
    for (int i = 0; i < 2; ++i) { int R, C; stage_rc(tid * 16 + i * 8192, R, C); const int Rb = (E.mode != 0) ? ((R & ~31) + perm32(R & 31)) : R;
        voffA[i] = (unsigned)(R * K + C) * 2u; voffB[i] = (unsigned)(Rb * K + C) * 2u; }
    const size_t kstep = (size_t)(BK * 2);
    const size_t hstep = (size_t)HALF * K * 2;
    const size_t tstep = 2 * hstep;
    const unsigned ldsw = (unsigned)wid * 1024u;
    const int aoff = lds_byte(wr * 64 + fr, fq * 8), boff = lds_byte(wc * 32 + fr, fq * 8);
#define PG8_SA(b, h) (((b) * 2 + (h)) * HTB)
#define PG8_SB(b, h) ((4 + (b) * 2 + (h)) * HTB)
#define PG8_STAGE(bufoff, gbase, voff) do { _Pragma("unroll") for (int _i = 0; _i < 2; ++_i) \
        __builtin_amdgcn_global_load_lds((const unsigned*)((const char*)(gbase) + (voff)[_i]), (LAS unsigned*)(lds + (bufoff) + ldsw + _i * 8192), 16, 0, 0); } while (0)
#define PG8_LDA(dst, b, h) do { _Pragma("unroll") for (int m = 0; m < 4; ++m) _Pragma("unroll") for (int k = 0; k < 2; ++k) dst[m][k] = *(const LAS bf16x8*)(lds + PG8_SA(b, h) + aoff + m * 2048 + k * 1024); } while (0)
#define PG8_LDB(dst, b, h) do { _Pragma("unroll") for (int n = 0; n < 2; ++n) _Pragma("unroll") for (int k = 0; k < 2; ++k) dst[n][k] = *(const LAS bf16x8*)(lds + PG8_SB(b, h) + boff + n * 2048 + k * 1024); } while (0)
#define PG8_MMA(ai, bj, At, Bt) do { __builtin_amdgcn_s_setprio(1); _Pragma("unroll") for (int m = 0; m < 4; ++m) _Pragma("unroll") for (int n = 0; n < 2; ++n) _Pragma("unroll") for (int k = 0; k < 2; ++k) \
        acc[ai][bj][m][n] = __builtin_amdgcn_mfma_f32_16x16x32_bf16(Bt[n][k], At[m][k], acc[ai][bj][m][n], 0, 0, 0); __builtin_amdgcn_s_setprio(0); } while (0)
#define PG8_WAIT_V(n) asm volatile("s_waitcnt vmcnt(" #n ")" ::: "memory")
#define PG8_WAIT_L(n) asm volatile("s_waitcnt lgkmcnt(" #n ")" ::: "memory")
#define PG8_BAR __builtin_amdgcn_s_barrier()
#define PG8_SCHED __builtin_amdgcn_sched_barrier(0)
    Unit cur, nxt; int ui = 0;
    if (!S.next(0, cur)) return;
    f32x4 acc[2][2][4][2];
#pragma unroll
    for (int a = 0; a < 2; ++a)
#pragma unroll
        for (int b = 0; b < 2; ++b)
#pragma unroll
            for (int m = 0; m < 4; ++m)
#pragma unroll
                for (int n = 0; n < 2; ++n) acc[a][b][m][n] = (f32x4){0.f, 0.f, 0.f, 0.f};
    bf16x8 At[4][2], B0[2][2], B1[2][2];
    const char* cA = (const char*)g.A + (size_t)cur.pm * tstep; const char* cB = (const char*)g.Bt + (size_t)cur.pn * tstep;
    PG8_STAGE(PG8_SB(0, 0), cB, voffB); PG8_STAGE(PG8_SA(0, 0), cA, voffA); PG8_STAGE(PG8_SB(0, 1), cB + hstep, voffB); PG8_STAGE(PG8_SA(0, 1), cA + hstep, voffA);
    if (wr == 1) PG8_BAR;
    PG8_WAIT_V(4); PG8_BAR;
    PG8_STAGE(PG8_SB(1, 0), cB + kstep, voffB); PG8_STAGE(PG8_SA(1, 0), cA + kstep, voffA); PG8_STAGE(PG8_SB(1, 1), cB + hstep + kstep, voffB);
    PG8_WAIT_V(6); PG8_BAR;
    for (;;) {
        const bool has_next = S.next(ui + 1, nxt);
        const char* nA = has_next ? (const char*)g.A + (size_t)nxt.pm * tstep : cA; const char* nB = has_next ? (const char*)g.Bt + (size_t)nxt.pn * tstep : cB;
        for (int t = 0; t < nt; t += 2) {
            const bool last = (t == nt - 2);
            const char* a1 = cA + (size_t)(t + 1) * kstep;
            const char* a2 = last ? nA : cA + (size_t)(t + 2) * kstep; const char* b2 = last ? nB : cB + (size_t)(t + 2) * kstep;
            const char* a3 = a2 + kstep; const char* b3 = b2 + kstep;
            PG8_LDB(B0, 0, 0); PG8_SCHED; PG8_LDA(At, 0, 0); PG8_STAGE(PG8_SA(1, 1), a1 + hstep, voffA);
            PG8_WAIT_L(8); PG8_BAR; PG8_WAIT_L(0); PG8_MMA(0, 0, At, B0); PG8_BAR; PG8_SCHED;
            PG8_LDB(B1, 0, 1); PG8_STAGE(PG8_SB(0, 0), b2, voffB);
            PG8_BAR; PG8_WAIT_L(0); PG8_MMA(0, 1, At, B1); PG8_BAR;
            PG8_LDA(At, 0, 1); PG8_STAGE(PG8_SA(0, 0), a2, voffA);
            PG8_BAR; PG8_WAIT_L(0); PG8_MMA(1, 0, At, B0); PG8_BAR; PG8_SCHED;
            PG8_STAGE(PG8_SB(0, 1), b2 + hstep, voffB);
            PG8_WAIT_V(6); PG8_BAR; PG8_MMA(1, 1, At, B1); PG8_BAR;
            PG8_LDB(B0, 1, 0); PG8_SCHED; PG8_LDA(At, 1, 0); PG8_STAGE(PG8_SA(0, 1), a2 + hstep, voffA);
            PG8_WAIT_L(8); PG8_BAR; PG8_WAIT_L(0); PG8_MMA(0, 0, At, B0); PG8_BAR; PG8_SCHED;
            PG8_LDB(B1, 1, 1); PG8_STAGE(PG8_SB(1, 0), b3, voffB);
            PG8_BAR; PG8_WAIT_L(0); PG8_MMA(0, 1, At, B1); PG8_BAR;
            PG8_LDA(At, 1, 1); PG8_STAGE(PG8_SA(1, 0), a3, voffA);
            PG8_BAR; PG8_WAIT_L(0); PG8_MMA(1, 0, At, B0); PG8_BAR; PG8_SCHED;
            PG8_STAGE(PG8_SB(1, 1), b3 + hstep, voffB);
            PG8_WAIT_V(6); PG8_BAR; PG8_MMA(1, 1, At, B1); PG8_BAR;
        }
        E(acc, cur, wr, wc, fr, fq);
        if (!has_next) break;
#pragma unroll
        for (int a = 0; a < 2; ++a)
#pragma unroll
            for (int b = 0; b < 2; ++b)
#pragma unroll
                for (int m = 0; m < 4; ++m)
#pragma unroll
                    for (int n = 0; n < 2; ++n) acc[a][b][m][n] = (f32x4){0.f, 0.f, 0.f, 0.f};
        cur = nxt; cA = nA; cB = nB; ++ui;
    }
    PG8_WAIT_V(0);
    if (wr == 0) PG8_BAR;
    PG8_BAR;
#undef PG8_SA
#undef PG8_SB
#undef PG8_STAGE
#undef PG8_LDA
#undef PG8_LDB
#undef PG8_MMA
#undef PG8_WAIT_V
#undef PG8_WAIT_L
#undef PG8_BAR
#undef PG8_SCHED
}
}

struct Args {
    const float* in[30];
    float* out;
    unsigned char* ws;
    int ph_lo, ph_hi;
};

struct DecStore {
    int ldp, nbf, nf; bf16_t* Pd; float* BAd;
    __device__ __forceinline__ void operator()(int row, int col, float v0, float v1) const {
        if (col < nbf) { *(unsigned*)(Pd + (size_t)row * ldp + col) = pack2(v0, v1); }
        else if (col < nbf + nf) { BAd[row * 32 + col - nbf] = v0; BAd[row * 32 + col - nbf + 1] = v1; }
    }
};
__device__ __forceinline__ void small_gemm_item(LAS unsigned char* lds, const bf16_t* __restrict__ A, int lda, const bf16_t* __restrict__ Bt, int K, int item, const DecStore& st, int tid_in) {
    const int tid = tid_in, wid = tid >> 6, lane = tid & 63, fr = lane & 15, fq = lane >> 4;
    const int rg = item & 7, cgp = item >> 3;
    const int kw = K >> 3;
    const bf16_t* ap = A + (size_t)(rg * 16 + fr) * lda + wid * kw + fq * 8;
    const bf16_t* bp = Bt + (size_t)(cgp * 64 + fr) * K + wid * kw + fq * 8;
    f32x4 acc[4];
#pragma unroll
    for (int n = 0; n < 4; ++n) acc[n] = (f32x4){0.f, 0.f, 0.f, 0.f};
    int k0 = 0;
    for (; k0 + 128 <= kw; k0 += 128) {
        bf16x8 a[4], bq[4][4];
#pragma unroll
        for (int q = 0; q < 4; ++q) { a[q] = *(const bf16x8*)(ap + k0 + 32 * q);
#pragma unroll
            for (int n = 0; n < 4; ++n) bq[q][n] = *(const bf16x8*)(bp + (size_t)n * 16 * K + k0 + 32 * q); }
#pragma unroll
        for (int q = 0; q < 4; ++q)
#pragma unroll
            for (int n = 0; n < 4; ++n) acc[n] = mfma16(a[q], bq[q][n], acc[n]);
    }
    for (; k0 < kw; k0 += 32) {
        const bf16x8 a = *(const bf16x8*)(ap + k0);
#pragma unroll
        for (int n = 0; n < 4; ++n) { const bf16x8 b = *(const bf16x8*)(bp + (size_t)n * 16 * K + k0); acc[n] = mfma16(a, b, acc[n]); }
    }
    LAS float* red = (LAS float*)lds;
#pragma unroll
    for (int n = 0; n < 4; ++n)
#pragma unroll
        for (int r = 0; r < 4; ++r) red[wid * 1024 + (fq * 4 + r) * 64 + n * 16 + fr] = acc[n][r];
    __syncthreads();
    {
        const int row = tid >> 5, c2 = (tid & 31) * 2; float v0 = 0.f, v1 = 0.f;
#pragma unroll
        for (int w = 0; w < 8; ++w) { v0 += red[w * 1024 + row * 64 + c2]; v1 += red[w * 1024 + row * 64 + c2 + 1]; }
        st(rg * 16 + row, cgp * 64 + c2, v0, v1);
    }
    __syncthreads();
}

template <int NT>
__device__ __forceinline__ void narrow_item(const bf16_t* __restrict__ A, const bf16_t* __restrict__ Bt, int K, float* __restrict__ BAo, int item, int tid_in) {
    const int tid = tid_in, wid = tid >> 6, lane = tid & 63, fr = lane & 15, fq = lane >> 4;
    const int row0 = item * 128 + wid * 16;
    const bf16_t* ap = A + (size_t)(row0 + fr) * K + fq * 8;
    const bf16_t* bp = Bt + (size_t)fr * K + fq * 8;
    f32x4 acc[NT];
#pragma unroll
    for (int n = 0; n < NT; ++n) acc[n] = (f32x4){0.f, 0.f, 0.f, 0.f};
#pragma unroll 4
    for (int k = 0; k < K; k += 32) {
        const bf16x8 a = *(const bf16x8*)(ap + k);
#pragma unroll
        for (int n = 0; n < NT; ++n) { const bf16x8 bfr = *(const bf16x8*)(bp + (size_t)n * 16 * K + k); acc[n] = mfma16(bfr, a, acc[n]); }
    }
#pragma unroll
    for (int n = 0; n < NT; ++n) *(f32x4*)(BAo + (size_t)(row0 + fr) * 32 + n * 16 + fq * 4) = acc[n];
}

__device__ __forceinline__ void convert_rows16(const float* __restrict__ src, bf16_t* __restrict__ dst, int tid_in) {
#pragma unroll
    for (int i = 0; i < 8; ++i) { const int e = i * 512 + tid_in; const f32x4 v = __builtin_nontemporal_load((const f32x4*)src + e);
        u32x2 w; w.x = pack2(v[0], v[1]); w.y = pack2(v[2], v[3]); ((u32x2*)dst)[e] = w; }
}

__device__ __forceinline__ void unpack8(const u32x4 w, float (&f)[8]) {
    f[0] = lo_f(w.x); f[1] = hi_f(w.x); f[2] = lo_f(w.y); f[3] = hi_f(w.y); f[4] = lo_f(w.z); f[5] = hi_f(w.z); f[6] = lo_f(w.w); f[7] = hi_f(w.w);
}
__device__ __forceinline__ u32x4 pack8(const float (&f)[8]) { u32x4 w; w.x = pack2(f[0], f[1]); w.y = pack2(f[2], f[3]); w.z = pack2(f[4], f[5]); w.w = pack2(f[6], f[7]); return w; }
__device__ __forceinline__ void ln_row(const bf16_t* __restrict__ xres, const bf16_t* __restrict__ h, const float* __restrict__ gam, const float* __restrict__ bet,
                                       float* __restrict__ outF, bf16_t* __restrict__ outB, int lane) {
    float v[2][8]; float s = 0.f;
#pragma unroll
    for (int i = 0; i < 2; ++i) { float a[8], b[8]; unpack8(((const u32x4*)xres)[i * 64 + lane], a); unpack8(((const u32x4*)h)[i * 64 + lane], b);
#pragma unroll
        for (int j = 0; j < 8; ++j) { v[i][j] = a[j] * DN_ALPHA + b[j]; s += v[i][j]; } }
    const float mu = wave_sum(s) * (1.f / 1024.f); float q = 0.f;
#pragma unroll
    for (int i = 0; i < 2; ++i)
#pragma unroll
        for (int j = 0; j < 8; ++j) { v[i][j] -= mu; q += v[i][j] * v[i][j]; }
    const float rstd = __builtin_amdgcn_rsqf(wave_sum(q) * (1.f / 1024.f) + LN_EPS);
#pragma unroll
    for (int i = 0; i < 2; ++i) { float o[8];
#pragma unroll
        for (int hh = 0; hh < 2; ++hh) { const f32x4 g = ((const f32x4*)gam)[i * 128 + lane * 2 + hh], b = ((const f32x4*)bet)[i * 128 + lane * 2 + hh];
#pragma unroll
            for (int j = 0; j < 4; ++j) o[hh * 4 + j] = v[i][hh * 4 + j] * rstd * g[j] + b[j]; }
        if (outB) ((u32x4*)outB)[i * 64 + lane] = pack8(o);
        if (outF) { ((f32x4*)outF)[i * 128 + lane * 2] = (f32x4){o[0], o[1], o[2], o[3]}; ((f32x4*)outF)[i * 128 + lane * 2 + 1] = (f32x4){o[4], o[5], o[6], o[7]}; } }
}

__device__ __forceinline__ void ln_row2(const bf16_t* __restrict__ x0, const bf16_t* __restrict__ h0, const bf16_t* __restrict__ x1, const bf16_t* __restrict__ h1,
                                        const float* __restrict__ gam, const float* __restrict__ bet, float* oF0, bf16_t* oB0, float* oF1, bf16_t* oB1, int lane) {
    u32x4 xa[2][2], ha[2][2];
#pragma unroll
    for (int i = 0; i < 2; ++i) { xa[0][i] = ((const u32x4*)x0)[i * 64 + lane]; ha[0][i] = ((const u32x4*)h0)[i * 64 + lane]; xa[1][i] = ((const u32x4*)x1)[i * 64 + lane]; ha[1][i] = ((const u32x4*)h1)[i * 64 + lane]; }
#pragma unroll
    for (int rr = 0; rr < 2; ++rr) {
        float v[2][8]; float s = 0.f;
#pragma unroll
        for (int i = 0; i < 2; ++i) { float a[8], b[8]; unpack8(xa[rr][i], a); unpack8(ha[rr][i], b);
#pragma unroll
            for (int j = 0; j < 8; ++j) { v[i][j] = a[j] * DN_ALPHA + b[j]; s += v[i][j]; } }
        const float mu = wave_sum(s) * (1.f / 1024.f); float q = 0.f;
#pragma unroll
        for (int i = 0; i < 2; ++i)
#pragma unroll
            for (int j = 0; j < 8; ++j) { v[i][j] -= mu; q += v[i][j] * v[i][j]; }
        const float rstd = __builtin_amdgcn_rsqf(wave_sum(q) * (1.f / 1024.f) + LN_EPS);
        float* outF = rr ? oF1 : oF0; bf16_t* outB = rr ? oB1 : oB0;
#pragma unroll
        for (int i = 0; i < 2; ++i) { float o[8];
#pragma unroll
            for (int hh = 0; hh < 2; ++hh) { const f32x4 g = ((const f32x4*)gam)[i * 128 + lane * 2 + hh], b = ((const f32x4*)bet)[i * 128 + lane * 2 + hh];
#pragma unroll
                for (int j = 0; j < 4; ++j) o[hh * 4 + j] = v[i][hh * 4 + j] * rstd * g[j] + b[j]; }
            if (outB) ((u32x4*)outB)[i * 64 + lane] = pack8(o);
            if (outF) { __builtin_nontemporal_store((f32x4){o[0], o[1], o[2], o[3]}, (f32x4*)outF + i * 128 + lane * 2); __builtin_nontemporal_store((f32x4){o[4], o[5], o[6], o[7]}, (f32x4*)outF + i * 128 + lane * 2 + 1); } }
    }
}

__device__ __forceinline__ void ffn_fixup_item(const float* __restrict__ edge, const float* __restrict__ first, bf16_t* __restrict__ HB, const float* __restrict__ cw, int strip, int tid_in) {
    const int t = tid_in; if (t >= 352) return;
    const int c0 = t * 8;
    const bool has_hist = (strip & 31) != 0;
#pragma unroll
    for (int hh = 0; hh < 2; ++hh) {
        const int ch = c0 + 4 * hh;
        const f32x4 w0 = *(const f32x4*)(cw + ch), w1 = *(const f32x4*)(cw + DFF + ch);
        f32x4 e0 = (f32x4){0.f, 0.f, 0.f, 0.f}, e1 = e0;
        if (has_hist) { e0 = *(const f32x4*)(edge + ((size_t)(strip - 1) * 2 + 0) * DFF + ch); e1 = *(const f32x4*)(edge + ((size_t)(strip - 1) * 2 + 1) * DFF + ch); }
#pragma unroll
        for (int rr = 0; rr < 2; ++rr) {
            const float* fp = first + ((size_t)strip * 2 + rr) * (2 * DFF) + ch;
            const f32x4 pa = *(const f32x4*)fp, v = *(const f32x4*)(fp + DFF);
            const f32x4 y = (rr == 0) ? (pa + w0 * e0 + w1 * e1) : (pa + w0 * e1); f32x4 o;
#pragma unroll
            for (int j = 0; j < 4; ++j) o[j] = silu_f(y[j]) * v[j];
            *(u32x2*)(HB + ((size_t)strip * 64 + rr) * DFF + ch) = pack4(o);
        }
    }
}
__device__ __forceinline__ void ffn_gate_dec_item(const bf16_t* __restrict__ GVd, bf16_t* __restrict__ HBd, const float* __restrict__ cw, const float* __restrict__ cb,
                                                  const float* __restrict__ cache_in  , float* __restrict__ cache_out, int item, int tid_in) {
    const int t = tid_in; if (t >= 352) return;
    const int c0 = t * 8;
    float w0[8], w1[8], w2[8], bb[8];
#pragma unroll
    for (int j = 0; j < 8; ++j) { w0[j] = cw[c0 + j]; w1[j] = cw[DFF + c0 + j]; w2[j] = cw[2 * DFF + c0 + j]; bb[j] = cb[c0 + j]; }
    for (int r = 0; r < 16; ++r) {
        const int row = item * 16 + r;
        float gcur[8], vv[8], o[8];
        const int cp = 256 * (c0 >> 7) + (c0 & 127);
        unpack8(*(const u32x4*)(GVd + (size_t)row * NUP + cp), gcur); unpack8(*(const u32x4*)(GVd + (size_t)row * NUP + cp + 128), vv);
        const float* ci = cache_in + (size_t)row * 2 * DFF + c0; float* co = cache_out + (size_t)row * 2 * DFF + c0;
#pragma unroll
        for (int j = 0; j < 8; ++j) { const float c0v = ci[j], c1v = ci[DFF + j]; const float y = bb[j] + w0[j] * c0v + w1[j] * c1v + w2[j] * gcur[j]; o[j] = silu_f(y) * vv[j];
            co[j] = c1v; co[DFF + j] = gcur[j]; }
        *(u32x4*)(HBd + (size_t)row * DFF + c0) = pack8(o);
    }
}

constexpr int GA_QS = 0, GA_KS = 17408, GA_VBT = 34816, GA_KBGT = 53248, GA_MS = 71680, GA_TS = 89088, GA_GC = 98304, GA_BT = 98560, GA_TL = 99328, GA_PB = 115712;
__device__ __forceinline__ void gdn_a_phase(LAS unsigned char* lds, const Args& A, int bid, int G, int tid_in) {
    const bf16_t* PROJ = (const bf16_t*)(A.ws + WS_PROJ);
    const float* BA = (const float*)(A.ws + WS_BA);
    float* EGL = (float*)(A.ws + WS_EGL);
    LAS unsigned* Qs = (LAS unsigned*)(lds + GA_QS); LAS unsigned* Ks = (LAS unsigned*)(lds + GA_KS);
    LAS float* Ms = (LAS float*)(lds + GA_MS); LAS bf16_t* Ts = (LAS bf16_t*)(lds + GA_TS);
    LAS float* gc = (LAS float*)(lds + GA_GC); LAS float* bt = (LAS float*)(lds + GA_BT);
    LAS float* Tl = (LAS float*)(lds + GA_TL); LAS float* Pb = (LAS float*)(lds + GA_PB);
    unsigned xw[3][11]; float pbr = 0.f, par = 0.f;
#define GA_IDS int tid = tid_in; asm volatile("" : "+v"(tid)); const int wid = tid >> 6, lane = tid & 63, fr = lane & 15, fq = lane >> 4, i0 = wid * 8, c = 2 * lane; (void)fr; (void)fq;
#define GA_LOAD(it) { const int _n = (it) & 31, _h = ((it) >> 5) & 7, _b = (it) >> 8; \
        _Pragma("unroll") for (int seg = 0; seg < 3; ++seg) _Pragma("unroll") for (int r = 0; r < 11; ++r) { const int t = _n * 64 + i0 + r - 3; \
            xw[seg][r] = *(const unsigned*)(PROJ + ((size_t)_b * SL + (t < 0 ? 0 : t)) * 4096 + seg * 1024 + _h * 128 + c); } \
        if (wid == 0) { const size_t _rb = (size_t)_b * SL + _n * 64 + lane; pbr = BA[_rb * 32 + _h]; par = BA[_rb * 32 + 8 + _h]; } }
    if (bid < 2048) { GA_IDS GA_LOAD(bid) }
    for (int item = bid; item < 2048; item += G) {
        GA_IDS
        const int n = item & 31, h = (item >> 5) & 7, b = item >> 8, chunk = (b * 8 + h) * 32 + n;
        bf16_t* UT = (bf16_t*)(A.ws + WS_UT) + (size_t)chunk * 8192; bf16_t* WN = (bf16_t*)(A.ws + WS_WN) + (size_t)chunk * 8192;
        bf16_t* QD = (bf16_t*)(A.ws + WS_QD) + (size_t)chunk * 8192; bf16_t* KDT = (bf16_t*)(A.ws + WS_KDT) + (size_t)chunk * 8192;
        bf16_t* QK = (bf16_t*)(A.ws + WS_QK) + (size_t)chunk * 4096;
        if (wid == 0) {
            const float g = -__expf(A.in[10][h]) * softplus_f(par + A.in[11][h]);
            const float gcum = wave_incl_scan(g, lane);
            gc[lane] = gcum; bt[lane] = sigmoid_f(pbr);
            if (lane == 63) EGL[chunk] = __expf(gcum);
        }
        lds_barrier();
        {
            const float glast = gc[63];
#pragma unroll
            for (int seg = 0; seg < 3; ++seg) {
                const int col = seg * 1024 + h * 128 + c;
                float w0[4], w1[4];
#pragma unroll
                for (int k = 0; k < 4; ++k) { const f32x2 t = *(const f32x2*)(A.in[8] + k * 3072 + col); w0[k] = t.x; w1[k] = t.y; }
                const f32x2 bb = *(const f32x2*)(A.in[9] + col);
                float x0[11], x1[11];
#pragma unroll
                for (int r = 0; r < 11; ++r) { const bool okr = (n * 64 + i0 + r - 3) >= 0; x0[r] = okr ? lo_f(xw[seg][r]) : 0.f; x1[r] = okr ? hi_f(xw[seg][r]) : 0.f; }
                if (n == 31 && wid == 7) {
#pragma unroll
                    for (int rr = 0; rr < 3; ++rr) *(f32x2*)(A.out + O_GCP + ((size_t)b * 3 + rr) * 3072 + col) = (f32x2){x0[8 + rr], x1[8 + rr]};
                }
                float y0[8], y1[8];
#pragma unroll
                for (int r = 0; r < 8; ++r) {
                    y0[r] = silu_f(bb.x + w0[0] * x0[r] + w0[1] * x0[r + 1] + w0[2] * x0[r + 2] + w0[3] * x0[r + 3]);
                    y1[r] = silu_f(bb.y + w1[0] * x1[r] + w1[1] * x1[r + 1] + w1[2] * x1[r + 2] + w1[3] * x1[r + 3]);
                }
                if (seg < 2) {
#pragma unroll
                    for (int r = 0; r < 8; ++r) { const float ss = wave_sum(y0[r] * y0[r] + y1[r] * y1[r]); const float rn = __builtin_amdgcn_rsqf(ss + 1e-6f) * (seg == 0 ? 0.08838834764831845f : 1.f); y0[r] *= rn; y1[r] *= rn; }
                }
                if (seg == 0) {
#pragma unroll
                    for (int r = 0; r < 8; ++r) { const int i = i0 + r; Qs[i * 68 + lane] = pack2(y0[r], y1[r]); const float eg = __expf(gc[i]);
                        *(unsigned*)(QD + i * 128 + c) = pack2(y0[r] * eg, y1[r] * eg); }
                } else if (seg == 1) {
                    float a0[8], a1[8], d0[8], d1[8];
#pragma unroll
                    for (int r = 0; r < 8; ++r) { const int i = i0 + r; Ks[i * 68 + lane] = pack2(y0[r], y1[r]); const float gi = gc[i], s1 = bt[i] * __expf(gi), s2 = __expf(glast - gi);
                        a0[r] = y0[r] * s1; a1[r] = y1[r] * s1; d0[r] = y0[r] * s2; d1[r] = y1[r] * s2; }
                    *(LAS u32x4*)(lds + GA_KBGT + (c * 72 + i0) * 2) = pack8(a0); *(LAS u32x4*)(lds + GA_KBGT + ((c + 1) * 72 + i0) * 2) = pack8(a1);
                    *(u32x4*)(KDT + c * 64 + i0) = pack8(d0); *(u32x4*)(KDT + (c + 1) * 64 + i0) = pack8(d1);
                } else {
                    float a0[8], a1[8];
#pragma unroll
                    for (int r = 0; r < 8; ++r) { const float be = bt[i0 + r]; a0[r] = y0[r] * be; a1[r] = y1[r] * be; }
                    *(LAS u32x4*)(lds + GA_VBT + (c * 72 + i0) * 2) = pack8(a0); *(LAS u32x4*)(lds + GA_VBT + ((c + 1) * 72 + i0) * 2) = pack8(a1);
                }
                __builtin_amdgcn_sched_barrier(0);
            }
        }
        lds_barrier();
        if (item + G < 2048) { GA_LOAD(item + G) }
        {
            const int ti = wid >> 1;
#pragma unroll
            for (int tjj = 0; tjj < 2; ++tjj) {
                const int tj = (wid & 1) * 2 + tjj;
                f32x4 ak = (f32x4){0.f, 0.f, 0.f, 0.f}, aq = (f32x4){0.f, 0.f, 0.f, 0.f};
                if (tj <= ti) {
#pragma unroll
                    for (int kk = 0; kk < 4; ++kk) {
                        const bf16x8 bk = *(const LAS bf16x8*)(lds + GA_KS + ((tj * 16 + fr) * 136 + kk * 32 + fq * 8) * 2);
                        const bf16x8 fk = *(const LAS bf16x8*)(lds + GA_KS + ((ti * 16 + fr) * 136 + kk * 32 + fq * 8) * 2);
                        const bf16x8 fqv = *(const LAS bf16x8*)(lds + GA_QS + ((ti * 16 + fr) * 136 + kk * 32 + fq * 8) * 2);
                        ak = mfma16(fk, bk, ak); aq = mfma16(fqv, bk, aq);
                    }
                }
                const int j = tj * 16 + fr; const float gj = gc[j];
#pragma unroll
                for (int r = 0; r < 4; ++r) { const int i = ti * 16 + fq * 4 + r; const float gi = gc[i];
                    const float e = (i >= j) ? __expf(gi - gj) : 0.f;
                    if (tj <= ti) Ms[i * 68 + j] = (i > j) ? bt[i] * ak[r] * e : 0.f;
                    QK[i * 64 + j] = (bf16_t)(pack2(aq[r] * e, 0.f) & 0xffffu); }
            }
        }
        lds_barrier();
        for (int ib = 0; ib < 4; ++ib) {
            if (ib > 0) {
                float p0 = 0.f, p1 = 0.f;
                const int ra = ib * 16 + 2 * wid;
                for (int j = 0; j < ib * 16; j += 4) {
                    const float t0 = Tl[j * 64 + lane], t1 = Tl[(j + 1) * 64 + lane], t2 = Tl[(j + 2) * 64 + lane], t3 = Tl[(j + 3) * 64 + lane];
                    const f32x4 m0 = *(const LAS f32x4*)(Ms + ra * 68 + j), m1 = *(const LAS f32x4*)(Ms + (ra + 1) * 68 + j);
                    p0 += (m0[0] * t0 + m0[1] * t1) + (m0[2] * t2 + m0[3] * t3);
                    p1 += (m1[0] * t0 + m1[1] * t1) + (m1[2] * t2 + m1[3] * t3);
                }
                Pb[(2 * wid) * 64 + lane] = p0; Pb[(2 * wid + 1) * 64 + lane] = p1;
                lds_barrier();
            }
            if (wid == 0) {
                float Tr[16];
#pragma unroll
                for (int r = 0; r < 16; ++r) {
                    float a = (ib > 0) ? -Pb[r * 64 + lane] : 0.f;
#pragma unroll
                    for (int q = 0; q < r; q += 4) {
                        const f32x4 m = *(const LAS f32x4*)(Ms + (ib * 16 + r) * 68 + ib * 16 + q);
                        a -= m[0] * Tr[q];
                        if (q + 1 < r) a -= m[1] * Tr[q + 1];
                        if (q + 2 < r) a -= m[2] * Tr[q + 2];
                        if (q + 3 < r) a -= m[3] * Tr[q + 3];
                    }
                    Tr[r] = a + ((lane == ib * 16 + r) ? 1.f : 0.f);
                    Tl[(ib * 16 + r) * 64 + lane] = Tr[r];
                    Ts[(ib * 16 + r) * 72 + lane] = (bf16_t)(pack2(Tr[r], 0.f) & 0xffffu);
                }
            }
            lds_barrier();
        }
        {
            const int td = wid;
            bf16x8 bv[2], bk[2];
#pragma unroll
            for (int kk = 0; kk < 2; ++kk) { bv[kk] = *(const LAS bf16x8*)(lds + GA_VBT + ((td * 16 + fr) * 72 + kk * 32 + fq * 8) * 2);
                bk[kk] = *(const LAS bf16x8*)(lds + GA_KBGT + ((td * 16 + fr) * 72 + kk * 32 + fq * 8) * 2); }
#pragma unroll
            for (int ti = 0; ti < 4; ++ti) {
                f32x4 au = (f32x4){0.f, 0.f, 0.f, 0.f}, aw = (f32x4){0.f, 0.f, 0.f, 0.f};
#pragma unroll
                for (int kk = 0; kk < 2; ++kk) { const bf16x8 ft = *(const LAS bf16x8*)(lds + GA_TS + ((ti * 16 + fr) * 72 + kk * 32 + fq * 8) * 2);
                    au = mfma16(ft, bv[kk], au);
                    aw = mfma16(bk[kk], ft, aw); }
                *(u32x2*)(UT + (td * 16 + fr) * 64 + ti * 16 + fq * 4) = pack4(au);
                *(u32x2*)(WN + (ti * 16 + fr) * 128 + td * 16 + fq * 4) = pack4(-aw);
            }
        }
        lds_barrier();
    }
#undef GA_LOAD
#undef GA_IDS
}

__device__ __forceinline__ void gdn_dec_item(LAS unsigned char* lds, const Args& A, int item, int tid_in) {
    const int tid = tid_in, wid = tid >> 6, lane = tid & 63;
    const int h = item & 7, b = item >> 3;
    const bf16_t* Pd = (const bf16_t*)(A.ws + WS_PROJD) + (size_t)b * NUP; const float* BAd = (const float*)(A.ws + WS_BAD) + b * 32;
    bf16_t* YBd = (bf16_t*)(A.ws + WS_YBD) + (size_t)b * DFF;
    LAS float* qs = (LAS float*)lds; LAS float* ks = qs + 128; LAS float* vs = qs + 256; LAS float* sc = qs + 384;
    LAS float* part = qs + 512;
    LAS float* os = qs + 512 + 1024;
    if (tid < 384) {
        const int seg = tid >> 7, d = tid & 127, col = seg * 1024 + h * 128 + d;
        const float* cin = A.in[2] + (size_t)b * 3 * 3072 + col;
        const float c0 = cin[0], c1 = cin[3072], c2 = cin[6144], nw = bf2f(Pd[col]);
        const float* cw = A.in[8] + col;
        const float y = A.in[9][col] + cw[0] * c0 + cw[3072] * c1 + cw[6144] * c2 + cw[9216] * nw;
        qs[tid] = silu_f(y);
        float* co = A.out + O_GCS + (size_t)b * 3 * 3072 + col; co[0] = c1; co[3072] = c2; co[6144] = nw;
    }
    __syncthreads();
    if (wid < 3) {
        const float q0 = qs[lane], q1 = qs[lane + 64], k0 = ks[lane], k1 = ks[lane + 64];
        const float v = (wid == 0) ? (q0 * q0 + q1 * q1) : (wid == 1) ? (k0 * k0 + k1 * k1) : (q0 * k0 + q1 * k1);
        const float s = wave_sum(v); if (lane == 0) sc[wid] = s;
    }
    __syncthreads();
    const float rq = __builtin_amdgcn_rsqf(sc[0] + 1e-6f) * 0.08838834764831845f, rk = __builtin_amdgcn_rsqf(sc[1] + 1e-6f), qk = sc[2] * rq * rk;
    const float g = -__expf(A.in[10][h]) * softplus_f(BAd[8 + h] + A.in[11][h]), eg = __expf(g), beta = sigmoid_f(BAd[h]);
    const int v = tid & 127, kg = tid >> 7;
    const float* Sin = A.in[3] + ((size_t)(b * 8 + h) * 128 + kg * 32) * 128 + v;
    float S[32]; float pk = 0.f, pq = 0.f;
#pragma unroll
    for (int k = 0; k < 32; ++k) S[k] = __builtin_nontemporal_load(Sin + k * 128);
#pragma unroll
    for (int k = 0; k < 32; ++k) { pk += ks[kg * 32 + k] * S[k]; pq += qs[kg * 32 + k] * S[k]; }
    part[kg * 128 + v] = pk * rk; part[512 + kg * 128 + v] = pq * rq;
    __syncthreads();
    const float kS = (part[v] + part[128 + v]) + (part[256 + v] + part[384 + v]);
    const float qS = (part[512 + v] + part[640 + v]) + (part[768 + v] + part[896 + v]);
    const float vnew = beta * (vs[v] - eg * kS);
    const float o = eg * qS + qk * vnew;
    float* Sout = A.out + O_GSS + ((size_t)(b * 8 + h) * 128 + kg * 32) * 128 + v;
#pragma unroll
    for (int k = 0; k < 32; ++k) __builtin_nontemporal_store(eg * S[k] + (ks[kg * 32 + k] * rk) * vnew, Sout + k * 128);
    if (kg == 0) os[v] = o;
    __syncthreads();
    if (wid == 0) {
        const float o0 = os[lane], o1 = os[lane + 64];
        const float rstd = __builtin_amdgcn_rsqf(wave_sum(o0 * o0 + o1 * o1) * (1.f / 128.f) + RMS_EPS);
        const float z0 = bf2f(Pd[3072 + h * 128 + lane]), z1 = bf2f(Pd[3072 + h * 128 + lane + 64]);
        const float r0 = o0 * rstd * A.in[12][lane] * silu_f(z0), r1 = o1 * rstd * A.in[12][lane + 64] * silu_f(z1);
        YBd[h * 128 + lane] = (bf16_t)(pack2(r0, 0.f) & 0xffffu); YBd[h * 128 + lane + 64] = (bf16_t)(pack2(r1, 0.f) & 0xffffu);
    }
    __syncthreads();
}

constexpr int GS_SB0 = 0, GS_SB1 = 8704, GS_VN = 17408;
__device__ __forceinline__ void gdn_scan_item(LAS unsigned char* lds, const Args& A, int item, int tid_in) {
    const int tid = tid_in, wid = tid >> 6, lane = tid & 63, fr = lane & 15, fq = lane >> 4;
    const int xcd = item & 7, slot = item >> 3, pair = xcd * 8 + (slot >> 2);
    const int vs = slot & 3, h = pair & 7, b = pair >> 3;
    const int ti = wid >> 1, tv = wid & 1;
    const bf16_t* UTb = (const bf16_t*)(A.ws + WS_UT); const bf16_t* WNb = (const bf16_t*)(A.ws + WS_WN);
    const bf16_t* QDb = (const bf16_t*)(A.ws + WS_QD); const bf16_t* KDTb = (const bf16_t*)(A.ws + WS_KDT);
    const bf16_t* QKb = (const bf16_t*)(A.ws + WS_QK); const float* EGL = (const float*)(A.ws + WS_EGL);
    float* O = (float*)(A.ws + WS_O);
    for (int e = tid; e < 8704 / 4; e += 512) ((LAS unsigned*)(lds + GS_SB0))[e] = 0u;
    f32x4 sacc[2]; sacc[0] = (f32x4){0.f, 0.f, 0.f, 0.f}; sacc[1] = sacc[0];
    __syncthreads();
    const int chunk0 = (b * 8 + h) * 32;
    bf16x8 nfw0[4], nfqd0[4], nfqk0[2], nfkd0[2]; u32x2 nuu0; float ndecay0;
    bf16x8 nfw1[4], nfqd1[4], nfqk1[2], nfkd1[2]; u32x2 nuu1; float ndecay1;
#define GS_LOAD(S, ch) { const size_t _c = (size_t)(ch); \
        _Pragma("unroll") for (int kk = 0; kk < 4; ++kk) { nfw##S[kk] = *(const bf16x8*)(WNb + _c * 8192 + (ti * 16 + fr) * 128 + kk * 32 + fq * 8); nfqd##S[kk] = *(const bf16x8*)(QDb + _c * 8192 + (ti * 16 + fr) * 128 + kk * 32 + fq * 8); } \
        _Pragma("unroll") for (int kk = 0; kk < 2; ++kk) { nfqk##S[kk] = *(const bf16x8*)(QKb + _c * 4096 + (ti * 16 + fr) * 64 + kk * 32 + fq * 8); nfkd##S[kk] = *(const bf16x8*)(KDTb + _c * 8192 + (wid * 16 + fr) * 64 + kk * 32 + fq * 8); } \
        nuu##S = *(const u32x2*)(UTb + _c * 8192 + (vs * 32 + tv * 16 + fr) * 64 + ti * 16 + fq * 4); ndecay##S = EGL[_c]; }
#define GS_STEP(S, nn, SBC, SBN, DOLOAD) { \
        bf16x8 fw[4], fqd[4], fqk[2], fkd[2]; \
        _Pragma("unroll") for (int kk = 0; kk < 4; ++kk) { fw[kk] = nfw##S[kk]; fqd[kk] = nfqd##S[kk]; } \
        _Pragma("unroll") for (int kk = 0; kk < 2; ++kk) { fqk[kk] = nfqk##S[kk]; fkd[kk] = nfkd##S[kk]; } \
        const u32x2 uu = nuu##S; const float decay = ndecay##S; \
        if (DOLOAD) { GS_LOAD(S, chunk0 + (nn) + 2) } \
        f32x4 acc = (f32x4){lo_f(uu.x), hi_f(uu.x), lo_f(uu.y), hi_f(uu.y)}; \
        bf16x8 fs[4]; \
        _Pragma("unroll") for (int kk = 0; kk < 4; ++kk) { fs[kk] = *(const LAS bf16x8*)(lds + (SBC) + ((tv * 16 + fr) * 136 + kk * 32 + fq * 8) * 2); acc = mfma16(fw[kk], fs[kk], acc); } \
        *(LAS u32x2*)(lds + GS_VN + ((tv * 16 + fr) * 72 + ti * 16 + fq * 4) * 2) = pack4(acc); \
        lds_barrier(); \
        f32x4 ao = (f32x4){0.f, 0.f, 0.f, 0.f}; \
        _Pragma("unroll") for (int kk = 0; kk < 4; ++kk) ao = mfma16(fs[kk], fqd[kk], ao); \
        bf16x8 fv[2][2]; \
        _Pragma("unroll") for (int t2 = 0; t2 < 2; ++t2) _Pragma("unroll") for (int kk = 0; kk < 2; ++kk) fv[t2][kk] = *(const LAS bf16x8*)(lds + GS_VN + ((t2 * 16 + fr) * 72 + kk * 32 + fq * 8) * 2); \
        _Pragma("unroll") for (int kk = 0; kk < 2; ++kk) { const bf16x8 fvo = *(const LAS bf16x8*)(lds + GS_VN + ((tv * 16 + fr) * 72 + kk * 32 + fq * 8) * 2); ao = mfma16(fvo, fqk[kk], ao); } \
        *(f32x4*)(O + ((size_t)b * SL + (nn) * 64 + ti * 16 + fr) * 1024 + h * 128 + vs * 32 + tv * 16 + fq * 4) = ao; \
        _Pragma("unroll") for (int t2 = 0; t2 < 2; ++t2) { sacc[t2] = sacc[t2] * decay; \
            _Pragma("unroll") for (int kk = 0; kk < 2; ++kk) sacc[t2] = mfma16(fkd[kk], fv[t2][kk], sacc[t2]); \
            *(LAS u32x2*)(lds + (SBN) + ((t2 * 16 + fr) * 136 + wid * 16 + fq * 4) * 2) = pack4(sacc[t2]); } \
        lds_barrier(); }
    GS_LOAD(0, chunk0) GS_LOAD(1, chunk0 + 1)
    for (int n = 0; n < 32; n += 8) {
        __builtin_amdgcn_s_waitcnt(0x0F70);
        GS_STEP(0, n, GS_SB0, GS_SB1, 1) GS_STEP(1, n + 1, GS_SB1, GS_SB0, 1) GS_STEP(0, n + 2, GS_SB0, GS_SB1, 1) GS_STEP(1, n + 3, GS_SB1, GS_SB0, 1)
        GS_STEP(0, n + 4, GS_SB0, GS_SB1, 1) GS_STEP(1, n + 5, GS_SB1, GS_SB0, 1) GS_STEP(0, n + 6, GS_SB0, GS_SB1, (n + 8 < 32)) GS_STEP(1, n + 7, GS_SB1, GS_SB0, (n + 9 < 32))
    }
#undef GS_STEP
#undef GS_LOAD
    float* So = A.out + O_GSP + (size_t)(b * 8 + h) * 16384;
#pragma unroll
    for (int t2 = 0; t2 < 2; ++t2)
#pragma unroll
        for (int r = 0; r < 4; ++r) So[(wid * 16 + fq * 4 + r) * 128 + vs * 32 + t2 * 16 + fr] = sacc[t2][r];
    __syncthreads();
}

__device__ __forceinline__ void gdn_gate_row(const Args& A, size_t row, int lane) {
    const float* O = (const float*)(A.ws + WS_O) + row * 1024 + lane * 16;
    const bf16_t* Z = (const bf16_t*)(A.ws + WS_PROJ) + row * 4096 + 3072 + lane * 16;
    bf16_t* Y = (bf16_t*)(A.ws + WS_YB) + row * 1024 + lane * 16;
    const float* nw = A.in[12] + (lane & 7) * 16;
    float o[16]; float ss = 0.f;
#pragma unroll
    for (int i = 0; i < 4; ++i) { const f32x4 v = ((const f32x4*)O)[i]; o[4 * i] = v[0]; o[4 * i + 1] = v[1]; o[4 * i + 2] = v[2]; o[4 * i + 3] = v[3]; ss += (v[0] * v[0] + v[1] * v[1]) + (v[2] * v[2] + v[3] * v[3]); }
    ss += __shfl_xor(ss, 1); ss += __shfl_xor(ss, 2); ss += __shfl_xor(ss, 4);
    const float rstd = __builtin_amdgcn_rsqf(ss * (1.f / 128.f) + RMS_EPS);
    float z[16]; { float t[8]; unpack8(((const u32x4*)Z)[0], t);
#pragma unroll
        for (int j = 0; j < 8; ++j) z[j] = t[j];
        unpack8(((const u32x4*)Z)[1], t);
#pragma unroll
        for (int j = 0; j < 8; ++j) z[8 + j] = t[j]; }
    float r[8];
#pragma unroll
    for (int hh = 0; hh < 2; ++hh) {
#pragma unroll
        for (int j = 0; j < 8; ++j) r[j] = o[hh * 8 + j] * rstd * nw[hh * 8 + j] * silu_f(z[hh * 8 + j]);
        ((u32x4*)Y)[hh] = pack8(r);
    }
}
__device__ __forceinline__ void gdn_gate_row2(const Args& A, size_t row, int lane) {
    const float* O = (const float*)(A.ws + WS_O) + row * 1024 + lane * 16;
    const bf16_t* Z = (const bf16_t*)(A.ws + WS_PROJ) + row * 4096 + 3072 + lane * 16;
    bf16_t* Y = (bf16_t*)(A.ws + WS_YB) + row * 1024 + lane * 16;
    const float* nw = A.in[12] + (lane & 7) * 16;
    f32x4 ov[2][4]; u32x4 zv[2][2];
#pragma unroll
    for (int rr = 0; rr < 2; ++rr) {
#pragma unroll
        for (int i = 0; i < 4; ++i) ov[rr][i] = ((const f32x4*)(O + rr * 1024))[i];
        zv[rr][0] = ((const u32x4*)(Z + rr * 4096))[0]; zv[rr][1] = ((const u32x4*)(Z + rr * 4096))[1];
    }
#pragma unroll
    for (int rr = 0; rr < 2; ++rr) {
        float ss = 0.f;
#pragma unroll
        for (int i = 0; i < 4; ++i) ss += (ov[rr][i][0] * ov[rr][i][0] + ov[rr][i][1] * ov[rr][i][1]) + (ov[rr][i][2] * ov[rr][i][2] + ov[rr][i][3] * ov[rr][i][3]);
        ss += __shfl_xor(ss, 1); ss += __shfl_xor(ss, 2); ss += __shfl_xor(ss, 4);
        const float rstd = __builtin_amdgcn_rsqf(ss * (1.f / 128.f) + RMS_EPS);
#pragma unroll
        for (int hh = 0; hh < 2; ++hh) { float z[8], r[8]; unpack8(zv[rr][hh], z);
#pragma unroll
            for (int j = 0; j < 8; ++j) r[j] = ov[rr][hh * 2 + (j >> 2)][j & 3] * rstd * nw[hh * 8 + j] * silu_f(z[j]);
            ((u32x4*)(Y + rr * 1024))[hh] = pack8(r); }
    }
}

__device__ __forceinline__ void ssd_conv_item(const Args& A, int item, int tid_in) {
    const int t = tid_in; if (t >= 384) return;
    const int c0 = t * 8, r0 = item * 16, tb = r0 & (SL - 1), b = r0 >> 11;
    const bf16_t* P = (const bf16_t*)(A.ws + WS_PROJ);
    bf16_t* XA = (bf16_t*)(A.ws + WS_XA); bf16_t* BCA = (bf16_t*)(A.ws + WS_BCA);
    u32x4 xq[19];
#pragma unroll
    for (int r = 0; r < 19; ++r) xq[r] = (tb == 0 && r < 3) ? (u32x4){0u, 0u, 0u, 0u} : *(const u32x4*)(P + (size_t)(r0 + r - 3) * 5120 + 2048 + c0);
    float w[4][8], bb[8];
#pragma unroll
    for (int j = 0; j < 8; ++j) { bb[j] = A.in[16][c0 + j];
#pragma unroll
        for (int k = 0; k < 4; ++k) w[k][j] = A.in[15][k * 3072 + c0 + j]; }
    float p3[8], p2[8], p1[8];
    unpack8(xq[0], p3); unpack8(xq[1], p2); unpack8(xq[2], p1);
#pragma unroll
    for (int r = 0; r < 16; ++r) {
        const size_t row = (size_t)(r0 + r);
        float cur[8], o[8];
        unpack8(xq[r + 3], cur);
#pragma unroll
        for (int j = 0; j < 8; ++j) o[j] = silu_f(bb[j] + w[0][j] * p3[j] + w[1][j] * p2[j] + w[2][j] * p1[j] + w[3][j] * cur[j]);
        if (c0 < 2048) *(u32x4*)(XA + row * 2048 + c0) = pack8(o); else *(u32x4*)(BCA + row * 1024 + (c0 - 2048)) = pack8(o);
        const int tt = tb + r;
        if (tt >= SL - 3) { float* cp = A.out + O_SCP + ((size_t)b * 3 + (tt - (SL - 3))) * 3072 + c0;
#pragma unroll
            for (int j = 0; j < 8; ++j) cp[j] = cur[j]; }
#pragma unroll
        for (int j = 0; j < 8; ++j) { p3[j] = p2[j]; p2[j] = p1[j]; p1[j] = cur[j]; }
    }
}

__device__ __forceinline__ void ssd_dec_item(LAS unsigned char* lds, const Args& A, int item, int tid_in) {
    const int tid = tid_in, wid = tid >> 6, lane = tid & 63;
    const int g = item & 3, b = item >> 2;
    const bf16_t* Pd = (const bf16_t*)(A.ws + WS_PROJD) + (size_t)b * NUP; const float* BAd = (const float*)(A.ws + WS_BAD) + b * 32;
    bf16_t* YBd = (bf16_t*)(A.ws + WS_YBD) + (size_t)b * DFF;
    LAS float* xs = (LAS float*)lds; LAS float* Bs = xs + 512; LAS float* Cs = xs + 640; LAS float* ys = xs + 768; LAS float* dts = xs + 1280; LAS float* dAs = xs + 1288; LAS float* red = xs + 1296;
    for (int c = tid; c < 768; c += 512) {
        const int xc = (c < 512) ? (g * 512 + c) : (c < 640) ? (2048 + g * 128 + (c - 512)) : (2560 + g * 128 + (c - 640));
        const float* cin = A.in[(4)] + (size_t)b * 3 * 3072 + xc;
        const float c0 = cin[0], c1 = cin[3072], c2 = cin[6144], nw = bf2f(Pd[2048 + xc]);
        const float* cw = A.in[(15)] + xc;
        xs[c] = silu_f(A.in[(16)][xc] + cw[0] * c0 + cw[3072] * c1 + cw[6144] * c2 + cw[9216] * nw);
        float* co = A.out + O_SCS + (size_t)b * 3 * 3072 + xc; co[0] = c1; co[3072] = c2; co[6144] = nw;
    }
    if (tid < 8) { const int h = g * 8 + tid; const float dt = softplus_f(BAd[h] + A.in[(18)][h]); dts[tid] = dt; dAs[tid] = __expf(-__expf(A.in[(17)][h]) * dt); }
    __syncthreads();
    const int sl = tid & 31, pr = tid >> 5;
    const f32x4 B4 = *(const LAS f32x4*)(Bs + sl * 4), C4 = *(const LAS f32x4*)(Cs + sl * 4);
    const float* Sin0 = A.in[(5)] + ((size_t)(b * 32 + g * 8) * 64) * 128 + sl * 4;
    float* Sout0 = A.out + O_SSS + ((size_t)(b * 32 + g * 8) * 64) * 128 + sl * 4;
    f32x4 Snx[4];
#pragma unroll
    for (int it = 0; it < 4; ++it) Snx[it] = __builtin_nontemporal_load((const f32x4*)(Sin0 + (it * 16 + pr) * 128));
#pragma unroll
    for (int j = 0; j < 8; ++j) {
        const float dt = dts[j], dA = dAs[j];
        f32x4 S[4];
#pragma unroll
        for (int it = 0; it < 4; ++it) S[it] = Snx[it];
        if (j + 1 < 8) {
#pragma unroll
            for (int it = 0; it < 4; ++it) Snx[it] = __builtin_nontemporal_load((const f32x4*)(Sin0 + (size_t)(j + 1) * 8192 + (it * 16 + pr) * 128));
        }
#pragma unroll
        for (int it = 0; it < 4; ++it) { const int p = it * 16 + pr; const float xd = xs[j * 64 + p] * dt;
            const f32x4 Sn = S[it] * dA + B4 * xd; __builtin_nontemporal_store(Sn, (f32x4*)(Sout0 + (size_t)j * 8192 + p * 128));
            float y = (Sn[0] * C4[0] + Sn[1] * C4[1]) + (Sn[2] * C4[2] + Sn[3] * C4[3]);
            y += DPP_F(y, 0xB1, 0xf); y += DPP_F(y, 0x4E, 0xf); y += DPP_F(y, 0x141, 0xf); y += DPP_F(y, 0x140, 0xf); y += DPP_F(y, 0x142, 0xa);
            if (sl == 31) ys[j * 64 + p] = y; }
    }
    __syncthreads();
    {
        const int c = tid, h = g * 8 + (c >> 6);
        const float y = (ys[c] + A.in[(19)][h] * xs[c]) * silu_f(bf2f(Pd[g * 512 + c]));
        const float s = wave_sum(y * y); if (lane == 0) red[wid] = s;
        __syncthreads();
        float tot = 0.f;
#pragma unroll
        for (int w = 0; w < 8; ++w) tot += red[w];
        const float r = y * __builtin_amdgcn_rsqf(tot * (1.f / 512.f) + RMS_EPS) * A.in[(20)][g * 512 + c];
        YBd[g * 512 + c] = (bf16_t)(pack2(r, 0.f) & 0xffffu);
    }
    __syncthreads();
}

constexpr int SS_XT = 0, SS_XDT = 9216, SS_BT = 18432, SS_SC = 36864, SS_SB0 = 46080, SS_SB1 = 63488, SS_BS = 80896, SS_CS = 98304, SS_AC = 115712, SS_DT = 115968;
__device__ __forceinline__ void ssd_step(LAS unsigned char* lds, bf16_t* __restrict__ Y, const size_t t0, const int h, const int sbc, const int sbn,
                                         const u32x4 px, const u32x4 pb0, const u32x4 pb1, const u32x4 pc0, const u32x4 pc1, const float pdt,
                                         const float aneg, const float dtb, const float Dh, f32x4 (&sacc)[4], const int tid) {
    const int wid = tid >> 6, lane = tid & 63, fr = lane & 15, fq = lane >> 4, ti = wid >> 1;
    const int jx = tid >> 3, xm = tid & 7, jb0 = tid >> 4, jb1 = 32 + (tid >> 4), bm = tid & 15;
    LAS float* acum = (LAS float*)(lds + SS_AC); LAS float* dtv = (LAS float*)(lds + SS_DT);
        if (wid == 0) { const float dt = softplus_f(pdt + dtb); const float ac = wave_incl_scan(dt * aneg, lane); acum[lane] = ac; dtv[lane] = dt; }
        *(LAS u32x4*)(lds + SS_BS + (jb0 * 136 + bm * 8) * 2) = pb0; *(LAS u32x4*)(lds + SS_BS + (jb1 * 136 + bm * 8) * 2) = pb1;
        *(LAS u32x4*)(lds + SS_CS + (jb0 * 136 + bm * 8) * 2) = pc0; *(LAS u32x4*)(lds + SS_CS + (jb1 * 136 + bm * 8) * 2) = pc1;
        lds_barrier();
        const float alast = acum[63];
        {
            const float sx = dtv[jx] * __expf(alast - acum[jx]);
            const int colx = (((jx >> 3) ^ xm) * 8 + (jx & 7)) * 2;
            const unsigned wx[4] = {px.x, px.y, px.z, px.w};
#pragma unroll
            for (int q = 0; q < 8; ++q) { const unsigned w = wx[q >> 1]; const unsigned short raw = (q & 1) ? (unsigned short)(w >> 16) : (unsigned short)(w & 0xffffu);
                const float xv = bf2f(raw); const int rowb = (xm * 8 + q) * 144;
                *(LAS unsigned short*)(lds + SS_XT + rowb + colx) = raw;
                *(LAS unsigned short*)(lds + SS_XDT + rowb + colx) = (unsigned short)(pack2(xv * sx, 0.f) & 0xffffu); }
            const int colb0 = (((jb0 >> 3) ^ (bm & 7)) * 8 + (jb0 & 7)) * 2, colb1 = (((jb1 >> 3) ^ (bm & 7)) * 8 + (jb1 & 7)) * 2;
            const unsigned wb0[4] = {pb0.x, pb0.y, pb0.z, pb0.w}, wb1[4] = {pb1.x, pb1.y, pb1.z, pb1.w};
#pragma unroll
            for (int q = 0; q < 8; ++q) { const int rowb = (bm * 8 + q) * 144;
                *(LAS unsigned short*)(lds + SS_BT + rowb + colb0) = (q & 1) ? (unsigned short)(wb0[q >> 1] >> 16) : (unsigned short)(wb0[q >> 1] & 0xffffu);
                *(LAS unsigned short*)(lds + SS_BT + rowb + colb1) = (q & 1) ? (unsigned short)(wb1[q >> 1] >> 16) : (unsigned short)(wb1[q >> 1] & 0xffffu); }
        }
        bf16x8 fc[4];
#pragma unroll
        for (int kk = 0; kk < 4; ++kk) fc[kk] = *(const LAS bf16x8*)(lds + SS_CS + ((ti * 16 + fr) * 136 + kk * 32 + fq * 8) * 2);
#pragma unroll
        for (int tjj = 0; tjj < 2; ++tjj) {
            const int tj = (wid & 1) * 2 + tjj;
            f32x4 acc = (f32x4){0.f, 0.f, 0.f, 0.f};
            if (tj <= ti) {
#pragma unroll
                for (int kk = 0; kk < 4; ++kk) { const bf16x8 fb = *(const LAS bf16x8*)(lds + SS_BS + ((tj * 16 + fr) * 136 + kk * 32 + fq * 8) * 2); acc = mfma16(fb, fc[kk], acc); }
            }
            const int i = ti * 16 + fr; const float ai = acum[i]; f32x4 sc;
#pragma unroll
            for (int r = 0; r < 4; ++r) { const int j = tj * 16 + fq * 4 + r; sc[r] = (i >= j) ? acc[r] * __expf(ai - acum[j]) * dtv[j] : 0.f; }
            *(LAS u32x2*)(lds + SS_SC + (i * 72 + tj * 16 + fq * 4) * 2) = pack4(sc);
        }
        lds_barrier();
        {
            bf16x8 fsc[2];
#pragma unroll
            for (int kk = 0; kk < 2; ++kk) fsc[kk] = *(const LAS bf16x8*)(lds + SS_SC + ((ti * 16 + fr) * 72 + kk * 32 + fq * 8) * 2);
            const int i = ti * 16 + fr; const float ea = __expf(acum[i]);
#pragma unroll
            for (int tpp = 0; tpp < 2; ++tpp) {
                const int tp = (wid & 1) * 2 + tpp, prow = tp * 16 + fr, psw = (prow >> 3) & 7;
                f32x4 a1 = (f32x4){0.f, 0.f, 0.f, 0.f}, a2 = (f32x4){0.f, 0.f, 0.f, 0.f};
#pragma unroll
                for (int kk = 0; kk < 2; ++kk) { const bf16x8 fx = *(const LAS bf16x8*)(lds + SS_XT + (prow * 72 + (((kk * 4 + fq) ^ psw) * 8)) * 2); a1 = mfma16(fx, fsc[kk], a1); }
#pragma unroll
                for (int kk = 0; kk < 4; ++kk) { const bf16x8 fs = *(const LAS bf16x8*)(lds + sbc + (prow * 136 + kk * 32 + fq * 8) * 2); a2 = mfma16(fs, fc[kk], a2); }
                const int p0 = tp * 16 + fq * 4;
                const int xcol = (((i >> 3) ^ ((p0 >> 3) & 7)) * 8 + (i & 7)) * 2;
                f32x4 y = a1 + a2 * ea;
#pragma unroll
                for (int r = 0; r < 4; ++r) y[r] += Dh * bf2f(*(const LAS unsigned short*)(lds + SS_XT + (p0 + r) * 144 + xcol));
                *(u32x2*)(Y + (t0 + i) * 2048 + h * 64 + p0) = pack4(y);
            }
        }
        {
            const int tp = wid >> 1, prow = tp * 16 + fr, psw = (prow >> 3) & 7; const float el = __expf(alast);
            bf16x8 fxd[2];
#pragma unroll
            for (int kk = 0; kk < 2; ++kk) fxd[kk] = *(const LAS bf16x8*)(lds + SS_XDT + (prow * 72 + (((kk * 4 + fq) ^ psw) * 8)) * 2);
#pragma unroll
            for (int q = 0; q < 4; ++q) { const int ts = (wid & 1) * 4 + q, srow = ts * 16 + fr, ssw = (srow >> 3) & 7; sacc[q] = sacc[q] * el;
#pragma unroll
                for (int kk = 0; kk < 2; ++kk) { const bf16x8 fb = *(const LAS bf16x8*)(lds + SS_BT + (srow * 72 + (((kk * 4 + fq) ^ ssw) * 8)) * 2); sacc[q] = mfma16(fb, fxd[kk], sacc[q]); }
                *(LAS u32x2*)(lds + sbn + (prow * 136 + ts * 16 + fq * 4) * 2) = pack4(sacc[q]); }
        }
        lds_barrier();
}

__device__ __forceinline__ void ssd_scan_item(LAS unsigned char* lds, const Args& A, int item, int tid_in) {
    const int tid = tid_in, wid = tid >> 6, lane = tid & 63, fr = lane & 15, fq = lane >> 4;
    const int xcd = item & 7, slot = item >> 3, grp = xcd * 4 + (slot >> 3);
    const int b = grp >> 2, g = grp & 3, h = g * 8 + (slot & 7);
    const bf16_t* XA = (const bf16_t*)(A.ws + WS_XA); const bf16_t* BCA = (const bf16_t*)(A.ws + WS_BCA); const float* BA = (const float*)(A.ws + WS_BA);
    bf16_t* Y = (bf16_t*)(A.ws + WS_YB);
    LAS float* acum = (LAS float*)(lds + SS_AC); LAS float* dtv = (LAS float*)(lds + SS_DT);
    const float aneg = -__expf(A.in[17][h]), dtb = A.in[18][h], Dh = A.in[19][h];
    for (int e = tid; e < 17408 / 4; e += 512) ((LAS unsigned*)(lds + SS_SB0))[e] = 0u;
    f32x4 sacc[4];
#pragma unroll
    for (int q = 0; q < 4; ++q) sacc[q] = (f32x4){0.f, 0.f, 0.f, 0.f};
    int cur = 0;
    const int ti = wid >> 1;
    const int jx = tid >> 3, xm = tid & 7;
    const int jb0 = tid >> 4, jb1 = 32 + (tid >> 4), bm = tid & 15;
    u32x4 npx0, npb00, npb10, npc00, npc10; float npdt0 = 0.f;
    u32x4 npx1, npb01, npb11, npc01, npc11; float npdt1 = 0.f;
#define SS_LOAD(S, nn) { const size_t _t0 = (size_t)b * SL + (nn) * 64; \
        npx##S = *(const u32x4*)(XA + (_t0 + jx) * 2048 + h * 64 + xm * 8); \
        npb0##S = *(const u32x4*)(BCA + (_t0 + jb0) * 1024 + g * 128 + bm * 8); npb1##S = *(const u32x4*)(BCA + (_t0 + jb1) * 1024 + g * 128 + bm * 8); \
        npc0##S = *(const u32x4*)(BCA + (_t0 + jb0) * 1024 + 512 + g * 128 + bm * 8); npc1##S = *(const u32x4*)(BCA + (_t0 + jb1) * 1024 + 512 + g * 128 + bm * 8); \
        if (wid == 0) npdt##S = BA[(_t0 + lane) * 32 + h]; }
#define SS_STEP(S, nn, DOLOAD) { \
        const size_t t0 = (size_t)b * SL + (nn) * 64; \
        const int sbc = cur ? SS_SB1 : SS_SB0, sbn = cur ? SS_SB0 : SS_SB1; \
        const u32x4 px = npx##S, pb0 = npb0##S, pb1 = npb1##S, pc0 = npc0##S, pc1 = npc1##S; const float pdt = npdt##S; \
        if (DOLOAD) { SS_LOAD(S, (nn) + 2) } \
        ssd_step(lds, Y, t0, h, sbc, sbn, px, pb0, pb1, pc0, pc1, pdt, aneg, dtb, Dh, sacc, tid); \
        cur ^= 1; }
    SS_LOAD(0, 0) SS_LOAD(1, 1)
    __syncthreads();
    for (int n = 0; n < 28; n += 4) {
        __builtin_amdgcn_s_waitcnt(0x0F70);
        SS_STEP(0, n, 1) SS_STEP(1, n + 1, 1) SS_STEP(0, n + 2, 1) SS_STEP(1, n + 3, 1)
    }
    __builtin_amdgcn_s_waitcnt(0x0F70);
    SS_STEP(0, 28, 1) SS_STEP(1, 29, 1) SS_STEP(0, 30, 0) SS_STEP(1, 31, 0)
#undef SS_STEP
#undef SS_LOAD
    {
        const int tp = wid >> 1; float* So = A.out + O_SSP + (size_t)(b * 32 + h) * 8192;
#pragma unroll
        for (int q = 0; q < 4; ++q) { const int ts = (wid & 1) * 4 + q; *(f32x4*)(So + (tp * 16 + fr) * 128 + ts * 16 + fq * 4) = sacc[q]; }
    }
    __syncthreads();
}

__device__ __forceinline__ void ssd_gate_row(const Args& A, size_t row, int lane) {
    bf16_t* Y = (bf16_t*)(A.ws + WS_YB) + row * 2048; const bf16_t* Z = (const bf16_t*)(A.ws + WS_PROJ) + row * 5120;
    u32x4 yq[4], zq[4];
#pragma unroll
    for (int g = 0; g < 4; ++g) { yq[g] = *(const u32x4*)(Y + g * 512 + lane * 8); zq[g] = *(const u32x4*)(Z + g * 512 + lane * 8); }
#pragma unroll
    for (int g = 0; g < 4; ++g) {
        const int c0 = g * 512 + lane * 8; float y[8], z[8];
        unpack8(yq[g], y); unpack8(zq[g], z);
        float ss = 0.f;
#pragma unroll
        for (int j = 0; j < 8; ++j) { y[j] *= silu_f(z[j]); ss += y[j] * y[j]; }
        const float rstd = __builtin_amdgcn_rsqf(wave_sum(ss) * (1.f / 512.f) + RMS_EPS);
        const float* nw = A.in[20] + c0;
#pragma unroll
        for (int j = 0; j < 8; ++j) y[j] = y[j] * rstd * nw[j];
        *(u32x4*)(Y + c0) = pack8(y);
    }
}


__constant__ int P0_BASE[8] = {0, 544, 672, 1344, 1600, 2304, 3008, 3360};
__constant__ int P0_IN[8] = {7, 13, 14, 21, 22, 22, 25, 25};
__constant__ unsigned P0_INOFF[8] = {0, 0, 0, 0, 0, 1024u * 5632u, 0, 2816u * 1024u};
__constant__ unsigned P0_WOFS[8] = {(unsigned)WS_WGI, (unsigned)WS_WGO, (unsigned)WS_WSI, (unsigned)WS_WSO, (unsigned)WS_WUP0, (unsigned)WS_WUP1, (unsigned)WS_WDN0, (unsigned)WS_WDN1};
__constant__ int P0_K[8] = {1024, 1024, 1024, 2048, 1024, 1024, 2816, 2816};
__constant__ int P0_N[8] = {4112, 1024, 5152, 1024, 5632, 5632, 1024, 1024};

#define XB_TMO      128
#define XB_XCNT(j)  (256  + 64 * (j))
#define XB_XSUB(j)  (1280 + 64 * (j))
#define XB_XGEN(j)  (2304 + 64 * (j))
#define XB_TOP      3328
#define XB_TOPGEN   3392
#define XCD_BAR_WORDS 3456
#define XB_SPIN_CAP (1u << 18)
__device__ __forceinline__ unsigned xb_ld(unsigned* p)              { return __hip_atomic_load(p, __ATOMIC_RELAXED, __HIP_MEMORY_SCOPE_AGENT); }
__device__ __forceinline__ unsigned xb_add(unsigned* p, unsigned v) { return __hip_atomic_fetch_add(p, v, __ATOMIC_RELAXED, __HIP_MEMORY_SCOPE_AGENT); }
__device__ __forceinline__ unsigned xb_xcc_id() { return (unsigned)__builtin_amdgcn_s_getreg((3 << 11) | 20) & 0xFu; }
#define XB_SPIN(cond, bar) do { unsigned _sp = 0; while (cond) { __builtin_amdgcn_s_sleep(1); \
    if ((++_sp & 255u) == 0u) { if (xb_ld(&(bar)[XB_TMO])) break; if (_sp > XB_SPIN_CAP) { atomicAdd(&(bar)[XB_TMO], 1u); break; } } } } while (0)
struct XcdBarrier { unsigned* bar; unsigned x; volatile LAS unsigned* st; };
__device__ __forceinline__ XcdBarrier xcd_barrier_post(unsigned* bar, volatile LAS unsigned* st) {
    XcdBarrier b; b.bar = bar; b.x = xb_xcc_id(); b.st = st;
    if (threadIdx.x == 0) (void)xb_add(&bar[XB_XCNT(b.x)], 1u);
    return b;
}
__device__ __forceinline__ void xcd_barrier_complete(unsigned* bar, unsigned x, unsigned& nloc, unsigned& nx) {
    const unsigned G = gridDim.x * gridDim.y * gridDim.z;
    unsigned sum, cnt, mine, sp = 0u;
    for (;;) {
        sum = 0u; cnt = 0u; mine = 0u;
#pragma unroll
        for (unsigned j = 0; j < 16; ++j) { const unsigned c = xb_ld(&bar[XB_XCNT(j)]); sum += c; cnt += (c > 0u) ? 1u : 0u; mine = (j == x) ? c : mine; }
        if (sum == G) break;
        __builtin_amdgcn_s_sleep(1);
        if ((++sp & 255u) == 0u) { if (xb_ld(&bar[XB_TMO])) break; if (sp > XB_SPIN_CAP) { atomicAdd(&bar[XB_TMO], 1u); break; } }
    }
    nloc = mine > 0u ? mine : 1u; nx = cnt > 0u ? cnt : 1u;
}
__device__ __forceinline__ void xcd_barrier(const XcdBarrier& b, int tid) {
    asm volatile("s_waitcnt vmcnt(0)" ::: "memory");
    __syncthreads();
    if (tid == 0) {
        unsigned* bar = b.bar;
        __builtin_amdgcn_s_waitcnt(0);
        unsigned nloc = b.st[0], nx = b.st[1];
        if (nloc == 0u) { xcd_barrier_complete(bar, b.x, nloc, nx); b.st[0] = nloc; b.st[1] = nx; }
        const unsigned old = xb_add(&bar[XB_XSUB(b.x)], 1u);
        const unsigned gen = old / nloc;
        if (old + 1u == (gen + 1u) * nloc) {
            __builtin_amdgcn_fence(__ATOMIC_RELEASE, "agent");
            asm volatile("s_waitcnt vmcnt(0)" ::: "memory");
            const unsigned og = xb_add(&bar[XB_TOP], 1u);
            const unsigned tg = og / nx;
            if (og + 1u == (tg + 1u) * nx) xb_add(&bar[XB_TOPGEN], 1u);
            else XB_SPIN(xb_ld(&bar[XB_TOPGEN]) == tg, bar);
            __builtin_amdgcn_fence(__ATOMIC_ACQUIRE, "agent");
            xb_add(&bar[XB_XGEN(b.x)], 1u);
            asm volatile("s_waitcnt vmcnt(0)" ::: "memory");
        } else {
            XB_SPIN(xb_ld(&bar[XB_XGEN(b.x)]) == gen, bar);
            __builtin_amdgcn_fence(__ATOMIC_ACQUIRE, "agent");
            asm volatile("s_waitcnt vmcnt(0)" ::: "memory");
        }
    }
    __syncthreads();
}

#ifndef PHMASK
#define PHMASK 0xffffff
#endif
#define EN(k) ((PHMASK >> (k)) & 1)
constexpr int NPHASE = 21;
__global__ void __launch_bounds__(512, 2) fwd_kernel(Args A) {
    __shared__ __attribute__((aligned(16))) unsigned char lds_raw[LDS_BYTES];
    LAS unsigned char* lds = (LAS unsigned char*)lds_raw;
    const int wave_s = __builtin_amdgcn_readfirstlane((int)threadIdx.x >> 6);
#define TID make_tid(wave_s)
    if (threadIdx.x < 4) ((LAS unsigned*)(lds + 131072))[threadIdx.x] = 0u;
    __syncthreads();
    (void)xcd_barrier_post((unsigned*)(A.ws + WS_BARR), (volatile LAS unsigned*)(lds + 131072));
    if (A.ph_hi > NPHASE) cg::this_grid().sync();
#ifndef REPMASK
#define REPMASK 0
#endif
    const int ph_end = __builtin_amdgcn_readfirstlane(A.ph_hi);
    int rep_done = 0;
    for (int ph = __builtin_amdgcn_readfirstlane(A.ph_lo); ph < ph_end; ) {
        {
        int G = gridDim.x, bid = blockIdx.x; asm volatile("" : "+s"(G), "+s"(bid));
        unsigned long long zoff = 0; asm volatile("" : "+s"(zoff));
        unsigned char* ws = A.ws + zoff;
        const bool is_gemm = (ph == 1) | (ph == 5) | (ph == 7) | (ph == 9) | (ph == 11) | (ph == 15) | (ph == 17) | (ph == 19);
        const bool is_ln = (ph == 6) | (ph == 10) | (ph == 16) | (ph == 20);
        if (EN(1) && is_gemm) {
            const bf16_t* Ap = (const bf16_t*)(ws + WS_XB); const bf16_t* Ad = (const bf16_t*)(ws + WS_XBD); int ldad = 1024;
            size_t wofs = WS_WGI, oofs = WS_PROJ, dofs = WS_PROJD; int N = 4096, K = 1024, ldo = 4096, nbf = 4096, nf = 16, ncg = 65, ldp = NUP;
            if (ph == 5) { Ap = (const bf16_t*)(ws + WS_YB); Ad = (const bf16_t*)(ws + WS_YBD); ldad = DFF; wofs = WS_WGO; N = 1024; K = 1024; }
            else if (ph == 7 || ph == 17) { wofs = (ph == 7) ? WS_WUP0 : WS_WUP1; N = NUP; K = 1024; ldo = NUP; nbf = NUP; nf = 0; ncg = 88; }
            else if (ph == 9 || ph == 19) { Ap = (const bf16_t*)(ws + WS_YB); Ad = (const bf16_t*)(ws + WS_YBD); ldad = DFF; wofs = (ph == 9) ? WS_WDN0 : WS_WDN1; N = 1024; K = DFF; }
            else if (ph == 11) { wofs = WS_WSI; N = 5120; K = 1024; ldo = 5120; nbf = 5120; nf = 32; ncg = 81; }
            else if (ph == 15) { Ap = (const bf16_t*)(ws + WS_YB); Ad = (const bf16_t*)(ws + WS_YBD); ldad = DFF; wofs = WS_WSO; N = 1024; K = 2048; }
            if (N == 1024) { oofs = WS_H; dofs = WS_HD; ldo = 1024; nbf = 1024; nf = 0; ncg = 16; ldp = 1024; }
            const bf16_t* Bt = (const bf16_t*)(ws + wofs);
            pg8::Gemm g{Ap, Bt, MP, N, K}; pg8::StaticOrder S; S.init(MP, N, G, bid);
            const bool gated = (ph == 7) | (ph == 17); const int lyr = (ph == 17);
            if (gated) oofs = WS_YB;
            pg8::EpiUni E{gated ? 2 : 1, (bf16_t*)(ws + oofs), ldo,
                          A.in[23] + (size_t)lyr * 3 * DFF, A.in[24] + (size_t)lyr * DFF, (float*)(ws + WS_XF), A.out + O_FCP + (size_t)lyr * 8 * 2 * DFF};
            pg8::gemm_phase(lds, g, S, E, TID);
            DecStore st{ldp, nbf, nf, (bf16_t*)(ws + dofs), (float*)(ws + WS_BAD)};
            {
                const int rxt = S.nwg % G, nfree = G - rxt;
                if (bid >= rxt) for (int it = bid - rxt; it < 8 * ncg; it += nfree) small_gemm_item(lds, Ad, ldad, Bt, K, it, st, TID);
            }
            if (ph == 1) { for (int it = bid; it < MP / 128; it += G) narrow_item<1>(Ap, Bt + (size_t)4096 * 1024, 1024, (float*)(ws + WS_BA), it, TID); }
            if (ph == 11) { for (int it = bid; it < MP / 128; it += G) narrow_item<2>(Ap, Bt + (size_t)5120 * 1024, 1024, (float*)(ws + WS_BA), it, TID); }
        } else if (EN(6) && is_ln) {
            const int tid = TID, wid = tid >> 6, lane = tid & 63; (void)tid;
            const int layer = (ph >= 16); const bool fin = (ph == 20), is2 = (ph == 10) | (ph == 20);
            const float* gam = A.in[is2 ? 28 : 26] + layer * 1024; const float* bet = A.in[is2 ? 29 : 27] + layer * 1024;
            bf16_t* XB = (bf16_t*)(ws + WS_XB); bf16_t* XBd = (bf16_t*)(ws + WS_XBD);
            const bf16_t* H = (const bf16_t*)(ws + WS_H); const bf16_t* Hd = (const bf16_t*)(ws + WS_HD);
            for (int it = bid; it < (MP + DB) / 16; it += G) { const int row = it * 16 + wid * 2;
                if (row < MP) { const size_t o0 = (size_t)row * 1024, o1 = o0 + 1024;
                    ln_row2(XB + o0, H + o0, XB + o1, H + o1, gam, bet, fin ? A.out + O_YP + o0 : (float*)nullptr, fin ? (bf16_t*)nullptr : XB + o0, fin ? A.out + O_YP + o1 : (float*)nullptr, fin ? (bf16_t*)nullptr : XB + o1, lane); }
                else { const size_t o0 = (size_t)(row - MP) * 1024, o1 = o0 + 1024;
                    ln_row2(XBd + o0, Hd + o0, XBd + o1, Hd + o1, gam, bet, fin ? A.out + O_YS + o0 : (float*)nullptr, fin ? (bf16_t*)nullptr : XBd + o0, fin ? A.out + O_YS + o1 : (float*)nullptr, fin ? (bf16_t*)nullptr : XBd + o1, lane); } }
        } else if (EN(0) && ph == 0) {
            const int tid = TID, wid = tid >> 6, lane = tid & 63; (void)tid; (void)wid; (void)lane;
#define P0_DESC(it) \
            int mi = 0; \
            _Pragma("unroll") for (int q = 1; q < 8; ++q) mi += ((it) >= P0_BASE[q]) ? 1 : 0; \
            const float* W = A.in[P0_IN[mi]] + P0_INOFF[mi]; bf16_t* Wt = (bf16_t*)(ws + P0_WOFS[mi]); const int K = P0_K[mi], N = P0_N[mi]; \
            const int idx = (it) - P0_BASE[mi], nk = K / 128, k0 = (idx % nk) * 128, n0 = (idx / nk) * 64; \
            const int ns0 = (mi == 4 || mi == 5) ? (((n0 >> 7) & 1) * DFF + (n0 >> 8) * 128 + (n0 & 127)) : n0;
            for (int it = bid; it < 1032; it += G) {
                if (it < 1024) convert_rows16(A.in[0] + (size_t)it * 16 * 1024, (bf16_t*)(ws + WS_XB) + (size_t)it * 16 * 1024, TID);
                else convert_rows16(A.in[1] + (size_t)(it - 1024) * 16 * 1024, (bf16_t*)(ws + WS_XBD) + (size_t)(it - 1024) * 16 * 1024, TID);
            }
            LAS float* s = (LAS float*)lds;
            float rr[16];
            if (bid < 3712) { P0_DESC(bid)
#pragma unroll
                for (int i = 0; i < 16; ++i) { const int e = i * 512 + tid, kk = e >> 6, nn = e & 63, n = ns0 + nn; rr[i] = (n < N) ? __builtin_nontemporal_load(W + (size_t)(k0 + kk) * N + n) : 0.f; } }
            for (int it = bid; it < 3712; it += G) {
#pragma unroll
                for (int i = 0; i < 16; ++i) { const int e = i * 512 + tid, kk = e >> 6, nn = e & 63; s[nn * 129 + kk] = rr[i]; }
                __syncthreads();
                if (it + G < 3712) { P0_DESC(it + G)
#pragma unroll
                    for (int i = 0; i < 16; ++i) { const int e = i * 512 + tid, kk = e >> 6, nn = e & 63, n = ns0 + nn; rr[i] = (n < N) ? __builtin_nontemporal_load(W + (size_t)(k0 + kk) * N + n) : 0.f; } }
                { P0_DESC(it)
#pragma unroll
                    for (int i = 0; i < 8; ++i) { const int e = i * 512 + tid, nn = e >> 6, kp = e & 63;
                        *(unsigned*)(Wt + (size_t)(n0 + nn) * K + k0 + 2 * kp) = pack2(s[nn * 129 + 2 * kp], s[nn * 129 + 2 * kp + 1]); } }
                __syncthreads();
            }
#undef P0_DESC
        } else if (EN(2) && ph == 2) {
            gdn_a_phase(lds, A, bid, G, TID);
#ifndef NO_DEC
            for (int it = bid; it < 1024; it += G) gdn_dec_item(lds, A, it, TID);
#endif
        } else if (EN(3) && ph == 3) {
            for (int it = bid; it < 256; it += G) gdn_scan_item(lds, A, it, TID);
        } else if (EN(4) && ph == 4) {
            const int tid = TID, wid = tid >> 6, lane = tid & 63; (void)tid; (void)wid; (void)lane;
            for (int it = bid; it < MP / 16; it += G) gdn_gate_row2(A, (size_t)it * 16 + wid * 2, lane);
        } else if (EN(8) && (ph == 8 || ph == 18)) {
            const int layer = (ph == 18);
            const float* cw = A.in[23] + (size_t)layer * 3 * DFF; const float* cb = A.in[24] + (size_t)layer * DFF;
            for (int it = bid; it < 256 + 8; it += G) {
                if (it < 256) ffn_fixup_item((const float*)(ws + WS_XF), (const float*)(ws + WS_XF) + (size_t)256 * 2 * DFF, (bf16_t*)(ws + WS_YB), cw, it, TID);
                else ffn_gate_dec_item((const bf16_t*)(ws + WS_PROJD), (bf16_t*)(ws + WS_YBD), cw, cb, A.in[6] + (size_t)layer * 128 * 2 * DFF, A.out + O_FCS + (size_t)layer * 128 * 2 * DFF, it - 256, TID); }
        } else if (EN(12) && ph == 12) {
            for (int it = bid; it < MP / 16; it += G) ssd_conv_item(A, it, TID);
            __syncthreads();
            for (int it = bid; it < 512; it += G) ssd_dec_item(lds, A, it, TID);
        } else if (EN(13) && ph == 13) {
            for (int it = bid; it < 256; it += G) ssd_scan_item(lds, A, it, TID);
        } else if (EN(14) && ph == 14) {
            const int tid = TID, wid = tid >> 6, lane = tid & 63; (void)tid; (void)wid; (void)lane;
            for (int it = bid; it < MP / 8; it += G) ssd_gate_row(A, (size_t)it * 8 + wid, lane);
        }
        }
        const bool again = (((unsigned)REPMASK >> ph) & 1u) && !rep_done;
        rep_done = again ? 1 : 0;
        const int phn = __builtin_amdgcn_readfirstlane(again ? ph : ph + 1);
        if (phn < ph_end) {
            { XcdBarrier xbar; xbar.bar = (unsigned*)(A.ws + WS_BARR); xbar.x = xb_xcc_id(); xbar.st = (volatile LAS unsigned*)(lds + 131072); xcd_barrier(xbar, TID); }
        }
        ph = phn;
    }
}

extern "C" void kernel_launch(void* const* d_in, const int* in_sizes, int n_in, void* d_out, int out_size, void* d_ws, size_t ws_size, hipStream_t stream) {
    static int grid = 0;
    if (grid == 0) {
        if (n_in != 30 || ws_size < WS_END) { fprintf(stderr, "kernel_launch: need 30 inputs and >= %zu bytes of workspace (got %d, %zu)\n", (size_t)WS_END, n_in, ws_size); grid = -1; return; }
        int dev = 0, cus = 0, per_cu = 0;
        (void)hipGetDevice(&dev); (void)hipDeviceGetAttribute(&cus, hipDeviceAttributeMultiprocessorCount, dev);
        if (hipOccupancyMaxActiveBlocksPerMultiprocessor(&per_cu, (const void*)fwd_kernel, 512, 0) != hipSuccess || per_cu < 1) { fprintf(stderr, "kernel_launch: occupancy query failed (%d)\n", per_cu); per_cu = 1; (void)hipGetLastError(); }
        grid = cus * per_cu;
    }
    if (grid < 0) return;
    if (hipMemsetAsync((char*)d_ws + WS_BARR, 0, 16384, stream) != hipSuccess) { fprintf(stderr, "kernel_launch: memset of barrier words failed\n"); return; }
    Args a{};
    for (int i = 0; i < 30; ++i) a.in[i] = (const float*)d_in[i];
    a.out = (float*)d_out; a.ws = (unsigned char*)d_ws;
#if ONE_LAUNCH
    a.ph_lo = 0; a.ph_hi = NPHASE;
    void* args[] = {&a};
    hipError_t e = hipLaunchCooperativeKernel((const void*)fwd_kernel, dim3(grid), dim3(512), args, 0, stream);
    if (e != hipSuccess) fprintf(stderr, "cooperative launch failed: %s (grid %d)\n", hipGetErrorString(e), grid);
#else
#ifndef NPH_RUN
#define NPH_RUN NPHASE
#endif
    for (int p = 0; p < NPH_RUN; ++p) { a.ph_lo = p; a.ph_hi = p + 1; hipLaunchKernelGGL(fwd_kernel, dim3(grid), dim3(512), 0, stream, a); }
#endif
}
```

```cpp
#include <hip/hip_runtime.h>
#include <hip/hip_cooperative_groups.h>
#include <cstdio>
namespace cg = cooperative_groups;

#ifndef ONE_LAUNCH
#define ONE_LAUNCH 1
#endif

#define LAS __attribute__((address_space(3)))
typedef unsigned short bf16_t;
typedef short bf16x8 __attribute__((ext_vector_type(8)));
typedef float f32x4 __attribute__((ext_vector_type(4)));
typedef float f32x2 __attribute__((ext_vector_type(2)));
typedef unsigned u32x4 __attribute__((ext_vector_type(4)));
typedef unsigned u32x2 __attribute__((ext_vector_type(2)));

constexpr int D = 1024, BP = 8, SL = 2048, MP = BP * SL, DB = 128;
constexpr int GH = 8, GIN = 4112, GINP = 4352;
constexpr int SIN = 5152, SINP = 5376, SINNER = 2048, SHEADS = 32;
constexpr int DFF = 2816, NUP = 5632;
constexpr float DN_ALPHA = 1.4142135623730951f;
constexpr float LN_EPS = 1e-5f, RMS_EPS = 1e-6f;

constexpr size_t MB = 1u << 20;
constexpr size_t WS_WGI = 0, WS_WGO = 17 * MB / 2, WS_WSI = 21 * MB / 2, WS_WSO = 21 * MB, WS_WUP0 = 25 * MB, WS_WUP1 = 36 * MB,
                 WS_WDN0 = 47 * MB, WS_WDN1 = 105 * MB / 2, WS_XB = 58 * MB, WS_XF = 90 * MB, WS_PROJ = 154 * MB, WS_H = 330 * MB,
                 WS_YB = 394 * MB, WS_BA = 482 * MB, WS_DEC = 484 * MB;
constexpr size_t WS_XBD = WS_DEC, WS_XFD = WS_XBD + 256 * 1024, WS_PROJD = WS_XFD + 512 * 1024, WS_BAD = WS_PROJD + 1441792,
                 WS_HD = WS_BAD + 16384, WS_YBD = WS_HD + 512 * 1024, WS_EGL = WS_YBD + 720896, WS_BARR = WS_EGL + 8192, WS_END = WS_BARR + 16384;
constexpr size_t WS_UT = WS_YB, WS_WN = WS_YB + 32 * MB, WS_QK = WS_YB + 64 * MB, WS_QD = WS_PROJ + 128 * MB, WS_KDT = WS_XF;
constexpr size_t WS_O = WS_H, WS_XA = WS_H, WS_BCA = WS_XF;

constexpr size_t O_YP = 0, O_YS = 16777216, O_GCP = 16908288, O_GCS = 16982016, O_GSP = 18161664, O_GSS = 19210240, O_SCP = 35987456,
                 O_SCS = 36061184, O_SSP = 37240832, O_SSS = 39337984, O_FCP = 72892416, O_FCS = 72982528;

constexpr int LDS_BYTES = 131072 + 2048;

__device__ __forceinline__ int make_tid(int wave_s) { unsigned ones = ~0u; asm volatile("" : "+s"(ones)); int t = wave_s * 64 + (int)__builtin_amdgcn_mbcnt_hi(ones, __builtin_amdgcn_mbcnt_lo(ones, 0u)); asm volatile("" : "+v"(t)); return t; }
__device__ __forceinline__ float bf2f(unsigned b) { return __uint_as_float(b << 16); }
typedef __bf16 bf16x2_t __attribute__((ext_vector_type(2)));
__device__ __forceinline__ unsigned pack2(float lo, float hi) { const f32x2 v = {lo, hi}; const bf16x2_t b = __builtin_convertvector(v, bf16x2_t); return __builtin_bit_cast(unsigned, b); }
__device__ __forceinline__ float lo_f(unsigned w) { return __uint_as_float(w << 16); }
__device__ __forceinline__ float hi_f(unsigned w) { return __uint_as_float(w & 0xffff0000u); }
__device__ __forceinline__ float silu_f(float x) { return x * __builtin_amdgcn_rcpf(1.f + __expf(-x)); }
__device__ __forceinline__ float sigmoid_f(float x) { return __builtin_amdgcn_rcpf(1.f + __expf(-x)); }
__device__ __forceinline__ float softplus_f(float x) { return x > 20.f ? x : log1pf(__expf(x)); }
#define DPP_F(x, ctrl, rmask) __builtin_bit_cast(float, __builtin_amdgcn_update_dpp(0, __builtin_bit_cast(int, (x)), (ctrl), (rmask), 0xf, false))
__device__ __forceinline__ float wave_sum(float v) {
    v += DPP_F(v, 0xB1, 0xf);
    v += DPP_F(v, 0x4E, 0xf);
    v += DPP_F(v, 0x141, 0xf);
    v += DPP_F(v, 0x140, 0xf);
    v += DPP_F(v, 0x142, 0xa);
    v += DPP_F(v, 0x143, 0xc);
    return __builtin_bit_cast(float, __builtin_amdgcn_readlane(__builtin_bit_cast(int, v), 63));
}
__device__ __forceinline__ float wave_incl_scan(float v, int lane) {
#pragma unroll
    for (int o = 1; o < 64; o <<= 1) { float t = __shfl_up(v, o); if (lane >= o) v += t; }
    return v;
}
__device__ __forceinline__ f32x4 mfma16(bf16x8 a, bf16x8 b, f32x4 c) { return __builtin_amdgcn_mfma_f32_16x16x32_bf16(a, b, c, 0, 0, 0); }
__device__ __forceinline__ void lds_barrier() { asm volatile("s_waitcnt lgkmcnt(0)" ::: "memory"); __builtin_amdgcn_s_barrier(); asm volatile("" ::: "memory"); }
__device__ __forceinline__ u32x2 pack4(f32x4 v) { u32x2 r; r.x = pack2(v[0], v[1]); r.y = pack2(v[2], v[3]); return r; }

namespace pg8 {
constexpr int BM = 256, BK = 64, HALF = 128, HTB = HALF * BK * 2, STAGE_BYTES = 8 * HTB, NXCD = 8, WGM = 8;
__device__ __forceinline__ int lds_byte(int r, int c) { const int st = (r >> 4) * 2 + (c >> 5), rr = r & 15, cc = c & 31, ob = rr * 64 + cc * 2; return st * 1024 + (ob ^ (((ob >> 9) & 1) << 5)); }
__device__ __forceinline__ void stage_rc(int b, int& R, int& C) { const int st = b / 1024, sb = b % 1024, swz = sb ^ (((sb >> 9) & 1) << 5); R = (st >> 1) * 16 + swz / 64; C = (st & 1) * 32 + (swz % 64) / 2; }
__device__ __forceinline__ int perm32(int rho) { const int n = rho >> 4, i = rho & 15; return 8 * (i >> 2) + 4 * n + (i & 3); }
struct Unit { int pm, pn; };
struct Gemm { const bf16_t* A; const bf16_t* Bt; int M, N, K; };
struct StaticOrder {
    int nM, nN, nwg, G, c;
    __device__ void init(int M, int N, int G_, int c_) { nM = M / BM; nN = N / BM; nwg = nM * nN; G = G_; c = c_; }
    __device__ bool next(int i, Unit& u) const {
        const long L = (long)i * G + c; if (L >= nwg) return false;
        int wgid = (int)L; { const int q = nwg / NXCD, r = nwg % NXCD, xcd = wgid % NXCD, off = wgid / NXCD; wgid = (xcd < r ? xcd * (q + 1) : r * (q + 1) + (xcd - r) * q) + off; }
        const int nig = WGM * nN, gid = wgid / nig, fm = gid * WGM, gsz = (nM - fm) < WGM ? (nM - fm) : WGM;
        u.pm = fm + ((wgid % nig) % gsz); u.pn = (wgid % nig) / gsz; return true;
    }
};
struct EpiF32 {
    static constexpr bool PERM = false;
    float* C; int ldc;
    __device__ __forceinline__ void operator()(const f32x4 (&acc)[2][2][4][2], const Unit& u, int wr, int wc, int fr, int fq) const {
        const int row0 = u.pm * BM + wr * 64 + fr, col0 = u.pn * BM + wc * 32 + 4 * fq;
#pragma unroll
        for (int ai = 0; ai < 2; ++ai)
#pragma unroll
            for (int m = 0; m < 4; ++m) { float* rowp = C + (size_t)(row0 + ai * HALF + m * 16) * ldc + col0;
#pragma unroll
                for (int bj = 0; bj < 2; ++bj)
#pragma unroll
                    for (int n = 0; n < 2; ++n) *(f32x4*)(rowp + bj * HALF + n * 16) = acc[ai][bj][m][n]; }
    }
};
struct EpiBf16 {
    static constexpr bool PERM = true;
    bf16_t* O; int ldo;
    __device__ __forceinline__ void operator()(const f32x4 (&acc)[2][2][4][2], const Unit& u, int wr, int wc, int fr, int fq) const {
        const int row0 = u.pm * BM + wr * 64 + fr, col0 = u.pn * BM + wc * 32 + 8 * fq;
#pragma unroll
        for (int ai = 0; ai < 2; ++ai)
#pragma unroll
            for (int m = 0; m < 4; ++m) { bf16_t* rowp = O + (size_t)(row0 + ai * HALF + m * 16) * ldo + col0;
#pragma unroll
                for (int bj = 0; bj < 2; ++bj) { const f32x4 v0 = acc[ai][bj][m][0], v1 = acc[ai][bj][m][1];
                    u32x4 w; w.x = pack2(v0[0], v0[1]); w.y = pack2(v0[2], v0[3]); w.z = pack2(v1[0], v1[1]); w.w = pack2(v1[2], v1[3]);
                    *(u32x4*)(rowp + bj * HALF) = w; } }
    }
};
__device__ __forceinline__ float dpp_ror1(float x) { return __builtin_bit_cast(float, __builtin_amdgcn_update_dpp(0, __builtin_bit_cast(int, x), 0x121, 0xf, 0xf, false)); }
__device__ __forceinline__ float dpp_ror2(float x) { return __builtin_bit_cast(float, __builtin_amdgcn_update_dpp(0, __builtin_bit_cast(int, x), 0x122, 0xf, 0xf, false)); }
struct EpiGate {
    bf16_t* HB; const float* cw; const float* cb; float* edge; float* first; float* cache;
    __device__ __forceinline__ void operator()(const f32x4 (&acc)[2][2][4][2], const Unit& u, int wr, int wc, int fr_, int fq_) const {
        int fr = fr_, fq = fq_; asm volatile("" : "+v"(fr), "+v"(fq));
#pragma unroll
        for (int n = 0; n < 2; ++n) {
            const int ch = u.pn * 128 + wc * 32 + 8 * fq + 4 * n;
            const f32x4 w0 = *(const f32x4*)(cw + ch), w1 = *(const f32x4*)(cw + DFF + ch), w2 = *(const f32x4*)(cw + 2 * DFF + ch), bb = *(const f32x4*)(cb + ch);
#pragma unroll
            for (int ai = 0; ai < 2; ++ai) {
                const int strip = u.pm * 4 + ai * 2 + wr;
                f32x4 pr1 = (f32x4){0.f, 0.f, 0.f, 0.f}, pr2 = pr1;
#pragma unroll
                for (int m = 0; m < 4; ++m) {
                    const f32x4 g = acc[ai][0][m][n], v = acc[ai][1][m][n];
                    f32x4 c1, c2;
#pragma unroll
                    for (int j = 0; j < 4; ++j) { c1[j] = dpp_ror1(g[j]); c2[j] = dpp_ror2(g[j]); }
                    const f32x4 p1 = (m == 0 || fr >= 1) ? c1 : pr1;
                    const f32x4 p2 = (m == 0 || fr >= 2) ? c2 : pr2;
                    pr1 = c1; pr2 = c2;
                    const size_t row = (size_t)u.pm * 256 + ai * 128 + wr * 64 + m * 16 + fr;
                    if (m == 0 && fr < 2) {
                        const f32x4 pa = (fr == 0) ? (bb + w2 * g) : (bb + w1 * p1 + w2 * g);
                        float* fp = first + ((size_t)strip * 2 + fr) * (2 * DFF) + ch;
                        *(f32x4*)fp = pa; *(f32x4*)(fp + DFF) = v;
                    } else {
                        const f32x4 y = bb + w0 * p2 + w1 * p1 + w2 * g; f32x4 o;
#pragma unroll
                        for (int j = 0; j < 4; ++j) o[j] = silu_f(y[j]) * v[j];
                        *(u32x2*)(HB + row * DFF + ch) = pack4(o);
                    }
                    if (m == 3 && fr >= 14) {
                        *(f32x4*)(edge + ((size_t)strip * 2 + (fr - 14)) * DFF + ch) = g;
                        if ((strip & 31) == 31) *(f32x4*)(cache + ((size_t)(strip >> 5) * 2 + (fr - 14)) * DFF + ch) = g;
                    }
                }
            }
        }
    }
};
struct EpiUni {
    int mode; bf16_t* O; int ldo; const float* cw; const float* cb; float* aux; float* cache;
    __device__ __forceinline__ void operator()(const f32x4 (&acc)[2][2][4][2], const Unit& u, int wr, int wc, int fr_, int fq_) const {
        (void)fr_; (void)fq_;
        unsigned ones = ~0u; asm volatile("" : "+s"(ones));
        const int lane_e = (int)__builtin_amdgcn_mbcnt_hi(ones, __builtin_amdgcn_mbcnt_lo(ones, 0u)), fr = lane_e & 15, fq = lane_e >> 4;
        if (mode == 2) { EpiGate e{O, cw, cb, aux, aux + (size_t)256 * 2 * DFF, cache}; e(acc, u, wr, wc, fr, fq); }
        else { EpiBf16 e{O, ldo}; e(acc, u, wr, wc, fr, fq); }
    }
};

template <class Epi, class Sched>
__device__ __forceinline__ void gemm_phase(LAS unsigned char* lds, const Gemm g, const Sched& S, const Epi& E, int tid_in) {
    const int tid = tid_in, wid = __builtin_amdgcn_readfirstlane(tid >> 6), lane = tid & 63, wr = wid >> 2, wc = wid & 3, fr = lane & 15, fq = lane >> 4;
    const int K = g.K, nt = K / BK;
    unsigned voffA[2], voffB[2];
#pragma unroll
    for (int i = 0; i < 2; ++i) { int R, C; stage_rc(tid * 16 + i * 8192, R, C); const int Rb = (E.mode != 0) ? ((R & ~31) + perm32(R & 31)) : R;
        voffA[i] = (unsigned)(R * K + C) * 2u; voffB[i] = (unsigned)(Rb * K + C) * 2u; }
    const size_t kstep = (size_t)(BK * 2);
    const size_t hstep = (size_t)HALF * K * 2;
    const size_t tstep = 2 * hstep;
    const unsigned ldsw = (unsigned)wid * 1024u;
    const int aoff = lds_byte(wr * 64 + fr, fq * 8), boff = lds_byte(wc * 32 + fr, fq * 8);
#define PG8_SA(b, h) (((b) * 2 + (h)) * HTB)
#define PG8_SB(b, h) ((4 + (b) * 2 + (h)) * HTB)
#define PG8_STAGE(bufoff, gbase, voff) do { _Pragma("unroll") for (int _i = 0; _i < 2; ++_i) \
        __builtin_amdgcn_global_load_lds((const unsigned*)((const char*)(gbase) + (voff)[_i]), (LAS unsigned*)(lds + (bufoff) + ldsw + _i * 8192), 16, 0, 0); } while (0)
#define PG8_LDA(dst, b, h) do { _Pragma("unroll") for (int m = 0; m < 4; ++m) _Pragma("unroll") for (int k = 0; k < 2; ++k) dst[m][k] = *(const LAS bf16x8*)(lds + PG8_SA(b, h) + aoff + m * 2048 + k * 1024); } while (0)
#define PG8_LDB(dst, b, h) do { _Pragma("unroll") for (int n = 0; n < 2; ++n) _Pragma("unroll") for (int k = 0; k < 2; ++k) dst[n][k] = *(const LAS bf16x8*)(lds + PG8_SB(b, h) + boff + n * 2048 + k * 1024); } while (0)
#define PG8_MMA(ai, bj, At, Bt) do { __builtin_amdgcn_s_setprio(1); _Pragma("unroll") for (int m = 0; m < 4; ++m) _Pragma("unroll") for (int n = 0; n < 2; ++n) _Pragma("unroll") for (int k = 0; k < 2; ++k) \
        acc[ai][bj][m][n] = __builtin_amdgcn_mfma_f32_16x16x32_bf16(Bt[n][k], At[m][k], acc[ai][bj][m][n], 0, 0, 0); __builtin_amdgcn_s_setprio(0); } while (0)
#define PG8_WAIT_V(n) asm volatile("s_waitcnt vmcnt(" #n ")" ::: "memory")
#define PG8_WAIT_L(n) asm volatile("s_waitcnt lgkmcnt(" #n ")" ::: "memory")
#define PG8_BAR __builtin_amdgcn_s_barrier()
#define PG8_SCHED __builtin_amdgcn_sched_barrier(0)
    Unit cur, nxt; int ui = 0;
    if (!S.next(0, cur)) return;
    f32x4 acc[2][2][4][2];
#pragma unroll
    for (int a = 0; a < 2; ++a)
#pragma unroll
        for (int b = 0; b < 2; ++b)
#pragma unroll
            for (int m = 0; m < 4; ++m)
#pragma unroll
                for (int n = 0; n < 2; ++n) acc[a][b][m][n] = (f32x4){0.f, 0.f, 0.f, 0.f};
    bf16x8 At[4][2], B0[2][2], B1[2][2];
    const char* cA = (const char*)g.A + (size_t)cur.pm * tstep; const char* cB = (const char*)g.Bt + (size_t)cur.pn * tstep;
    PG8_STAGE(PG8_SB(0, 0), cB, voffB); PG8_STAGE(PG8_SA(0, 0), cA, voffA); PG8_STAGE(PG8_SB(0, 1), cB + hstep, voffB); PG8_STAGE(PG8_SA(0, 1), cA + hstep, voffA);
    if (wr == 1) PG8_BAR;
    PG8_WAIT_V(4); PG8_BAR;
    PG8_STAGE(PG8_SB(1, 0), cB + kstep, voffB); PG8_STAGE(PG8_SA(1, 0), cA + kstep, voffA); PG8_STAGE(PG8_SB(1, 1), cB + hstep + kstep, voffB);
    PG8_WAIT_V(6); PG8_BAR;
    for (;;) {
        const bool has_next = S.next(ui + 1, nxt);
        const char* nA = has_next ? (const char*)g.A + (size_t)nxt.pm * tstep : cA; const char* nB = has_next ? (const char*)g.Bt + (size_t)nxt.pn * tstep : cB;
        for (int t = 0; t < nt; t += 2) {
            const bool last = (t == nt - 2);
            const char* a1 = cA + (size_t)(t + 1) * kstep;
            const char* a2 = last ? nA : cA + (size_t)(t + 2) * kstep; const char* b2 = last ? nB : cB + (size_t)(t + 2) * kstep;
            const char* a3 = a2 + kstep; const char* b3 = b2 + kstep;
            PG8_LDB(B0, 0, 0); PG8_SCHED; PG8_LDA(At, 0, 0); PG8_STAGE(PG8_SA(1, 1), a1 + hstep, voffA);
            PG8_WAIT_L(8); PG8_BAR; PG8_WAIT_L(0); PG8_MMA(0, 0, At, B0); PG8_BAR; PG8_SCHED;
            PG8_LDB(B1, 0, 1); PG8_STAGE(PG8_SB(0, 0), b2, voffB);
            PG8_BAR; PG8_WAIT_L(0); PG8_MMA(0, 1, At, B1); PG8_BAR;
            PG8_LDA(At, 0, 1); PG8_STAGE(PG8_SA(0, 0), a2, voffA);
            PG8_BAR; PG8_WAIT_L(0); PG8_MMA(1, 0, At, B0); PG8_BAR; PG8_SCHED;
            PG8_STAGE(PG8_SB(0, 1), b2 + hstep, voffB);
            PG8_WAIT_V(6); PG8_BAR; PG8_MMA(1, 1, At, B1); PG8_BAR;
            PG8_LDB(B0, 1, 0); PG8_SCHED; PG8_LDA(At, 1, 0); PG8_STAGE(PG8_SA(0, 1), a2 + hstep, voffA);
            PG8_WAIT_L(8); PG8_BAR; PG8_WAIT_L(0); PG8_MMA(0, 0, At, B0); PG8_BAR; PG8_SCHED;
            PG8_LDB(B1, 1, 1); PG8_STAGE(PG8_SB(1, 0), b3, voffB);
            PG8_BAR; PG8_WAIT_L(0); PG8_MMA(0, 1, At, B1); PG8_BAR;
            PG8_LDA(At, 1, 1); PG8_STAGE(PG8_SA(1, 0), a3, voffA);
            PG8_BAR; PG8_WAIT_L(0); PG8_MMA(1, 0, At, B0); PG8_BAR; PG8_SCHED;
            PG8_STAGE(PG8_SB(1, 1), b3 + hstep, voffB);
            PG8_WAIT_V(6); PG8_BAR; PG8_MMA(1, 1, At, B1); PG8_BAR;
        }
        E(acc, cur, wr, wc, fr, fq);
        if (!has_next) break;
#pragma unroll
        for (int a = 0; a < 2; ++a)
#pragma unroll
            for (int b = 0; b < 2; ++b)
#pragma unroll
                for (int m = 0; m < 4; ++m)
#pragma unroll
                    for (int n = 0; n < 2; ++n) acc[a][b][m][n] = (f32x4){0.f, 0.f, 0.f, 0.f};
        cur = nxt; cA = nA; cB = nB; ++ui;
    }
    PG8_WAIT_V(0);
    if (wr == 0) PG8_BAR;
    PG8_BAR;
#undef PG8_SA
#undef PG8_SB
#undef PG8_STAGE
#undef PG8_LDA
#undef PG8_LDB
#undef PG8_MMA
#undef PG8_WAIT_V
#undef PG8_WAIT_L
#undef PG8_BAR
#undef PG8_SCHED
}
}

struct Args {
    const float* in[30];
    float* out;
    unsigned char* ws;
    int ph_lo, ph_hi;
};

struct DecStore {
    int ldp, nbf, nf; bf16_t* Pd; float* BAd;
    __device__ __forceinline__ void operator()(int row, int col, float v0, float v1) const {
        if (col < nbf) { *(unsigned*)(Pd + (size_t)row * ldp + col) = pack2(v0, v1); }
        else if (col < nbf + nf) { BAd[row * 32 + col - nbf] = v0; BAd[row * 32 + col - nbf + 1] = v1; }
    }
};
__device__ __forceinline__ void small_gemm_item(LAS unsigned char* lds, const bf16_t* __restrict__ A, int lda, const bf16_t* __restrict__ Bt, int K, int item, const DecStore& st, int tid_in) {
    const int tid = tid_in, wid = tid >> 6, lane = tid & 63, fr = lane & 15, fq = lane >> 4;
    const int rg = item & 7, cgp = item >> 3;
    const int kw = K >> 3;
    const bf16_t* ap = A + (size_t)(rg * 16 + fr) * lda + wid * kw + fq * 8;
    const bf16_t* bp = Bt + (size_t)(cgp * 64 + fr) * K + wid * kw + fq * 8;
    f32x4 acc[4];
#pragma unroll
    for (int n = 0; n < 4; ++n) acc[n] = (f32x4){0.f, 0.f, 0.f, 0.f};
    int k0 = 0;
    for (; k0 + 128 <= kw; k0 += 128) {
        bf16x8 a[4], bq[4][4];
#pragma unroll
        for (int q = 0; q < 4; ++q) { a[q] = *(const bf16x8*)(ap + k0 + 32 * q);
#pragma unroll
            for (int n = 0; n < 4; ++n) bq[q][n] = *(const bf16x8*)(bp + (size_t)n * 16 * K + k0 + 32 * q); }
#pragma unroll
        for (int q = 0; q < 4; ++q)
#pragma unroll
            for (int n = 0; n < 4; ++n) acc[n] = mfma16(a[q], bq[q][n], acc[n]);
    }
    for (; k0 < kw; k0 += 32) {
        const bf16x8 a = *(const bf16x8*)(ap + k0);
#pragma unroll
        for (int n = 0; n < 4; ++n) { const bf16x8 b = *(const bf16x8*)(bp + (size_t)n * 16 * K + k0); acc[n] = mfma16(a, b, acc[n]); }
    }
    LAS float* red = (LAS float*)lds;
#pragma unroll
    for (int n = 0; n < 4; ++n)
#pragma unroll
        for (int r = 0; r < 4; ++r) red[wid * 1024 + (fq * 4 + r) * 64 + n * 16 + fr] = acc[n][r];
    __syncthreads();
    {
        const int row = tid >> 5, c2 = (tid & 31) * 2; float v0 = 0.f, v1 = 0.f;
#pragma unroll
        for (int w = 0; w < 8; ++w) { v0 += red[w * 1024 + row * 64 + c2]; v1 += red[w * 1024 + row * 64 + c2 + 1]; }
        st(rg * 16 + row, cgp * 64 + c2, v0, v1);
    }
    __syncthreads();
}

template <int NT>
__device__ __forceinline__ void narrow_item(const bf16_t* __restrict__ A, const bf16_t* __restrict__ Bt, int K, float* __restrict__ BAo, int item, int tid_in) {
    const int tid = tid_in, wid = tid >> 6, lane = tid & 63, fr = lane & 15, fq = lane >> 4;
    const int row0 = item * 128 + wid * 16;
    const bf16_t* ap = A + (size_t)(row0 + fr) * K + fq * 8;
    const bf16_t* bp = Bt + (size_t)fr * K + fq * 8;
    f32x4 acc[NT];
#pragma unroll
    for (int n = 0; n < NT; ++n) acc[n] = (f32x4){0.f, 0.f, 0.f, 0.f};
#pragma unroll 4
    for (int k = 0; k < K; k += 32) {
        const bf16x8 a = *(const bf16x8*)(ap + k);
#pragma unroll
        for (int n = 0; n < NT; ++n) { const bf16x8 bfr = *(const bf16x8*)(bp + (size_t)n * 16 * K + k); acc[n] = mfma16(bfr, a, acc[n]); }
    }
#pragma unroll
    for (int n = 0; n < NT; ++n) *(f32x4*)(BAo + (size_t)(row0 + fr) * 32 + n * 16 + fq * 4) = acc[n];
}

__device__ __forceinline__ void convert_rows16(const float* __restrict__ src, bf16_t* __restrict__ dst, int tid_in) {
#pragma unroll
    for (int i = 0; i < 8; ++i) { const int e = i * 512 + tid_in; const f32x4 v = __builtin_nontemporal_load((const f32x4*)src + e);
        u32x2 w; w.x = pack2(v[0], v[1]); w.y = pack2(v[2], v[3]); ((u32x2*)dst)[e] = w; }
}

__device__ __forceinline__ void unpack8(const u32x4 w, float (&f)[8]) {
    f[0] = lo_f(w.x); f[1] = hi_f(w.x); f[2] = lo_f(w.y); f[3] = hi_f(w.y); f[4] = lo_f(w.z); f[5] = hi_f(w.z); f[6] = lo_f(w.w); f[7] = hi_f(w.w);
}
__device__ __forceinline__ u32x4 pack8(const float (&f)[8]) { u32x4 w; w.x = pack2(f[0], f[1]); w.y = pack2(f[2], f[3]); w.z = pack2(f[4], f[5]); w.w = pack2(f[6], f[7]); return w; }
__device__ __forceinline__ void ln_row(const bf16_t* __restrict__ xres, const bf16_t* __restrict__ h, const float* __restrict__ gam, const float* __restrict__ bet,
                                       float* __restrict__ outF, bf16_t* __restrict__ outB, int lane) {
    float v[2][8]; float s = 0.f;
#pragma unroll
    for (int i = 0; i < 2; ++i) { float a[8], b[8]; unpack8(((const u32x4*)xres)[i * 64 + lane], a); unpack8(((const u32x4*)h)[i * 64 + lane], b);
#pragma unroll
        for (int j = 0; j < 8; ++j) { v[i][j] = a[j] * DN_ALPHA + b[j]; s += v[i][j]; } }
    const float mu = wave_sum(s) * (1.f / 1024.f); float q = 0.f;
#pragma unroll
    for (int i = 0; i < 2; ++i)
#pragma unroll
        for (int j = 0; j < 8; ++j) { v[i][j] -= mu; q += v[i][j] * v[i][j]; }
    const float rstd = __builtin_amdgcn_rsqf(wave_sum(q) * (1.f / 1024.f) + LN_EPS);
#pragma unroll
    for (int i = 0; i < 2; ++i) { float o[8];
#pragma unroll
        for (int hh = 0; hh < 2; ++hh) { const f32x4 g = ((const f32x4*)gam)[i * 128 + lane * 2 + hh], b = ((const f32x4*)bet)[i * 128 + lane * 2 + hh];
#pragma unroll
            for (int j = 0; j < 4; ++j) o[hh * 4 + j] = v[i][hh * 4 + j] * rstd * g[j] + b[j]; }
        if (outB) ((u32x4*)outB)[i * 64 + lane] = pack8(o);
        if (outF) { ((f32x4*)outF)[i * 128 + lane * 2] = (f32x4){o[0], o[1], o[2], o[3]}; ((f32x4*)outF)[i * 128 + lane * 2 + 1] = (f32x4){o[4], o[5], o[6], o[7]}; } }
}

__device__ __forceinline__ void ln_row2(const bf16_t* __restrict__ x0, const bf16_t* __restrict__ h0, const bf16_t* __restrict__ x1, const bf16_t* __restrict__ h1,
                                        const float* __restrict__ gam, const float* __restrict__ bet, float* oF0, bf16_t* oB0, float* oF1, bf16_t* oB1, int lane) {
    u32x4 xa[2][2], ha[2][2];
#pragma unroll
    for (int i = 0; i < 2; ++i) { xa[0][i] = ((const u32x4*)x0)[i * 64 + lane]; ha[0][i] = ((const u32x4*)h0)[i * 64 + lane]; xa[1][i] = ((const u32x4*)x1)[i * 64 + lane]; ha[1][i] = ((const u32x4*)h1)[i * 64 + lane]; }
#pragma unroll
    for (int rr = 0; rr < 2; ++rr) {
        float v[2][8]; float s = 0.f;
#pragma unroll
        for (int i = 0; i < 2; ++i) { float a[8], b[8]; unpack8(xa[rr][i], a); unpack8(ha[rr][i], b);
#pragma unroll
            for (int j = 0; j < 8; ++j) { v[i][j] = a[j] * DN_ALPHA + b[j]; s += v[i][j]; } }
        const float mu = wave_sum(s) * (1.f / 1024.f); float q = 0.f;
#pragma unroll
        for (int i = 0; i < 2; ++i)
#pragma unroll
            for (int j = 0; j < 8; ++j) { v[i][j] -= mu; q += v[i][j] * v[i][j]; }
        const float rstd = __builtin_amdgcn_rsqf(wave_sum(q) * (1.f / 1024.f) + LN_EPS);
        float* outF = rr ? oF1 : oF0; bf16_t* outB = rr ? oB1 : oB0;
#pragma unroll
        for (int i = 0; i < 2; ++i) { float o[8];
#pragma unroll
            for (int hh = 0; hh < 2; ++hh) { const f32x4 g = ((const f32x4*)gam)[i * 128 + lane * 2 + hh], b = ((const f32x4*)bet)[i * 128 + lane * 2 + hh];
#pragma unroll
                for (int j = 0; j < 4; ++j) o[hh * 4 + j] = v[i][hh * 4 + j] * rstd * g[j] + b[j]; }
            if (outB) ((u32x4*)outB)[i * 64 + lane] = pack8(o);
            if (outF) { __builtin_nontemporal_store((f32x4){o[0], o[1], o[2], o[3]}, (f32x4*)outF + i * 128 + lane * 2); __builtin_nontemporal_store((f32x4){o[4], o[5], o[6], o[7]}, (f32x4*)outF + i * 128 + lane * 2 + 1); } }
    }
}

__device__ __forceinline__ void ffn_fixup_item(const float* __restrict__ edge, const float* __restrict__ first, bf16_t* __restrict__ HB, const float* __restrict__ cw, int strip, int tid_in) {
    const int t = tid_in; if (t >= 352) return;
    const int c0 = t * 8;
    const bool has_hist = (strip & 31) != 0;
#pragma unroll
    for (int hh = 0; hh < 2; ++hh) {
        const int ch = c0 + 4 * hh;
        const f32x4 w0 = *(const f32x4*)(cw + ch), w1 = *(const f32x4*)(cw + DFF + ch);
        f32x4 e0 = (f32x4){0.f, 0.f, 0.f, 0.f}, e1 = e0;
        if (has_hist) { e0 = *(const f32x4*)(edge + ((size_t)(strip - 1) * 2 + 0) * DFF + ch); e1 = *(const f32x4*)(edge + ((size_t)(strip - 1) * 2 + 1) * DFF + ch); }
#pragma unroll
        for (int rr = 0; rr < 2; ++rr) {
            const float* fp = first + ((size_t)strip * 2 + rr) * (2 * DFF) + ch;
            const f32x4 pa = *(const f32x4*)fp, v = *(const f32x4*)(fp + DFF);
            const f32x4 y = (rr == 0) ? (pa + w0 * e0 + w1 * e1) : (pa + w0 * e1); f32x4 o;
#pragma unroll
            for (int j = 0; j < 4; ++j) o[j] = silu_f(y[j]) * v[j];
            *(u32x2*)(HB + ((size_t)strip * 64 + rr) * DFF + ch) = pack4(o);
        }
    }
}
__device__ __forceinline__ void ffn_gate_dec_item(const bf16_t* __restrict__ GVd, bf16_t* __restrict__ HBd, const float* __restrict__ cw, const float* __restrict__ cb,
                                                  const float* __restrict__ cache_in  , float* __restrict__ cache_out, int item, int tid_in) {
    const int t = tid_in; if (t >= 352) return;
    const int c0 = t * 8;
    float w0[8], w1[8], w2[8], bb[8];
#pragma unroll
    for (int j = 0; j < 8; ++j) { w0[j] = cw[c0 + j]; w1[j] = cw[DFF + c0 + j]; w2[j] = cw[2 * DFF + c0 + j]; bb[j] = cb[c0 + j]; }
    {
        const int row = item;
        float gcur[8], vv[8], o[8];
        const int cp = 256 * (c0 >> 7) + (c0 & 127);
        unpack8(*(const u32x4*)(GVd + (size_t)row * NUP + cp), gcur); unpack8(*(const u32x4*)(GVd + (size_t)row * NUP + cp + 128), vv);
        const float* ci = cache_in + (size_t)row * 2 * DFF + c0; float* co = cache_out + (size_t)row * 2 * DFF + c0;
#pragma unroll
        for (int j = 0; j < 8; ++j) { const float c0v = ci[j], c1v = ci[DFF + j]; const float y = bb[j] + w0[j] * c0v + w1[j] * c1v + w2[j] * gcur[j]; o[j] = silu_f(y) * vv[j];
            co[j] = c1v; co[DFF + j] = gcur[j]; }
        *(u32x4*)(HBd + (size_t)row * DFF + c0) = pack8(o);
    }
}

constexpr int GA_QS = 0, GA_KS = 17408, GA_VBT = 34816, GA_KBGT = 53248, GA_MS = 71680, GA_TS = 89088, GA_GC = 98304, GA_BT = 98560, GA_TL = 99328, GA_PB = 115712;
__device__ __forceinline__ void gdn_a_phase(LAS unsigned char* lds, const Args& A, int bid, int G, int tid_in) {
    const bf16_t* PROJ = (const bf16_t*)(A.ws + WS_PROJ);
    const float* BA = (const float*)(A.ws + WS_BA);
    float* EGL = (float*)(A.ws + WS_EGL);
    LAS unsigned* Qs = (LAS unsigned*)(lds + GA_QS); LAS unsigned* Ks = (LAS unsigned*)(lds + GA_KS);
    LAS float* Ms = (LAS float*)(lds + GA_MS); LAS bf16_t* Ts = (LAS bf16_t*)(lds + GA_TS);
    LAS float* gc = (LAS float*)(lds + GA_GC); LAS float* bt = (LAS float*)(lds + GA_BT);
    LAS float* Tl = (LAS float*)(lds + GA_TL); LAS float* Pb = (LAS float*)(lds + GA_PB);
    unsigned xw[3][11]; float pbr = 0.f, par = 0.f;
#define GA_IDS int tid = tid_in; asm volatile("" : "+v"(tid)); const int wid = tid >> 6, lane = tid & 63, fr = lane & 15, fq = lane >> 4, i0 = wid * 8, c = 2 * lane; (void)fr; (void)fq;
#define GA_LOAD(it) { const int _n = (it) & 31, _h = ((it) >> 5) & 7, _b = (it) >> 8; \
        _Pragma("unroll") for (int seg = 0; seg < 3; ++seg) _Pragma("unroll") for (int r = 0; r < 11; ++r) { const int t = _n * 64 + i0 + r - 3; \
            xw[seg][r] = *(const unsigned*)(PROJ + ((size_t)_b * SL + (t < 0 ? 0 : t)) * 4096 + seg * 1024 + _h * 128 + c); } \
        if (wid == 0) { const size_t _rb = (size_t)_b * SL + _n * 64 + lane; pbr = BA[_rb * 32 + _h]; par = BA[_rb * 32 + 8 + _h]; } }
    if (bid < 2048) { GA_IDS GA_LOAD(bid) }
    for (int item = bid; item < 2048; item += G) {
        GA_IDS
        const int n = item & 31, h = (item >> 5) & 7, b = item >> 8, chunk = (b * 8 + h) * 32 + n;
        bf16_t* UT = (bf16_t*)(A.ws + WS_UT) + (size_t)chunk * 8192; bf16_t* WN = (bf16_t*)(A.ws + WS_WN) + (size_t)chunk * 8192;
        bf16_t* QD = (bf16_t*)(A.ws + WS_QD) + (size_t)chunk * 8192; bf16_t* KDT = (bf16_t*)(A.ws + WS_KDT) + (size_t)chunk * 8192;
        bf16_t* QK = (bf16_t*)(A.ws + WS_QK) + (size_t)chunk * 4096;
        if (wid == 0) {
            const float g = -__expf(A.in[10][h]) * softplus_f(par + A.in[11][h]);
            const float gcum = wave_incl_scan(g, lane);
            gc[lane] = gcum; bt[lane] = sigmoid_f(pbr);
            if (lane == 63) EGL[chunk] = __expf(gcum);
        }
        lds_barrier();
        {
            const float glast = gc[63];
#pragma unroll
            for (int seg = 0; seg < 3; ++seg) {
                const int col = seg * 1024 + h * 128 + c;
                float w0[4], w1[4];
#pragma unroll
                for (int k = 0; k < 4; ++k) { const f32x2 t = *(const f32x2*)(A.in[8] + k * 3072 + col); w0[k] = t.x; w1[k] = t.y; }
                const f32x2 bb = *(const f32x2*)(A.in[9] + col);
                float x0[11], x1[11];
#pragma unroll
                for (int r = 0; r < 11; ++r) { const bool okr = (n * 64 + i0 + r - 3) >= 0; x0[r] = okr ? lo_f(xw[seg][r]) : 0.f; x1[r] = okr ? hi_f(xw[seg][r]) : 0.f; }
                if (n == 31 && wid == 7) {
#pragma unroll
                    for (int rr = 0; rr < 3; ++rr) *(f32x2*)(A.out + O_GCP + ((size_t)b * 3 + rr) * 3072 + col) = (f32x2){x0[8 + rr], x1[8 + rr]};
                }
                float y0[8], y1[8];
#pragma unroll
                for (int r = 0; r < 8; ++r) {
                    y0[r] = silu_f(bb.x + w0[0] * x0[r] + w0[1] * x0[r + 1] + w0[2] * x0[r + 2] + w0[3] * x0[r + 3]);
                    y1[r] = silu_f(bb.y + w1[0] * x1[r] + w1[1] * x1[r + 1] + w1[2] * x1[r + 2] + w1[3] * x1[r + 3]);
                }
                if (seg < 2) {
#pragma unroll
                    for (int r = 0; r < 8; ++r) { const float ss = wave_sum(y0[r] * y0[r] + y1[r] * y1[r]); const float rn = __builtin_amdgcn_rsqf(ss + 1e-6f) * (seg == 0 ? 0.08838834764831845f : 1.f); y0[r] *= rn; y1[r] *= rn; }
                }
                if (seg == 0) {
#pragma unroll
                    for (int r = 0; r < 8; ++r) { const int i = i0 + r; Qs[i * 68 + lane] = pack2(y0[r], y1[r]); const float eg = __expf(gc[i]);
                        *(unsigned*)(QD + i * 128 + c) = pack2(y0[r] * eg, y1[r] * eg); }
                } else if (seg == 1) {
                    float a0[8], a1[8], d0[8], d1[8];
#pragma unroll
                    for (int r = 0; r < 8; ++r) { const int i = i0 + r; Ks[i * 68 + lane] = pack2(y0[r], y1[r]); const float gi = gc[i], s1 = bt[i] * __expf(gi), s2 = __expf(glast - gi);
                        a0[r] = y0[r] * s1; a1[r] = y1[r] * s1; d0[r] = y0[r] * s2; d1[r] = y1[r] * s2; }
                    *(LAS u32x4*)(lds + GA_KBGT + (c * 72 + i0) * 2) = pack8(a0); *(LAS u32x4*)(lds + GA_KBGT + ((c + 1) * 72 + i0) * 2) = pack8(a1);
                    *(u32x4*)(KDT + c * 64 + i0) = pack8(d0); *(u32x4*)(KDT + (c + 1) * 64 + i0) = pack8(d1);
                } else {
                    float a0[8], a1[8];
#pragma unroll
                    for (int r = 0; r < 8; ++r) { const float be = bt[i0 + r]; a0[r] = y0[r] * be; a1[r] = y1[r] * be; }
                    *(LAS u32x4*)(lds + GA_VBT + (c * 72 + i0) * 2) = pack8(a0); *(LAS u32x4*)(lds + GA_VBT + ((c + 1) * 72 + i0) * 2) = pack8(a1);
                }
                __builtin_amdgcn_sched_barrier(0);
            }
        }
        lds_barrier();
        if (item + G < 2048) { GA_LOAD(item + G) }
        {
            const int ti = wid >> 1;
#pragma unroll
            for (int tjj = 0; tjj < 2; ++tjj) {
                const int tj = (wid & 1) * 2 + tjj;
                f32x4 ak = (f32x4){0.f, 0.f, 0.f, 0.f}, aq = (f32x4){0.f, 0.f, 0.f, 0.f};
                if (tj <= ti) {
#pragma unroll
                    for (int kk = 0; kk < 4; ++kk) {
                        const bf16x8 bk = *(const LAS bf16x8*)(lds + GA_KS + ((tj * 16 + fr) * 136 + kk * 32 + fq * 8) * 2);
                        const bf16x8 fk = *(const LAS bf16x8*)(lds + GA_KS + ((ti * 16 + fr) * 136 + kk * 32 + fq * 8) * 2);
                        const bf16x8 fqv = *(const LAS bf16x8*)(lds + GA_QS + ((ti * 16 + fr) * 136 + kk * 32 + fq * 8) * 2);
                        ak = mfma16(fk, bk, ak); aq = mfma16(fqv, bk, aq);
                    }
                }
                const int j = tj * 16 + fr; const float gj = gc[j];
#pragma unroll
                for (int r = 0; r < 4; ++r) { const int i = ti * 16 + fq * 4 + r; const float gi = gc[i];
                    const float e = (i >= j) ? __expf(gi - gj) : 0.f;
                    if (tj <= ti) Ms[i * 68 + j] = (i > j) ? bt[i] * ak[r] * e : 0.f;
                    QK[i * 64 + j] = (bf16_t)(pack2(aq[r] * e, 0.f) & 0xffffu); }
            }
        }
        lds_barrier();
        for (int ib = 0; ib < 4; ++ib) {
            if (ib > 0) {
                float p0 = 0.f, p1 = 0.f;
                const int ra = ib * 16 + 2 * wid;
                for (int j = 0; j < ib * 16; j += 4) {
                    const float t0 = Tl[j * 64 + lane], t1 = Tl[(j + 1) * 64 + lane], t2 = Tl[(j + 2) * 64 + lane], t3 = Tl[(j + 3) * 64 + lane];
                    const f32x4 m0 = *(const LAS f32x4*)(Ms + ra * 68 + j), m1 = *(const LAS f32x4*)(Ms + (ra + 1) * 68 + j);
                    p0 += (m0[0] * t0 + m0[1] * t1) + (m0[2] * t2 + m0[3] * t3);
                    p1 += (m1[0] * t0 + m1[1] * t1) + (m1[2] * t2 + m1[3] * t3);
                }
                Pb[(2 * wid) * 64 + lane] = p0; Pb[(2 * wid + 1) * 64 + lane] = p1;
                lds_barrier();
            }
            if (wid == 0) {
                float Tr[16];
#pragma unroll
                for (int r = 0; r < 16; ++r) {
                    float a = (ib > 0) ? -Pb[r * 64 + lane] : 0.f;
#pragma unroll
                    for (int q = 0; q < r; q += 4) {
                        const f32x4 m = *(const LAS f32x4*)(Ms + (ib * 16 + r) * 68 + ib * 16 + q);
                        a -= m[0] * Tr[q];
                        if (q + 1 < r) a -= m[1] * Tr[q + 1];
                        if (q + 2 < r) a -= m[2] * Tr[q + 2];
                        if (q + 3 < r) a -= m[3] * Tr[q + 3];
                    }
                    Tr[r] = a + ((lane == ib * 16 + r) ? 1.f : 0.f);
                    Tl[(ib * 16 + r) * 64 + lane] = Tr[r];
                    Ts[(ib * 16 + r) * 72 + lane] = (bf16_t)(pack2(Tr[r], 0.f) & 0xffffu);
                }
            }
            lds_barrier();
        }
        {
            const int td = wid;
            bf16x8 bv[2], bk[2];
#pragma unroll
            for (int kk = 0; kk < 2; ++kk) { bv[kk] = *(const LAS bf16x8*)(lds + GA_VBT + ((td * 16 + fr) * 72 + kk * 32 + fq * 8) * 2);
                bk[kk] = *(const LAS bf16x8*)(lds + GA_KBGT + ((td * 16 + fr) * 72 + kk * 32 + fq * 8) * 2); }
#pragma unroll
            for (int ti = 0; ti < 4; ++ti) {
                f32x4 au = (f32x4){0.f, 0.f, 0.f, 0.f}, aw = (f32x4){0.f, 0.f, 0.f, 0.f};
#pragma unroll
                for (int kk = 0; kk < 2; ++kk) { const bf16x8 ft = *(const LAS bf16x8*)(lds + GA_TS + ((ti * 16 + fr) * 72 + kk * 32 + fq * 8) * 2);
                    au = mfma16(ft, bv[kk], au);
                    aw = mfma16(bk[kk], ft, aw); }
                *(u32x2*)(UT + (td * 16 + fr) * 64 + ti * 16 + fq * 4) = pack4(au);
                *(u32x2*)(WN + (ti * 16 + fr) * 128 + td * 16 + fq * 4) = pack4(-aw);
            }
        }
        lds_barrier();
    }
#undef GA_LOAD
#undef GA_IDS
}

__device__ __forceinline__ void gdn_dec_item(LAS unsigned char* lds, const Args& A, int item, int tid_in) {
    const int tid = tid_in, wid = tid >> 6, lane = tid & 63;
    const int h = item & 7, b = item >> 3;
    const bf16_t* Pd = (const bf16_t*)(A.ws + WS_PROJD) + (size_t)b * NUP; const float* BAd = (const float*)(A.ws + WS_BAD) + b * 32;
    bf16_t* YBd = (bf16_t*)(A.ws + WS_YBD) + (size_t)b * DFF;
    LAS float* qs = (LAS float*)lds; LAS float* ks = qs + 128; LAS float* vs = qs + 256; LAS float* sc = qs + 384;
    LAS float* part = qs + 512;
    LAS float* os = qs + 512 + 1024;
    if (tid < 384) {
        const int seg = tid >> 7, d = tid & 127, col = seg * 1024 + h * 128 + d;
        const float* cin = A.in[2] + (size_t)b * 3 * 3072 + col;
        const float c0 = cin[0], c1 = cin[3072], c2 = cin[6144], nw = bf2f(Pd[col]);
        const float* cw = A.in[8] + col;
        const float y = A.in[9][col] + cw[0] * c0 + cw[3072] * c1 + cw[6144] * c2 + cw[9216] * nw;
        qs[tid] = silu_f(y);
        float* co = A.out + O_GCS + (size_t)b * 3 * 3072 + col; co[0] = c1; co[3072] = c2; co[6144] = nw;
    }
    __syncthreads();
    if (wid < 3) {
        const float q0 = qs[lane], q1 = qs[lane + 64], k0 = ks[lane], k1 = ks[lane + 64];
        const float v = (wid == 0) ? (q0 * q0 + q1 * q1) : (wid == 1) ? (k0 * k0 + k1 * k1) : (q0 * k0 + q1 * k1);
        const float s = wave_sum(v); if (lane == 0) sc[wid] = s;
    }
    __syncthreads();
    const float rq = __builtin_amdgcn_rsqf(sc[0] + 1e-6f) * 0.08838834764831845f, rk = __builtin_amdgcn_rsqf(sc[1] + 1e-6f), qk = sc[2] * rq * rk;
    const float g = -__expf(A.in[10][h]) * softplus_f(BAd[8 + h] + A.in[11][h]), eg = __expf(g), beta = sigmoid_f(BAd[h]);
    const int v = tid & 127, kg = tid >> 7;
    const float* Sin = A.in[3] + ((size_t)(b * 8 + h) * 128 + kg * 32) * 128 + v;
    float S[32]; float pk = 0.f, pq = 0.f;
#pragma unroll
    for (int k = 0; k < 32; ++k) S[k] = __builtin_nontemporal_load(Sin + k * 128);
#pragma unroll
    for (int k = 0; k < 32; ++k) { pk += ks[kg * 32 + k] * S[k]; pq += qs[kg * 32 + k] * S[k]; }
    part[kg * 128 + v] = pk * rk; part[512 + kg * 128 + v] = pq * rq;
    __syncthreads();
    const float kS = (part[v] + part[128 + v]) + (part[256 + v] + part[384 + v]);
    const float qS = (part[512 + v] + part[640 + v]) + (part[768 + v] + part[896 + v]);
    const float vnew = beta * (vs[v] - eg * kS);
    const float o = eg * qS + qk * vnew;
    float* Sout = A.out + O_GSS + ((size_t)(b * 8 + h) * 128 + kg * 32) * 128 + v;
#pragma unroll
    for (int k = 0; k < 32; ++k) __builtin_nontemporal_store(eg * S[k] + (ks[kg * 32 + k] * rk) * vnew, Sout + k * 128);
    if (kg == 0) os[v] = o;
    __syncthreads();
    if (wid == 0) {
        const float o0 = os[lane], o1 = os[lane + 64];
        const float rstd = __builtin_amdgcn_rsqf(wave_sum(o0 * o0 + o1 * o1) * (1.f / 128.f) + RMS_EPS);
        const float z0 = bf2f(Pd[3072 + h * 128 + lane]), z1 = bf2f(Pd[3072 + h * 128 + lane + 64]);
        const float r0 = o0 * rstd * A.in[12][lane] * silu_f(z0), r1 = o1 * rstd * A.in[12][lane + 64] * silu_f(z1);
        YBd[h * 128 + lane] = (bf16_t)(pack2(r0, 0.f) & 0xffffu); YBd[h * 128 + lane + 64] = (bf16_t)(pack2(r1, 0.f) & 0xffffu);
    }
    __syncthreads();
}

constexpr int GS_SB0 = 0, GS_SB1 = 8704, GS_VN = 17408;
__device__ __forceinline__ void gdn_scan_item(LAS unsigned char* lds, const Args& A, int item, int tid_in) {
    const int tid = tid_in, wid = tid >> 6, lane = tid & 63, fr = lane & 15, fq = lane >> 4;
    const int xcd = item & 7, slot = item >> 3, pair = xcd * 8 + (slot >> 2);
    const int vs = slot & 3, h = pair & 7, b = pair >> 3;
    const int ti = wid >> 1, tv = wid & 1;
    const bf16_t* UTb = (const bf16_t*)(A.ws + WS_UT); const bf16_t* WNb = (const bf16_t*)(A.ws + WS_WN);
    const bf16_t* QDb = (const bf16_t*)(A.ws + WS_QD); const bf16_t* KDTb = (const bf16_t*)(A.ws + WS_KDT);
    const bf16_t* QKb = (const bf16_t*)(A.ws + WS_QK); const float* EGL = (const float*)(A.ws + WS_EGL);
    float* O = (float*)(A.ws + WS_O);
    for (int e = tid; e < 8704 / 4; e += 512) ((LAS unsigned*)(lds + GS_SB0))[e] = 0u;
    f32x4 sacc[2]; sacc[0] = (f32x4){0.f, 0.f, 0.f, 0.f}; sacc[1] = sacc[0];
    __syncthreads();
    const int chunk0 = (b * 8 + h) * 32;
    bf16x8 nfw0[4], nfqd0[4], nfqk0[2], nfkd0[2]; u32x2 nuu0; float ndecay0;
    bf16x8 nfw1[4], nfqd1[4], nfqk1[2], nfkd1[2]; u32x2 nuu1; float ndecay1;
#define GS_LOAD(S, ch) { const size_t _c = (size_t)(ch); \
        _Pragma("unroll") for (int kk = 0; kk < 4; ++kk) { nfw##S[kk] = *(const bf16x8*)(WNb + _c * 8192 + (ti * 16 + fr) * 128 + kk * 32 + fq * 8); nfqd##S[kk] = *(const bf16x8*)(QDb + _c * 8192 + (ti * 16 + fr) * 128 + kk * 32 + fq * 8); } \
        _Pragma("unroll") for (int kk = 0; kk < 2; ++kk) { nfqk##S[kk] = *(const bf16x8*)(QKb + _c * 4096 + (ti * 16 + fr) * 64 + kk * 32 + fq * 8); nfkd##S[kk] = *(const bf16x8*)(KDTb + _c * 8192 + (wid * 16 + fr) * 64 + kk * 32 + fq * 8); } \
        nuu##S = *(const u32x2*)(UTb + _c * 8192 + (vs * 32 + tv * 16 + fr) * 64 + ti * 16 + fq * 4); ndecay##S = EGL[_c]; }
#define GS_STEP(S, nn, SBC, SBN, DOLOAD) { \
        bf16x8 fw[4], fqd[4], fqk[2], fkd[2]; \
        _Pragma("unroll") for (int kk = 0; kk < 4; ++kk) { fw[kk] = nfw##S[kk]; fqd[kk] = nfqd##S[kk]; } \
        _Pragma("unroll") for (int kk = 0; kk < 2; ++kk) { fqk[kk] = nfqk##S[kk]; fkd[kk] = nfkd##S[kk]; } \
        const u32x2 uu = nuu##S; const float decay = ndecay##S; \
        if (DOLOAD) { GS_LOAD(S, chunk0 + (nn) + 2) } \
        f32x4 acc = (f32x4){lo_f(uu.x), hi_f(uu.x), lo_f(uu.y), hi_f(uu.y)}; \
        bf16x8 fs[4]; \
        _Pragma("unroll") for (int kk = 0; kk < 4; ++kk) { fs[kk] = *(const LAS bf16x8*)(lds + (SBC) + ((tv * 16 + fr) * 136 + kk * 32 + fq * 8) * 2); acc = mfma16(fw[kk], fs[kk], acc); } \
        *(LAS u32x2*)(lds + GS_VN + ((tv * 16 + fr) * 72 + ti * 16 + fq * 4) * 2) = pack4(acc); \
        lds_barrier(); \
        f32x4 ao = (f32x4){0.f, 0.f, 0.f, 0.f}; \
        _Pragma("unroll") for (int kk = 0; kk < 4; ++kk) ao = mfma16(fs[kk], fqd[kk], ao); \
        bf16x8 fv[2][2]; \
        _Pragma("unroll") for (int t2 = 0; t2 < 2; ++t2) _Pragma("unroll") for (int kk = 0; kk < 2; ++kk) fv[t2][kk] = *(const LAS bf16x8*)(lds + GS_VN + ((t2 * 16 + fr) * 72 + kk * 32 + fq * 8) * 2); \
        _Pragma("unroll") for (int kk = 0; kk < 2; ++kk) { const bf16x8 fvo = *(const LAS bf16x8*)(lds + GS_VN + ((tv * 16 + fr) * 72 + kk * 32 + fq * 8) * 2); ao = mfma16(fvo, fqk[kk], ao); } \
        *(f32x4*)(O + ((size_t)b * SL + (nn) * 64 + ti * 16 + fr) * 1024 + h * 128 + vs * 32 + tv * 16 + fq * 4) = ao; \
        _Pragma("unroll") for (int t2 = 0; t2 < 2; ++t2) { sacc[t2] = sacc[t2] * decay; \
            _Pragma("unroll") for (int kk = 0; kk < 2; ++kk) sacc[t2] = mfma16(fkd[kk], fv[t2][kk], sacc[t2]); \
            *(LAS u32x2*)(lds + (SBN) + ((t2 * 16 + fr) * 136 + wid * 16 + fq * 4) * 2) = pack4(sacc[t2]); } \
        lds_barrier(); }
    GS_LOAD(0, chunk0) GS_LOAD(1, chunk0 + 1)
    for (int n = 0; n < 32; n += 8) {
        __builtin_amdgcn_s_waitcnt(0x0F70);
        GS_STEP(0, n, GS_SB0, GS_SB1, 1) GS_STEP(1, n + 1, GS_SB1, GS_SB0, 1) GS_STEP(0, n + 2, GS_SB0, GS_SB1, 1) GS_STEP(1, n + 3, GS_SB1, GS_SB0, 1)
        GS_STEP(0, n + 4, GS_SB0, GS_SB1, 1) GS_STEP(1, n + 5, GS_SB1, GS_SB0, 1) GS_STEP(0, n + 6, GS_SB0, GS_SB1, (n + 8 < 32)) GS_STEP(1, n + 7, GS_SB1, GS_SB0, (n + 9 < 32))
    }
#undef GS_STEP
#undef GS_LOAD
    float* So = A.out + O_GSP + (size_t)(b * 8 + h) * 16384;
#pragma unroll
    for (int t2 = 0; t2 < 2; ++t2)
#pragma unroll
        for (int r = 0; r < 4; ++r) So[(wid * 16 + fq * 4 + r) * 128 + vs * 32 + t2 * 16 + fr] = sacc[t2][r];
    __syncthreads();
}

__device__ __forceinline__ void gdn_gate_row(const Args& A, size_t row, int lane) {
    const float* O = (const float*)(A.ws + WS_O) + row * 1024 + lane * 16;
    const bf16_t* Z = (const bf16_t*)(A.ws + WS_PROJ) + row * 4096 + 3072 + lane * 16;
    bf16_t* Y = (bf16_t*)(A.ws + WS_YB) + row * 1024 + lane * 16;
    const float* nw = A.in[12] + (lane & 7) * 16;
    float o[16]; float ss = 0.f;
#pragma unroll
    for (int i = 0; i < 4; ++i) { const f32x4 v = ((const f32x4*)O)[i]; o[4 * i] = v[0]; o[4 * i + 1] = v[1]; o[4 * i + 2] = v[2]; o[4 * i + 3] = v[3]; ss += (v[0] * v[0] + v[1] * v[1]) + (v[2] * v[2] + v[3] * v[3]); }
    ss += __shfl_xor(ss, 1); ss += __shfl_xor(ss, 2); ss += __shfl_xor(ss, 4);
    const float rstd = __builtin_amdgcn_rsqf(ss * (1.f / 128.f) + RMS_EPS);
    float z[16]; { float t[8]; unpack8(((const u32x4*)Z)[0], t);
#pragma unroll
        for (int j = 0; j < 8; ++j) z[j] = t[j];
        unpack8(((const u32x4*)Z)[1], t);
#pragma unroll
        for (int j = 0; j < 8; ++j) z[8 + j] = t[j]; }
    float r[8];
#pragma unroll
    for (int hh = 0; hh < 2; ++hh) {
#pragma unroll
        for (int j = 0; j < 8; ++j) r[j] = o[hh * 8 + j] * rstd * nw[hh * 8 + j] * silu_f(z[hh * 8 + j]);
        ((u32x4*)Y)[hh] = pack8(r);
    }
}
__device__ __forceinline__ void gdn_gate_row2(const Args& A, size_t row, int lane) {
    const float* O = (const float*)(A.ws + WS_O) + row * 1024 + lane * 16;
    const bf16_t* Z = (const bf16_t*)(A.ws + WS_PROJ) + row * 4096 + 3072 + lane * 16;
    bf16_t* Y = (bf16_t*)(A.ws + WS_YB) + row * 1024 + lane * 16;
    const float* nw = A.in[12] + (lane & 7) * 16;
    f32x4 ov[2][4]; u32x4 zv[2][2];
#pragma unroll
    for (int rr = 0; rr < 2; ++rr) {
#pragma unroll
        for (int i = 0; i < 4; ++i) ov[rr][i] = ((const f32x4*)(O + rr * 1024))[i];
        zv[rr][0] = ((const u32x4*)(Z + rr * 4096))[0]; zv[rr][1] = ((const u32x4*)(Z + rr * 4096))[1];
    }
#pragma unroll
    for (int rr = 0; rr < 2; ++rr) {
        float ss = 0.f;
#pragma unroll
        for (int i = 0; i < 4; ++i) ss += (ov[rr][i][0] * ov[rr][i][0] + ov[rr][i][1] * ov[rr][i][1]) + (ov[rr][i][2] * ov[rr][i][2] + ov[rr][i][3] * ov[rr][i][3]);
        ss += __shfl_xor(ss, 1); ss += __shfl_xor(ss, 2); ss += __shfl_xor(ss, 4);
        const float rstd = __builtin_amdgcn_rsqf(ss * (1.f / 128.f) + RMS_EPS);
#pragma unroll
        for (int hh = 0; hh < 2; ++hh) { float z[8], r[8]; unpack8(zv[rr][hh], z);
#pragma unroll
            for (int j = 0; j < 8; ++j) r[j] = ov[rr][hh * 2 + (j >> 2)][j & 3] * rstd * nw[hh * 8 + j] * silu_f(z[j]);
            ((u32x4*)(Y + rr * 1024))[hh] = pack8(r); }
    }
}

__device__ __forceinline__ void ssd_conv_item(const Args& A, int item, int tid_in) {
    const int t = tid_in; if (t >= 384) return;
    const int c0 = t * 8, r0 = item * 16, tb = r0 & (SL - 1), b = r0 >> 11;
    const bf16_t* P = (const bf16_t*)(A.ws + WS_PROJ);
    bf16_t* XA = (bf16_t*)(A.ws + WS_XA); bf16_t* BCA = (bf16_t*)(A.ws + WS_BCA);
    u32x4 xq[19];
#pragma unroll
    for (int r = 0; r < 19; ++r) xq[r] = (tb == 0 && r < 3) ? (u32x4){0u, 0u, 0u, 0u} : *(const u32x4*)(P + (size_t)(r0 + r - 3) * 5120 + 2048 + c0);
    float w[4][8], bb[8];
#pragma unroll
    for (int j = 0; j < 8; ++j) { bb[j] = A.in[16][c0 + j];
#pragma unroll
        for (int k = 0; k < 4; ++k) w[k][j] = A.in[15][k * 3072 + c0 + j]; }
    float p3[8], p2[8], p1[8];
    unpack8(xq[0], p3); unpack8(xq[1], p2); unpack8(xq[2], p1);
#pragma unroll
    for (int r = 0; r < 16; ++r) {
        const size_t row = (size_t)(r0 + r);
        float cur[8], o[8];
        unpack8(xq[r + 3], cur);
#pragma unroll
        for (int j = 0; j < 8; ++j) o[j] = silu_f(bb[j] + w[0][j] * p3[j] + w[1][j] * p2[j] + w[2][j] * p1[j] + w[3][j] * cur[j]);
        if (c0 < 2048) *(u32x4*)(XA + row * 2048 + c0) = pack8(o); else *(u32x4*)(BCA + row * 1024 + (c0 - 2048)) = pack8(o);
        const int tt = tb + r;
        if (tt >= SL - 3) { float* cp = A.out + O_SCP + ((size_t)b * 3 + (tt - (SL - 3))) * 3072 + c0;
#pragma unroll
            for (int j = 0; j < 8; ++j) cp[j] = cur[j]; }
#pragma unroll
        for (int j = 0; j < 8; ++j) { p3[j] = p2[j]; p2[j] = p1[j]; p1[j] = cur[j]; }
    }
}

__device__ __forceinline__ void ssd_dec_item(LAS unsigned char* lds, const Args& A, int item, int tid_in) {
    const int tid = tid_in, wid = tid >> 6, lane = tid & 63;
    const int g = item & 3, b = item >> 2;
    const bf16_t* Pd = (const bf16_t*)(A.ws + WS_PROJD) + (size_t)b * NUP; const float* BAd = (const float*)(A.ws + WS_BAD) + b * 32;
    bf16_t* YBd = (bf16_t*)(A.ws + WS_YBD) + (size_t)b * DFF;
    LAS float* xs = (LAS float*)lds; LAS float* Bs = xs + 512; LAS float* Cs = xs + 640; LAS float* ys = xs + 768; LAS float* dts = xs + 1280; LAS float* dAs = xs + 1288; LAS float* red = xs + 1296;
    for (int c = tid; c < 768; c += 512) {
        const int xc = (c < 512) ? (g * 512 + c) : (c < 640) ? (2048 + g * 128 + (c - 512)) : (2560 + g * 128 + (c - 640));
        const float* cin = A.in[(4)] + (size_t)b * 3 * 3072 + xc;
        const float c0 = cin[0], c1 = cin[3072], c2 = cin[6144], nw = bf2f(Pd[2048 + xc]);
        const float* cw = A.in[(15)] + xc;
        xs[c] = silu_f(A.in[(16)][xc] + cw[0] * c0 + cw[3072] * c1 + cw[6144] * c2 + cw[9216] * nw);
        float* co = A.out + O_SCS + (size_t)b * 3 * 3072 + xc; co[0] = c1; co[3072] = c2; co[6144] = nw;
    }
    if (tid < 8) { const int h = g * 8 + tid; const float dt = softplus_f(BAd[h] + A.in[(18)][h]); dts[tid] = dt; dAs[tid] = __expf(-__expf(A.in[(17)][h]) * dt); }
    __syncthreads();
    const int sl = tid & 31, pr = tid >> 5;
    const f32x4 B4 = *(const LAS f32x4*)(Bs + sl * 4), C4 = *(const LAS f32x4*)(Cs + sl * 4);
    const float* Sin0 = A.in[(5)] + ((size_t)(b * 32 + g * 8) * 64) * 128 + sl * 4;
    float* Sout0 = A.out + O_SSS + ((size_t)(b * 32 + g * 8) * 64) * 128 + sl * 4;
    f32x4 Snx[4];
#pragma unroll
    for (int it = 0; it < 4; ++it) Snx[it] = __builtin_nontemporal_load((const f32x4*)(Sin0 + (it * 16 + pr) * 128));
#pragma unroll
    for (int j = 0; j < 8; ++j) {
        const float dt = dts[j], dA = dAs[j];
        f32x4 S[4];
#pragma unroll
        for (int it = 0; it < 4; ++it) S[it] = Snx[it];
        if (j + 1 < 8) {
#pragma unroll
            for (int it = 0; it < 4; ++it) Snx[it] = __builtin_nontemporal_load((const f32x4*)(Sin0 + (size_t)(j + 1) * 8192 + (it * 16 + pr) * 128));
        }
#pragma unroll
        for (int it = 0; it < 4; ++it) { const int p = it * 16 + pr; const float xd = xs[j * 64 + p] * dt;
            const f32x4 Sn = S[it] * dA + B4 * xd; __builtin_nontemporal_store(Sn, (f32x4*)(Sout0 + (size_t)j * 8192 + p * 128));
            float y = (Sn[0] * C4[0] + Sn[1] * C4[1]) + (Sn[2] * C4[2] + Sn[3] * C4[3]);
            y += DPP_F(y, 0xB1, 0xf); y += DPP_F(y, 0x4E, 0xf); y += DPP_F(y, 0x141, 0xf); y += DPP_F(y, 0x140, 0xf); y += DPP_F(y, 0x142, 0xa);
            if (sl == 31) ys[j * 64 + p] = y; }
    }
    __syncthreads();
    {
        const int c = tid, h = g * 8 + (c >> 6);
        const float y = (ys[c] + A.in[(19)][h] * xs[c]) * silu_f(bf2f(Pd[g * 512 + c]));
        const float s = wave_sum(y * y); if (lane == 0) red[wid] = s;
        __syncthreads();
        float tot = 0.f;
#pragma unroll
        for (int w = 0; w < 8; ++w) tot += red[w];
        const float r = y * __builtin_amdgcn_rsqf(tot * (1.f / 512.f) + RMS_EPS) * A.in[(20)][g * 512 + c];
        YBd[g * 512 + c] = (bf16_t)(pack2(r, 0.f) & 0xffffu);
    }
    __syncthreads();
}

constexpr int SS_XT = 0, SS_XDT = 9216, SS_BT = 18432, SS_SC = 36864, SS_SB0 = 46080, SS_SB1 = 63488, SS_BS = 80896, SS_CS = 98304, SS_AC = 115712, SS_DT = 115968;
__device__ __forceinline__ void ssd_step(LAS unsigned char* lds, bf16_t* __restrict__ Y, const size_t t0, const int h, const int sbc, const int sbn,
                                         const u32x4 px, const u32x4 pb0, const u32x4 pb1, const u32x4 pc0, const u32x4 pc1, const float pdt,
                                         const float aneg, const float dtb, const float Dh, f32x4 (&sacc)[4], const int tid) {
    const int wid = tid >> 6, lane = tid & 63, fr = lane & 15, fq = lane >> 4, ti = wid >> 1;
    const int jx = tid >> 3, xm = tid & 7, jb0 = tid >> 4, jb1 = 32 + (tid >> 4), bm = tid & 15;
    LAS float* acum = (LAS float*)(lds + SS_AC); LAS float* dtv = (LAS float*)(lds + SS_DT);
        if (wid == 0) { const float dt = softplus_f(pdt + dtb); const float ac = wave_incl_scan(dt * aneg, lane); acum[lane] = ac; dtv[lane] = dt; }
        *(LAS u32x4*)(lds + SS_BS + (jb0 * 136 + bm * 8) * 2) = pb0; *(LAS u32x4*)(lds + SS_BS + (jb1 * 136 + bm * 8) * 2) = pb1;
        *(LAS u32x4*)(lds + SS_CS + (jb0 * 136 + bm * 8) * 2) = pc0; *(LAS u32x4*)(lds + SS_CS + (jb1 * 136 + bm * 8) * 2) = pc1;
        lds_barrier();
        const float alast = acum[63];
        {
            const float sx = dtv[jx] * __expf(alast - acum[jx]);
            const int colx = (((jx >> 3) ^ xm) * 8 + (jx & 7)) * 2;
            const unsigned wx[4] = {px.x, px.y, px.z, px.w};
#pragma unroll
            for (int q = 0; q < 8; ++q) { const unsigned w = wx[q >> 1]; const unsigned short raw = (q & 1) ? (unsigned short)(w >> 16) : (unsigned short)(w & 0xffffu);
                const float xv = bf2f(raw); const int rowb = (xm * 8 + q) * 144;
                *(LAS unsigned short*)(lds + SS_XT + rowb + colx) = raw;
                *(LAS unsigned short*)(lds + SS_XDT + rowb + colx) = (unsigned short)(pack2(xv * sx, 0.f) & 0xffffu); }
            const int colb0 = (((jb0 >> 3) ^ (bm & 7)) * 8 + (jb0 & 7)) * 2, colb1 = (((jb1 >> 3) ^ (bm & 7)) * 8 + (jb1 & 7)) * 2;
            const unsigned wb0[4] = {pb0.x, pb0.y, pb0.z, pb0.w}, wb1[4] = {pb1.x, pb1.y, pb1.z, pb1.w};
#pragma unroll
            for (int q = 0; q < 8; ++q) { const int rowb = (bm * 8 + q) * 144;
                *(LAS unsigned short*)(lds + SS_BT + rowb + colb0) = (q & 1) ? (unsigned short)(wb0[q >> 1] >> 16) : (unsigned short)(wb0[q >> 1] & 0xffffu);
                *(LAS unsigned short*)(lds + SS_BT + rowb + colb1) = (q & 1) ? (unsigned short)(wb1[q >> 1] >> 16) : (unsigned short)(wb1[q >> 1] & 0xffffu); }
        }
        bf16x8 fc[4];
#pragma unroll
        for (int kk = 0; kk < 4; ++kk) fc[kk] = *(const LAS bf16x8*)(lds + SS_CS + ((ti * 16 + fr) * 136 + kk * 32 + fq * 8) * 2);
#pragma unroll
        for (int tjj = 0; tjj < 2; ++tjj) {
            const int tj = (wid & 1) * 2 + tjj;
            f32x4 acc = (f32x4){0.f, 0.f, 0.f, 0.f};
            if (tj <= ti) {
#pragma unroll
                for (int kk = 0; kk < 4; ++kk) { const bf16x8 fb = *(const LAS bf16x8*)(lds + SS_BS + ((tj * 16 + fr) * 136 + kk * 32 + fq * 8) * 2); acc = mfma16(fb, fc[kk], acc); }
            }
            const int i = ti * 16 + fr; const float ai = acum[i]; f32x4 sc;
#pragma unroll
            for (int r = 0; r < 4; ++r) { const int j = tj * 16 + fq * 4 + r; sc[r] = (i >= j) ? acc[r] * __expf(ai - acum[j]) * dtv[j] : 0.f; }
            *(LAS u32x2*)(lds + SS_SC + (i * 72 + tj * 16 + fq * 4) * 2) = pack4(sc);
        }
        lds_barrier();
        {
            bf16x8 fsc[2];
#pragma unroll
            for (int kk = 0; kk < 2; ++kk) fsc[kk] = *(const LAS bf16x8*)(lds + SS_SC + ((ti * 16 + fr) * 72 + kk * 32 + fq * 8) * 2);
            const int i = ti * 16 + fr; const float ea = __expf(acum[i]);
#pragma unroll
            for (int tpp = 0; tpp < 2; ++tpp) {
                const int tp = (wid & 1) * 2 + tpp, prow = tp * 16 + fr, psw = (prow >> 3) & 7;
                f32x4 a1 = (f32x4){0.f, 0.f, 0.f, 0.f}, a2 = (f32x4){0.f, 0.f, 0.f, 0.f};
#pragma unroll
                for (int kk = 0; kk < 2; ++kk) { const bf16x8 fx = *(const LAS bf16x8*)(lds + SS_XT + (prow * 72 + (((kk * 4 + fq) ^ psw) * 8)) * 2); a1 = mfma16(fx, fsc[kk], a1); }
#pragma unroll
                for (int kk = 0; kk < 4; ++kk) { const bf16x8 fs = *(const LAS bf16x8*)(lds + sbc + (prow * 136 + kk * 32 + fq * 8) * 2); a2 = mfma16(fs, fc[kk], a2); }
                const int p0 = tp * 16 + fq * 4;
                const int xcol = (((i >> 3) ^ ((p0 >> 3) & 7)) * 8 + (i & 7)) * 2;
                f32x4 y = a1 + a2 * ea;
#pragma unroll
                for (int r = 0; r < 4; ++r) y[r] += Dh * bf2f(*(const LAS unsigned short*)(lds + SS_XT + (p0 + r) * 144 + xcol));
                *(u32x2*)(Y + (t0 + i) * 2048 + h * 64 + p0) = pack4(y);
            }
        }
        {
            const int tp = wid >> 1, prow = tp * 16 + fr, psw = (prow >> 3) & 7; const float el = __expf(alast);
            bf16x8 fxd[2];
#pragma unroll
            for (int kk = 0; kk < 2; ++kk) fxd[kk] = *(const LAS bf16x8*)(lds + SS_XDT + (prow * 72 + (((kk * 4 + fq) ^ psw) * 8)) * 2);
#pragma unroll
            for (int q = 0; q < 4; ++q) { const int ts = (wid & 1) * 4 + q, srow = ts * 16 + fr, ssw = (srow >> 3) & 7; sacc[q] = sacc[q] * el;
#pragma unroll
                for (int kk = 0; kk < 2; ++kk) { const bf16x8 fb = *(const LAS bf16x8*)(lds + SS_BT + (srow * 72 + (((kk * 4 + fq) ^ ssw) * 8)) * 2); sacc[q] = mfma16(fb, fxd[kk], sacc[q]); }
                *(LAS u32x2*)(lds + sbn + (prow * 136 + ts * 16 + fq * 4) * 2) = pack4(sacc[q]); }
        }
        lds_barrier();
}

__device__ __forceinline__ void ssd_scan_item(LAS unsigned char* lds, const Args& A, int item, int tid_in) {
    const int tid = tid_in, wid = tid >> 6, lane = tid & 63, fr = lane & 15, fq = lane >> 4;
    const int xcd = item & 7, slot = item >> 3, grp = xcd * 4 + (slot >> 3);
    const int b = grp >> 2, g = grp & 3, h = g * 8 + (slot & 7);
    const bf16_t* XA = (const bf16_t*)(A.ws + WS_XA); const bf16_t* BCA = (const bf16_t*)(A.ws + WS_BCA); const float* BA = (const float*)(A.ws + WS_BA);
    bf16_t* Y = (bf16_t*)(A.ws + WS_YB);
    LAS float* acum = (LAS float*)(lds + SS_AC); LAS float* dtv = (LAS float*)(lds + SS_DT);
    const float aneg = -__expf(A.in[17][h]), dtb = A.in[18][h], Dh = A.in[19][h];
    for (int e = tid; e < 17408 / 4; e += 512) ((LAS unsigned*)(lds + SS_SB0))[e] = 0u;
    f32x4 sacc[4];
#pragma unroll
    for (int q = 0; q < 4; ++q) sacc[q] = (f32x4){0.f, 0.f, 0.f, 0.f};
    int cur = 0;
    const int ti = wid >> 1;
    const int jx = tid >> 3, xm = tid & 7;
    const int jb0 = tid >> 4, jb1 = 32 + (tid >> 4), bm = tid & 15;
    u32x4 npx0, npb00, npb10, npc00, npc10; float npdt0 = 0.f;
    u32x4 npx1, npb01, npb11, npc01, npc11; float npdt1 = 0.f;
#define SS_LOAD(S, nn) { const size_t _t0 = (size_t)b * SL + (nn) * 64; \
        npx##S = *(const u32x4*)(XA + (_t0 + jx) * 2048 + h * 64 + xm * 8); \
        npb0##S = *(const u32x4*)(BCA + (_t0 + jb0) * 1024 + g * 128 + bm * 8); npb1##S = *(const u32x4*)(BCA + (_t0 + jb1) * 1024 + g * 128 + bm * 8); \
        npc0##S = *(const u32x4*)(BCA + (_t0 + jb0) * 1024 + 512 + g * 128 + bm * 8); npc1##S = *(const u32x4*)(BCA + (_t0 + jb1) * 1024 + 512 + g * 128 + bm * 8); \
        if (wid == 0) npdt##S = BA[(_t0 + lane) * 32 + h]; }
#define SS_STEP(S, nn, DOLOAD) { \
        const size_t t0 = (size_t)b * SL + (nn) * 64; \
        const int sbc = cur ? SS_SB1 : SS_SB0, sbn = cur ? SS_SB0 : SS_SB1; \
        const u32x4 px = npx##S, pb0 = npb0##S, pb1 = npb1##S, pc0 = npc0##S, pc1 = npc1##S; const float pdt = npdt##S; \
        if (DOLOAD) { SS_LOAD(S, (nn) + 2) } \
        ssd_step(lds, Y, t0, h, sbc, sbn, px, pb0, pb1, pc0, pc1, pdt, aneg, dtb, Dh, sacc, tid); \
        cur ^= 1; }
    SS_LOAD(0, 0) SS_LOAD(1, 1)
    __syncthreads();
    for (int n = 0; n < 28; n += 4) {
        __builtin_amdgcn_s_waitcnt(0x0F70);
        SS_STEP(0, n, 1) SS_STEP(1, n + 1, 1) SS_STEP(0, n + 2, 1) SS_STEP(1, n + 3, 1)
    }
    __builtin_amdgcn_s_waitcnt(0x0F70);
    SS_STEP(0, 28, 1) SS_STEP(1, 29, 1) SS_STEP(0, 30, 0) SS_STEP(1, 31, 0)
#undef SS_STEP
#undef SS_LOAD
    {
        const int tp = wid >> 1; float* So = A.out + O_SSP + (size_t)(b * 32 + h) * 8192;
#pragma unroll
        for (int q = 0; q < 4; ++q) { const int ts = (wid & 1) * 4 + q; *(f32x4*)(So + (tp * 16 + fr) * 128 + ts * 16 + fq * 4) = sacc[q]; }
    }
    __syncthreads();
}

__device__ __forceinline__ void ssd_gate_row(const Args& A, size_t row, int lane) {
    bf16_t* Y = (bf16_t*)(A.ws + WS_YB) + row * 2048; const bf16_t* Z = (const bf16_t*)(A.ws + WS_PROJ) + row * 5120;
    u32x4 yq[4], zq[4];
#pragma unroll
    for (int g = 0; g < 4; ++g) { yq[g] = *(const u32x4*)(Y + g * 512 + lane * 8); zq[g] = *(const u32x4*)(Z + g * 512 + lane * 8); }
#pragma unroll
    for (int g = 0; g < 4; ++g) {
        const int c0 = g * 512 + lane * 8; float y[8], z[8];
        unpack8(yq[g], y); unpack8(zq[g], z);
        float ss = 0.f;
#pragma unroll
        for (int j = 0; j < 8; ++j) { y[j] *= silu_f(z[j]); ss += y[j] * y[j]; }
        const float rstd = __builtin_amdgcn_rsqf(wave_sum(ss) * (1.f / 512.f) + RMS_EPS);
        const float* nw = A.in[20] + c0;
#pragma unroll
        for (int j = 0; j < 8; ++j) y[j] = y[j] * rstd * nw[j];
        *(u32x4*)(Y + c0) = pack8(y);
    }
}


__constant__ int P0_BASE[8] = {0, 544, 672, 1344, 1600, 2304, 3008, 3360};
__constant__ int P0_IN[8] = {7, 13, 14, 21, 22, 22, 25, 25};
__constant__ unsigned P0_INOFF[8] = {0, 0, 0, 0, 0, 1024u * 5632u, 0, 2816u * 1024u};
__constant__ unsigned P0_WOFS[8] = {(unsigned)WS_WGI, (unsigned)WS_WGO, (unsigned)WS_WSI, (unsigned)WS_WSO, (unsigned)WS_WUP0, (unsigned)WS_WUP1, (unsigned)WS_WDN0, (unsigned)WS_WDN1};
__constant__ int P0_K[8] = {1024, 1024, 1024, 2048, 1024, 1024, 2816, 2816};
__constant__ int P0_N[8] = {4112, 1024, 5152, 1024, 5632, 5632, 1024, 1024};

#define XB_TMO      128
#define XB_XCNT(j)  (256  + 64 * (j))
#define XB_XSUB(j)  (1280 + 64 * (j))
#define XB_XGEN(j)  (2304 + 64 * (j))
#define XB_TOP      3328
#define XB_TOPGEN   3392
#define XCD_BAR_WORDS 3456
#define XB_SPIN_CAP (1u << 18)
__device__ __forceinline__ unsigned xb_ld(unsigned* p)              { return __hip_atomic_load(p, __ATOMIC_RELAXED, __HIP_MEMORY_SCOPE_AGENT); }
__device__ __forceinline__ unsigned xb_add(unsigned* p, unsigned v) { return __hip_atomic_fetch_add(p, v, __ATOMIC_RELAXED, __HIP_MEMORY_SCOPE_AGENT); }
__device__ __forceinline__ unsigned xb_xcc_id() { return (unsigned)__builtin_amdgcn_s_getreg((3 << 11) | 20) & 0xFu; }
#define XB_SPIN(cond, bar) do { unsigned _sp = 0; while (cond) { __builtin_amdgcn_s_sleep(1); \
    if ((++_sp & 255u) == 0u) { if (xb_ld(&(bar)[XB_TMO])) break; if (_sp > XB_SPIN_CAP) { atomicAdd(&(bar)[XB_TMO], 1u); break; } } } } while (0)
struct XcdBarrier { unsigned* bar; unsigned x; volatile LAS unsigned* st; };
__device__ __forceinline__ XcdBarrier xcd_barrier_post(unsigned* bar, volatile LAS unsigned* st) {
    XcdBarrier b; b.bar = bar; b.x = xb_xcc_id(); b.st = st;
    if (threadIdx.x == 0) (void)xb_add(&bar[XB_XCNT(b.x)], 1u);
    return b;
}
__device__ __forceinline__ void xcd_barrier_complete(unsigned* bar, unsigned x, unsigned& nloc, unsigned& nx) {
    const unsigned G = gridDim.x * gridDim.y * gridDim.z;
    unsigned sum, cnt, mine, sp = 0u;
    for (;;) {
        sum = 0u; cnt = 0u; mine = 0u;
#pragma unroll
        for (unsigned j = 0; j < 16; ++j) { const unsigned c = xb_ld(&bar[XB_XCNT(j)]); sum += c; cnt += (c > 0u) ? 1u : 0u; mine = (j == x) ? c : mine; }
        if (sum == G) break;
        __builtin_amdgcn_s_sleep(1);
        if ((++sp & 255u) == 0u) { if (xb_ld(&bar[XB_TMO])) break; if (sp > XB_SPIN_CAP) { atomicAdd(&bar[XB_TMO], 1u); break; } }
    }
    nloc = mine > 0u ? mine : 1u; nx = cnt > 0u ? cnt : 1u;
}
__device__ __forceinline__ void xcd_barrier(const XcdBarrier& b, int tid) {
    asm volatile("s_waitcnt vmcnt(0)" ::: "memory");
    __syncthreads();
    if (tid == 0) {
        unsigned* bar = b.bar;
        __builtin_amdgcn_s_waitcnt(0);
        unsigned nloc = b.st[0], nx = b.st[1];
        if (nloc == 0u) { xcd_barrier_complete(bar, b.x, nloc, nx); b.st[0] = nloc; b.st[1] = nx; }
        const unsigned old = xb_add(&bar[XB_XSUB(b.x)], 1u);
        const unsigned gen = old / nloc;
        if (old + 1u == (gen + 1u) * nloc) {
            __builtin_amdgcn_fence(__ATOMIC_RELEASE, "agent");
            asm volatile("s_waitcnt vmcnt(0)" ::: "memory");
            const unsigned og = xb_add(&bar[XB_TOP], 1u);
            const unsigned tg = og / nx;
            if (og + 1u == (tg + 1u) * nx) xb_add(&bar[XB_TOPGEN], 1u);
            else XB_SPIN(xb_ld(&bar[XB_TOPGEN]) == tg, bar);
            __builtin_amdgcn_fence(__ATOMIC_ACQUIRE, "agent");
            xb_add(&bar[XB_XGEN(b.x)], 1u);
            asm volatile("s_waitcnt vmcnt(0)" ::: "memory");
        } else {
            XB_SPIN(xb_ld(&bar[XB_XGEN(b.x)]) == gen, bar);
            __builtin_amdgcn_fence(__ATOMIC_ACQUIRE, "agent");
            asm volatile("s_waitcnt vmcnt(0)" ::: "memory");
        }
    }
    __syncthreads();
}

#ifndef PHMASK
#define PHMASK 0xffffff
#endif
#define EN(k) ((PHMASK >> (k)) & 1)
constexpr int NPHASE = 21;
__global__ void __launch_bounds__(512, 2) fwd_kernel(Args A) {
    __shared__ __attribute__((aligned(16))) unsigned char lds_raw[LDS_BYTES];
    LAS unsigned char* lds = (LAS unsigned char*)lds_raw;
    const int wave_s = __builtin_amdgcn_readfirstlane((int)threadIdx.x >> 6);
#define TID make_tid(wave_s)
    if (threadIdx.x < 4) ((LAS unsigned*)(lds + 131072))[threadIdx.x] = 0u;
    __syncthreads();
    (void)xcd_barrier_post((unsigned*)(A.ws + WS_BARR), (volatile LAS unsigned*)(lds + 131072));
    if (A.ph_hi > NPHASE) cg::this_grid().sync();
#ifndef REPMASK
#define REPMASK 0
#endif
    const int ph_end = __builtin_amdgcn_readfirstlane(A.ph_hi);
    int rep_done = 0;
    for (int ph = __builtin_amdgcn_readfirstlane(A.ph_lo); ph < ph_end; ) {
        {
        int G = gridDim.x, bid = blockIdx.x; asm volatile("" : "+s"(G), "+s"(bid));
        unsigned long long zoff = 0; asm volatile("" : "+s"(zoff));
        unsigned char* ws = A.ws + zoff;
        const bool is_gemm = (ph == 1) | (ph == 5) | (ph == 7) | (ph == 9) | (ph == 11) | (ph == 15) | (ph == 17) | (ph == 19);
        const bool is_ln = (ph == 6) | (ph == 10) | (ph == 16) | (ph == 20);
        if (EN(1) && is_gemm) {
            const bf16_t* Ap = (const bf16_t*)(ws + WS_XB); const bf16_t* Ad = (const bf16_t*)(ws + WS_XBD); int ldad = 1024;
            size_t wofs = WS_WGI, oofs = WS_PROJ, dofs = WS_PROJD; int N = 4096, K = 1024, ldo = 4096, nbf = 4096, nf = 16, ncg = 65, ldp = NUP;
            if (ph == 5) { Ap = (const bf16_t*)(ws + WS_YB); Ad = (const bf16_t*)(ws + WS_YBD); ldad = DFF; wofs = WS_WGO; N = 1024; K = 1024; }
            else if (ph == 7 || ph == 17) { wofs = (ph == 7) ? WS_WUP0 : WS_WUP1; N = NUP; K = 1024; ldo = NUP; nbf = NUP; nf = 0; ncg = 88; }
            else if (ph == 9 || ph == 19) { Ap = (const bf16_t*)(ws + WS_YB); Ad = (const bf16_t*)(ws + WS_YBD); ldad = DFF; wofs = (ph == 9) ? WS_WDN0 : WS_WDN1; N = 1024; K = DFF; }
            else if (ph == 11) { wofs = WS_WSI; N = 5120; K = 1024; ldo = 5120; nbf = 5120; nf = 32; ncg = 81; }
            else if (ph == 15) { Ap = (const bf16_t*)(ws + WS_YB); Ad = (const bf16_t*)(ws + WS_YBD); ldad = DFF; wofs = WS_WSO; N = 1024; K = 2048; }
            if (N == 1024) { oofs = WS_H; dofs = WS_HD; ldo = 1024; nbf = 1024; nf = 0; ncg = 16; ldp = 1024; }
            const bf16_t* Bt = (const bf16_t*)(ws + wofs);
            pg8::Gemm g{Ap, Bt, MP, N, K}; pg8::StaticOrder S; S.init(MP, N, G, bid);
            const bool gated = (ph == 7) | (ph == 17); const int lyr = (ph == 17);
            if (gated) oofs = WS_YB;
            pg8::EpiUni E{gated ? 2 : 1, (bf16_t*)(ws + oofs), ldo,
                          A.in[23] + (size_t)lyr * 3 * DFF, A.in[24] + (size_t)lyr * DFF, (float*)(ws + WS_XF), A.out + O_FCP + (size_t)lyr * 8 * 2 * DFF};
            pg8::gemm_phase(lds, g, S, E, TID);
            DecStore st{ldp, nbf, nf, (bf16_t*)(ws + dofs), (float*)(ws + WS_BAD)};
            {
                const int rxt = S.nwg % G, nfree = G - rxt;
                if (bid >= rxt) for (int it = bid - rxt; it < 8 * ncg; it += nfree) small_gemm_item(lds, Ad, ldad, Bt, K, it, st, TID);
            }
            if (ph == 1) { for (int it = bid; it < MP / 128; it += G) narrow_item<1>(Ap, Bt + (size_t)4096 * 1024, 1024, (float*)(ws + WS_BA), it, TID); }
            if (ph == 11) { for (int it = bid; it < MP / 128; it += G) narrow_item<2>(Ap, Bt + (size_t)5120 * 1024, 1024, (float*)(ws + WS_BA), it, TID); }
        } else if (EN(6) && is_ln) {
            const int tid = TID, wid = tid >> 6, lane = tid & 63; (void)tid;
            const int layer = (ph >= 16); const bool fin = (ph == 20), is2 = (ph == 10) | (ph == 20);
            const float* gam = A.in[is2 ? 28 : 26] + layer * 1024; const float* bet = A.in[is2 ? 29 : 27] + layer * 1024;
            bf16_t* XB = (bf16_t*)(ws + WS_XB); bf16_t* XBd = (bf16_t*)(ws + WS_XBD);
            const bf16_t* H = (const bf16_t*)(ws + WS_H); const bf16_t* Hd = (const bf16_t*)(ws + WS_HD);
            for (int it = bid; it < (MP + DB) / 16; it += G) { const int row = it * 16 + wid * 2;
                if (row < MP) { const size_t o0 = (size_t)row * 1024, o1 = o0 + 1024;
                    ln_row2(XB + o0, H + o0, XB + o1, H + o1, gam, bet, fin ? A.out + O_YP + o0 : (float*)nullptr, fin ? (bf16_t*)nullptr : XB + o0, fin ? A.out + O_YP + o1 : (float*)nullptr, fin ? (bf16_t*)nullptr : XB + o1, lane); }
                else { const size_t o0 = (size_t)(row - MP) * 1024, o1 = o0 + 1024;
                    ln_row2(XBd + o0, Hd + o0, XBd + o1, Hd + o1, gam, bet, fin ? A.out + O_YS + o0 : (float*)nullptr, fin ? (bf16_t*)nullptr : XBd + o0, fin ? A.out + O_YS + o1 : (float*)nullptr, fin ? (bf16_t*)nullptr : XBd + o1, lane); } }
        } else if (EN(0) && ph == 0) {
            const int tid = TID, wid = tid >> 6, lane = tid & 63; (void)tid; (void)wid; (void)lane;
#define P0_DESC(it) \
            int mi = 0; \
            _Pragma("unroll") for (int q = 1; q < 8; ++q) mi += ((it) >= P0_BASE[q]) ? 1 : 0; \
            const float* W = A.in[P0_IN[mi]] + P0_INOFF[mi]; bf16_t* Wt = (bf16_t*)(ws + P0_WOFS[mi]); const int K = P0_K[mi], N = P0_N[mi]; \
            const int idx = (it) - P0_BASE[mi], nk = K / 128, k0 = (idx % nk) * 128, n0 = (idx / nk) * 64; \
            const int ns0 = (mi == 4 || mi == 5) ? (((n0 >> 7) & 1) * DFF + (n0 >> 8) * 128 + (n0 & 127)) : n0;
            for (int it = bid; it < 1032; it += G) {
                if (it < 1024) convert_rows16(A.in[0] + (size_t)it * 16 * 1024, (bf16_t*)(ws + WS_XB) + (size_t)it * 16 * 1024, TID);
                else convert_rows16(A.in[1] + (size_t)(it - 1024) * 16 * 1024, (bf16_t*)(ws + WS_XBD) + (size_t)(it - 1024) * 16 * 1024, TID);
            }
            LAS float* s = (LAS float*)lds;
            float rr[16];
            if (bid < 3712) { P0_DESC(bid)
#pragma unroll
                for (int i = 0; i < 16; ++i) { const int e = i * 512 + tid, kk = e >> 6, nn = e & 63, n = ns0 + nn; rr[i] = (n < N) ? __builtin_nontemporal_load(W + (size_t)(k0 + kk) * N + n) : 0.f; } }
            for (int it = bid; it < 3712; it += G) {
#pragma unroll
                for (int i = 0; i < 16; ++i) { const int e = i * 512 + tid, kk = e >> 6, nn = e & 63; s[nn * 129 + kk] = rr[i]; }
                __syncthreads();
                if (it + G < 3712) { P0_DESC(it + G)
#pragma unroll
                    for (int i = 0; i < 16; ++i) { const int e = i * 512 + tid, kk = e >> 6, nn = e & 63, n = ns0 + nn; rr[i] = (n < N) ? __builtin_nontemporal_load(W + (size_t)(k0 + kk) * N + n) : 0.f; } }
                { P0_DESC(it)
#pragma unroll
                    for (int i = 0; i < 8; ++i) { const int e = i * 512 + tid, nn = e >> 6, kp = e & 63;
                        *(unsigned*)(Wt + (size_t)(n0 + nn) * K + k0 + 2 * kp) = pack2(s[nn * 129 + 2 * kp], s[nn * 129 + 2 * kp + 1]); } }
                __syncthreads();
            }
#undef P0_DESC
        } else if (EN(2) && ph == 2) {
            gdn_a_phase(lds, A, bid, G, TID);
#ifndef NO_DEC
            for (int it = bid; it < 1024; it += G) gdn_dec_item(lds, A, it, TID);
#endif
        } else if (EN(3) && ph == 3) {
            for (int it = bid; it < 256; it += G) gdn_scan_item(lds, A, it, TID);
        } else if (EN(4) && ph == 4) {
            const int tid = TID, wid = tid >> 6, lane = tid & 63; (void)tid; (void)wid; (void)lane;
            for (int it = bid; it < MP / 16; it += G) gdn_gate_row2(A, (size_t)it * 16 + wid * 2, lane);
        } else if (EN(8) && (ph == 8 || ph == 18)) {
            const int layer = (ph == 18);
            const float* cw = A.in[23] + (size_t)layer * 3 * DFF; const float* cb = A.in[24] + (size_t)layer * DFF;
            for (int it = bid; it < 256 + DB; it += G) {
                if (it < 256) ffn_fixup_item((const float*)(ws + WS_XF), (const float*)(ws + WS_XF) + (size_t)256 * 2 * DFF, (bf16_t*)(ws + WS_YB), cw, it, TID);
                else ffn_gate_dec_item((const bf16_t*)(ws + WS_PROJD), (bf16_t*)(ws + WS_YBD), cw, cb, A.in[6] + (size_t)layer * 128 * 2 * DFF, A.out + O_FCS + (size_t)layer * 128 * 2 * DFF, it - 256, TID); }
        } else if (EN(12) && ph == 12) {
            for (int it = bid; it < MP / 16; it += G) ssd_conv_item(A, it, TID);
            __syncthreads();
            for (int it = bid; it < 512; it += G) ssd_dec_item(lds, A, it, TID);
        } else if (EN(13) && ph == 13) {
            for (int it = bid; it < 256; it += G) ssd_scan_item(lds, A, it, TID);
        } else if (EN(14) && ph == 14) {
            const int tid = TID, wid = tid >> 6, lane = tid & 63; (void)tid; (void)wid; (void)lane;
            for (int it = bid; it < MP / 8; it += G) ssd_gate_row(A, (size_t)it * 8 + wid, lane);
        }
        }
        const bool again = (((unsigned)REPMASK >> ph) & 1u) && !rep_done;
        rep_done = again ? 1 : 0;
        const int phn = __builtin_amdgcn_readfirstlane(again ? ph : ph + 1);
        if (phn < ph_end) {
            { XcdBarrier xbar; xbar.bar = (unsigned*)(A.ws + WS_BARR); xbar.x = xb_xcc_id(); xbar.st = (volatile LAS unsigned*)(lds + 131072); xcd_barrier(xbar, TID); }
        }
        ph = phn;
    }
}

extern "C" void kernel_launch(void* const* d_in, const int* in_sizes, int n_in, void* d_out, int out_size, void* d_ws, size_t ws_size, hipStream_t stream) {
    static int grid = 0;
    if (grid == 0) {
        if (n_in != 30 || ws_size < WS_END) { fprintf(stderr, "kernel_launch: need 30 inputs and >= %zu bytes of workspace (got %d, %zu)\n", (size_t)WS_END, n_in, ws_size); grid = -1; return; }
        int dev = 0, cus = 0, per_cu = 0;
        (void)hipGetDevice(&dev); (void)hipDeviceGetAttribute(&cus, hipDeviceAttributeMultiprocessorCount, dev);
        if (hipOccupancyMaxActiveBlocksPerMultiprocessor(&per_cu, (const void*)fwd_kernel, 512, 0) != hipSuccess || per_cu < 1) { fprintf(stderr, "kernel_launch: occupancy query failed (%d)\n", per_cu); per_cu = 1; (void)hipGetLastError(); }
        grid = cus * per_cu;
    }
    if (grid < 0) return;
    if (hipMemsetAsync((char*)d_ws + WS_BARR, 0, 16384, stream) != hipSuccess) { fprintf(stderr, "kernel_launch: memset of barrier words failed\n"); return; }
    Args a{};
    for (int i = 0; i < 30; ++i) a.in[i] = (const float*)d_in[i];
    a.out = (float*)d_out; a.ws = (unsigned char*)d_ws;
#if ONE_LAUNCH
    a.ph_lo = 0; a.ph_hi = NPHASE;
    void* args[] = {&a};
    hipError_t e = hipLaunchCooperativeKernel((const void*)fwd_kernel, dim3(grid), dim3(512), args, 0, stream);
    if (e != hipSuccess) fprintf(stderr, "cooperative launch failed: %s (grid %d)\n", hipGetErrorString(e), grid);
#else
#ifndef NPH_RUN
#define NPH_RUN NPHASE
#endif
    for (int p = 0; p < NPH_RUN; ++p) { a.ph_lo = p; a.ph_hi = p + 1; hipLaunchKernelGGL(fwd_kernel, dim3(grid), dim3(512), 0, stream, a); }
#endif
}
```

```cpp
#include <hip/hip_runtime.h>
#include <hip/hip_cooperative_groups.h>
#include <cstdio>
namespace cg = cooperative_groups;

#ifndef ONE_LAUNCH
#define ONE_LAUNCH 1
#endif

#define LAS __attribute__((address_space(3)))
typedef unsigned short bf16_t;
typedef short bf16x8 __attribute__((ext_vector_type(8)));
typedef float f32x4 __attribute__((ext_vector_type(4)));
typedef float f32x2 __attribute__((ext_vector_type(2)));
typedef unsigned u32x4 __attribute__((ext_vector_type(4)));
typedef unsigned u32x2 __attribute__((ext_vector_type(2)));

constexpr int D = 1024, BP = 8, SL = 2048, MP = BP * SL, DB = 128;
constexpr int GH = 8, GIN = 4112, GINP = 4352;
constexpr int SIN = 5152, SINP = 5376, SINNER = 2048, SHEADS = 32;
constexpr int DFF = 2816, NUP = 5632;
constexpr float DN_ALPHA = 1.4142135623730951f;
constexpr float LN_EPS = 1e-5f, RMS_EPS = 1e-6f;

constexpr size_t MB = 1u << 20;
constexpr size_t WS_WGI = 0, WS_WGO = 17 * MB / 2, WS_WSI = 21 * MB / 2, WS_WSO = 21 * MB, WS_WUP0 = 25 * MB, WS_WUP1 = 36 * MB,
                 WS_WDN0 = 47 * MB, WS_WDN1 = 105 * MB / 2, WS_XB = 58 * MB, WS_XF = 90 * MB, WS_PROJ = 154 * MB, WS_H = 330 * MB,
                 WS_YB = 394 * MB, WS_BA = 482 * MB, WS_DEC = 484 * MB;
constexpr size_t WS_XBD = WS_DEC, WS_XFD = WS_XBD + 256 * 1024, WS_PROJD = WS_XFD + 512 * 1024, WS_BAD = WS_PROJD + 1441792,
                 WS_HD = WS_BAD + 16384, WS_YBD = WS_HD + 512 * 1024, WS_EGL = WS_YBD + 720896, WS_BARR = WS_EGL + 8192, WS_END = WS_BARR + 16384;
constexpr size_t WS_UT = WS_YB, WS_WN = WS_YB + 32 * MB, WS_QK = WS_YB + 64 * MB, WS_QD = WS_PROJ + 128 * MB, WS_KDT = WS_XF;
constexpr size_t WS_O = WS_H, WS_XA = WS_H, WS_BCA = WS_XF;

constexpr size_t O_YP = 0, O_YS = 16777216, O_GCP = 16908288, O_GCS = 16982016, O_GSP = 18161664, O_GSS = 19210240, O_SCP = 35987456,
                 O_SCS = 36061184, O_SSP = 37240832, O_SSS = 39337984, O_FCP = 72892416, O_FCS = 72982528;

constexpr int LDS_BYTES = 131072 + 2048;

__device__ __forceinline__ int make_tid(int wave_s) { unsigned ones = ~0u; asm volatile("" : "+s"(ones)); int t = wave_s * 64 + (int)__builtin_amdgcn_mbcnt_hi(ones, __builtin_amdgcn_mbcnt_lo(ones, 0u)); asm volatile("" : "+v"(t)); return t; }
__device__ __forceinline__ float bf2f(unsigned b) { return __uint_as_float(b << 16); }
typedef __bf16 bf16x2_t __attribute__((ext_vector_type(2)));
__device__ __forceinline__ unsigned pack2(float lo, float hi) { const f32x2 v = {lo, hi}; const bf16x2_t b = __builtin_convertvector(v, bf16x2_t); return __builtin_bit_cast(unsigned, b); }
__device__ __forceinline__ float lo_f(unsigned w) { return __uint_as_float(w << 16); }
__device__ __forceinline__ float hi_f(unsigned w) { return __uint_as_float(w & 0xffff0000u); }
__device__ __forceinline__ float silu_f(float x) { return x * __builtin_amdgcn_rcpf(1.f + __expf(-x)); }
__device__ __forceinline__ float sigmoid_f(float x) { return __builtin_amdgcn_rcpf(1.f + __expf(-x)); }
__device__ __forceinline__ float softplus_f(float x) { return x > 20.f ? x : log1pf(__expf(x)); }
#define DPP_F(x, ctrl, rmask) __builtin_bit_cast(float, __builtin_amdgcn_update_dpp(0, __builtin_bit_cast(int, (x)), (ctrl), (rmask), 0xf, false))
__device__ __forceinline__ float wave_sum(float v) {
    v += DPP_F(v, 0xB1, 0xf);
    v += DPP_F(v, 0x4E, 0xf);
    v += DPP_F(v, 0x141, 0xf);
    v += DPP_F(v, 0x140, 0xf);
    v += DPP_F(v, 0x142, 0xa);
    v += DPP_F(v, 0x143, 0xc);
    return __builtin_bit_cast(float, __builtin_amdgcn_readlane(__builtin_bit_cast(int, v), 63));
}
__device__ __forceinline__ float wave_incl_scan(float v, int lane) {
#pragma unroll
    for (int o = 1; o < 64; o <<= 1) { float t = __shfl_up(v, o); if (lane >= o) v += t; }
    return v;
}
__device__ __forceinline__ f32x4 mfma16(bf16x8 a, bf16x8 b, f32x4 c) { return __builtin_amdgcn_mfma_f32_16x16x32_bf16(a, b, c, 0, 0, 0); }
__device__ __forceinline__ void lds_barrier() { asm volatile("s_waitcnt lgkmcnt(0)" ::: "memory"); __builtin_amdgcn_s_barrier(); asm volatile("" ::: "memory"); }
__device__ __forceinline__ u32x2 pack4(f32x4 v) { u32x2 r; r.x = pack2(v[0], v[1]); r.y = pack2(v[2], v[3]); return r; }

namespace pg8 {
constexpr int BM = 256, BK = 64, HALF = 128, HTB = HALF * BK * 2, STAGE_BYTES = 8 * HTB, NXCD = 8, WGM = 8;
__device__ __forceinline__ int lds_byte(int r, int c) { const int st = (r >> 4) * 2 + (c >> 5), rr = r & 15, cc = c & 31, ob = rr * 64 + cc * 2; return st * 1024 + (ob ^ (((ob >> 9) & 1) << 5)); }
__device__ __forceinline__ void stage_rc(int b, int& R, int& C) { const int st = b / 1024, sb = b % 1024, swz = sb ^ (((sb >> 9) & 1) << 5); R = (st >> 1) * 16 + swz / 64; C = (st & 1) * 32 + (swz % 64) / 2; }
__device__ __forceinline__ int perm32(int rho) { const int n = rho >> 4, i = rho & 15; return 8 * (i >> 2) + 4 * n + (i & 3); }
struct Unit { int pm, pn; };
struct Gemm { const bf16_t* A; const bf16_t* Bt; int M, N, K; };
struct StaticOrder {
    int nM, nN, nwg, G, c;
    __device__ void init(int M, int N, int G_, int c_) { nM = M / BM; nN = N / BM; nwg = nM * nN; G = G_; c = c_; }
    __device__ bool next(int i, Unit& u) const {
        const long L = (long)i * G + c; if (L >= nwg) return false;
        int wgid = (int)L; { const int q = nwg / NXCD, r = nwg % NXCD, xcd = wgid % NXCD, off = wgid / NXCD; wgid = (xcd < r ? xcd * (q + 1) : r * (q + 1) + (xcd - r) * q) + off; }
        const int nig = WGM * nN, gid = wgid / nig, fm = gid * WGM, gsz = (nM - fm) < WGM ? (nM - fm) : WGM;
        u.pm = fm + ((wgid % nig) % gsz); u.pn = (wgid % nig) / gsz; return true;
    }
};
struct EpiF32 {
    static constexpr bool PERM = false;
    float* C; int ldc;
    __device__ __forceinline__ void operator()(const f32x4 (&acc)[2][2][4][2], const Unit& u, int wr, int wc, int fr, int fq) const {
        const int row0 = u.pm * BM + wr * 64 + fr, col0 = u.pn * BM + wc * 32 + 4 * fq;
#pragma unroll
        for (int ai = 0; ai < 2; ++ai)
#pragma unroll
            for (int m = 0; m < 4; ++m) { float* rowp = C + (size_t)(row0 + ai * HALF + m * 16) * ldc + col0;
#pragma unroll
                for (int bj = 0; bj < 2; ++bj)
#pragma unroll
                    for (int n = 0; n < 2; ++n) *(f32x4*)(rowp + bj * HALF + n * 16) = acc[ai][bj][m][n]; }
    }
};
struct EpiBf16 {
    static constexpr bool PERM = true;
    bf16_t* O; int ldo;
    __device__ __forceinline__ void operator()(const f32x4 (&acc)[2][2][4][2], const Unit& u, int wr, int wc, int fr, int fq) const {
        const int row0 = u.pm * BM + wr * 64 + fr, col0 = u.pn * BM + wc * 32 + 8 * fq;
#pragma unroll
        for (int ai = 0; ai < 2; ++ai)
#pragma unroll
            for (int m = 0; m < 4; ++m) { bf16_t* rowp = O + (size_t)(row0 + ai * HALF + m * 16) * ldo + col0;
#pragma unroll
                for (int bj = 0; bj < 2; ++bj) { const f32x4 v0 = acc[ai][bj][m][0], v1 = acc[ai][bj][m][1];
                    u32x4 w; w.x = pack2(v0[0], v0[1]); w.y = pack2(v0[2], v0[3]); w.z = pack2(v1[0], v1[1]); w.w = pack2(v1[2], v1[3]);
                    *(u32x4*)(rowp + bj * HALF) = w; } }
    }
};
__device__ __forceinline__ float dpp_ror1(float x) { return __builtin_bit_cast(float, __builtin_amdgcn_update_dpp(0, __builtin_bit_cast(int, x), 0x121, 0xf, 0xf, false)); }
__device__ __forceinline__ float dpp_ror2(float x) { return __builtin_bit_cast(float, __builtin_amdgcn_update_dpp(0, __builtin_bit_cast(int, x), 0x122, 0xf, 0xf, false)); }
struct EpiGate {
    bf16_t* HB; const float* cw; const float* cb; float* edge; float* first; float* cache;
    __device__ __forceinline__ void operator()(const f32x4 (&acc)[2][2][4][2], const Unit& u, int wr, int wc, int fr_, int fq_) const {
        int fr = fr_, fq = fq_; asm volatile("" : "+v"(fr), "+v"(fq));
#pragma unroll
        for (int n = 0; n < 2; ++n) {
            const int ch = u.pn * 128 + wc * 32 + 8 * fq + 4 * n;
            const f32x4 w0 = *(const f32x4*)(cw + ch), w1 = *(const f32x4*)(cw + DFF + ch), w2 = *(const f32x4*)(cw + 2 * DFF + ch), bb = *(const f32x4*)(cb + ch);
#pragma unroll
            for (int ai = 0; ai < 2; ++ai) {
                const int strip = u.pm * 4 + ai * 2 + wr;
                f32x4 pr1 = (f32x4){0.f, 0.f, 0.f, 0.f}, pr2 = pr1;
#pragma unroll
                for (int m = 0; m < 4; ++m) {
                    const f32x4 g = acc[ai][0][m][n], v = acc[ai][1][m][n];
                    f32x4 c1, c2;
#pragma unroll
                    for (int j = 0; j < 4; ++j) { c1[j] = dpp_ror1(g[j]); c2[j] = dpp_ror2(g[j]); }
                    const f32x4 p1 = (m == 0 || fr >= 1) ? c1 : pr1;
                    const f32x4 p2 = (m == 0 || fr >= 2) ? c2 : pr2;
                    pr1 = c1; pr2 = c2;
                    const size_t row = (size_t)u.pm * 256 + ai * 128 + wr * 64 + m * 16 + fr;
                    if (m == 0 && fr < 2) {
                        const f32x4 pa = (fr == 0) ? (bb + w2 * g) : (bb + w1 * p1 + w2 * g);
                        float* fp = first + ((size_t)strip * 2 + fr) * (2 * DFF) + ch;
                        *(f32x4*)fp = pa; *(f32x4*)(fp + DFF) = v;
                    } else {
                        const f32x4 y = bb + w0 * p2 + w1 * p1 + w2 * g; f32x4 o;
#pragma unroll
                        for (int j = 0; j < 4; ++j) o[j] = silu_f(y[j]) * v[j];
                        *(u32x2*)(HB + row * DFF + ch) = pack4(o);
                    }
                    if (m == 3 && fr >= 14) {
                        *(f32x4*)(edge + ((size_t)strip * 2 + (fr - 14)) * DFF + ch) = g;
                        if ((strip & 31) == 31) *(f32x4*)(cache + ((size_t)(strip >> 5) * 2 + (fr - 14)) * DFF + ch) = g;
                    }
                }
            }
        }
    }
};
struct EpiUni {
    int mode; bf16_t* O; int ldo; const float* cw; const float* cb; float* aux; float* cache;
    __device__ __forceinline__ void operator()(const f32x4 (&acc)[2][2][4][2], const Unit& u, int wr, int wc, int fr_, int fq_) const {
        (void)fr_; (void)fq_;
        unsigned ones = ~0u; asm volatile("" : "+s"(ones));
        const int lane_e = (int)__builtin_amdgcn_mbcnt_hi(ones, __builtin_amdgcn_mbcnt_lo(ones, 0u)), fr = lane_e & 15, fq = lane_e >> 4;
        if (mode == 2) { EpiGate e{O, cw, cb, aux, aux + (size_t)256 * 2 * DFF, cache}; e(acc, u, wr, wc, fr, fq); }
        else { EpiBf16 e{O, ldo}; e(acc, u, wr, wc, fr, fq); }
    }
};

template <class Epi, class Sched>
__device__ __forceinline__ void gemm_phase(LAS unsigned char* lds, const Gemm g, const Sched& S, const Epi& E, int tid_in) {
    const int tid = tid_in, wid = __builtin_amdgcn_readfirstlane(tid >> 6), lane = tid & 63, wr = wid >> 2, wc = wid & 3, fr = lane & 15, fq = lane >> 4;
    const int K = g.K, nt = K / BK;
    unsigned voffA[2], voffB[2];
#pragma unroll
    for (int i = 0; i < 2; ++i) { int R, C; stage_rc(tid * 16 + i * 8192, R, C); const int Rb = (E.mode != 0) ? ((R & ~31) + perm32(R & 31)) : R;
        voffA[i] = (unsigned)(R * K + C) * 2u; voffB[i] = (unsigned)(Rb * K + C) * 2u; }
    const size_t kstep = (size_t)(BK * 2);
    const size_t hstep = (size_t)HALF * K * 2;
    const size_t tstep = 2 * hstep;
    const unsigned ldsw = (unsigned)wid * 1024u;
    const int aoff = lds_byte(wr * 64 + fr, fq * 8), boff = lds_byte(wc * 32 + fr, fq * 8);
#define PG8_SA(b, h) (((b) * 2 + (h)) * HTB)
#define PG8_SB(b, h) ((4 + (b) * 2 + (h)) * HTB)
#define PG8_STAGE(bufoff, gbase, voff) do { _Pragma("unroll") for (int _i = 0; _i < 2; ++_i) \
        __builtin_amdgcn_global_load_lds((const unsigned*)((const char*)(gbase) + (voff)[_i]), (LAS unsigned*)(lds + (bufoff) + ldsw + _i * 8192), 16, 0, 0); } while (0)
#define PG8_LDA(dst, b, h) do { _Pragma("unroll") for (int m = 0; m < 4; ++m) _Pragma("unroll") for (int k = 0; k < 2; ++k) dst[m][k] = *(const LAS bf16x8*)(lds + PG8_SA(b, h) + aoff + m * 2048 + k * 1024); } while (0)
#define PG8_LDB(dst, b, h) do { _Pragma("unroll") for (int n = 0; n < 2; ++n) _Pragma("unroll") for (int k = 0; k < 2; ++k) dst[n][k] = *(const LAS bf16x8*)(lds + PG8_SB(b, h) + boff + n * 2048 + k * 1024); } while (0)
#define PG8_MMA(ai, bj, At, Bt) do { __builtin_amdgcn_s_setprio(1); _Pragma("unroll") for (int m = 0; m < 4; ++m) _Pragma("unroll") for (int n = 0; n < 2; ++n) _Pragma("unroll") for (int k = 0; k < 2; ++k) \
        acc[ai][bj][m][n] = __builtin_amdgcn_mfma_f32_16x16x32_bf16(Bt[n][k], At[m][k], acc[ai][bj][m][n], 0, 0, 0); __builtin_amdgcn_s_setprio(0); } while (0)
#define PG8_WAIT_V(n) asm volatile("s_waitcnt vmcnt(" #n ")" ::: "memory")
#define PG8_WAIT_L(n) asm volatile("s_waitcnt lgkmcnt(" #n ")" ::: "memory")
#define PG8_BAR __builtin_amdgcn_s_barrier()
#define PG8_SCHED __builtin_amdgcn_sched_barrier(0)
    Unit cur, nxt; int ui = 0;
    if (!S.next(0, cur)) return;
    f32x4 acc[2][2][4][2];
#pragma unroll
    for (int a = 0; a < 2; ++a)
#pragma unroll
        for (int b = 0; b < 2; ++b)
#pragma unroll
            for (int m = 0; m < 4; ++m)
#pragma unroll
                for (int n = 0; n < 2; ++n) acc[a][b][m][n] = (f32x4){0.f, 0.f, 0.f, 0.f};
    bf16x8 At[4][2], B0[2][2], B1[2][2];
    const char* cA = (const char*)g.A + (size_t)cur.pm * tstep; const char* cB = (const char*)g.Bt + (size_t)cur.pn * tstep;
    PG8_STAGE(PG8_SB(0, 0), cB, voffB); PG8_STAGE(PG8_SA(0, 0), cA, voffA); PG8_STAGE(PG8_SB(0, 1), cB + hstep, voffB); PG8_STAGE(PG8_SA(0, 1), cA + hstep, voffA);
    if (wr == 1) PG8_BAR;
    PG8_WAIT_V(4); PG8_BAR;
    PG8_STAGE(PG8_SB(1, 0), cB + kstep, voffB); PG8_STAGE(PG8_SA(1, 0), cA + kstep, voffA); PG8_STAGE(PG8_SB(1, 1), cB + hstep + kstep, voffB);
    PG8_WAIT_V(6); PG8_BAR;
    for (;;) {
        const bool has_next = S.next(ui + 1, nxt);
        const char* nA = has_next ? (const char*)g.A + (size_t)nxt.pm * tstep : cA; const char* nB = has_next ? (const char*)g.Bt + (size_t)nxt.pn * tstep : cB;
        for (int t = 0; t < nt; t += 2) {
            const bool last = (t == nt - 2);
            const char* a1 = cA + (size_t)(t + 1) * kstep;
            const char* a2 = last ? nA : cA + (size_t)(t + 2) * kstep; const char* b2 = last ? nB : cB + (size_t)(t + 2) * kstep;
            const char* a3 = a2 + kstep; const char* b3 = b2 + kstep;
            PG8_LDB(B0, 0, 0); PG8_SCHED; PG8_LDA(At, 0, 0); PG8_STAGE(PG8_SA(1, 1), a1 + hstep, voffA);
            PG8_WAIT_L(8); PG8_BAR; PG8_WAIT_L(0); PG8_MMA(0, 0, At, B0); PG8_BAR; PG8_SCHED;
            PG8_LDB(B1, 0, 1); PG8_STAGE(PG8_SB(0, 0), b2, voffB);
            PG8_BAR; PG8_WAIT_L(0); PG8_MMA(0, 1, At, B1); PG8_BAR;
            PG8_LDA(At, 0, 1); PG8_STAGE(PG8_SA(0, 0), a2, voffA);
            PG8_BAR; PG8_WAIT_L(0); PG8_MMA(1, 0, At, B0); PG8_BAR; PG8_SCHED;
            PG8_STAGE(PG8_SB(0, 1), b2 + hstep, voffB);
            PG8_WAIT_V(6); PG8_BAR; PG8_MMA(1, 1, At, B1); PG8_BAR;
            PG8_LDB(B0, 1, 0); PG8_SCHED; PG8_LDA(At, 1, 0); PG8_STAGE(PG8_SA(0, 1), a2 + hstep, voffA);
            PG8_WAIT_L(8); PG8_BAR; PG8_WAIT_L(0); PG8_MMA(0, 0, At, B0); PG8_BAR; PG8_SCHED;
            PG8_LDB(B1, 1, 1); PG8_STAGE(PG8_SB(1, 0), b3, voffB);
            PG8_BAR; PG8_WAIT_L(0); PG8_MMA(0, 1, At, B1); PG8_BAR;
            PG8_LDA(At, 1, 1); PG8_STAGE(PG8_SA(1, 0), a3, voffA);
            PG8_BAR; PG8_WAIT_L(0); PG8_MMA(1, 0, At, B0); PG8_BAR; PG8_SCHED;
            PG8_STAGE(PG8_SB(1, 1), b3 + hstep, voffB);
            PG8_WAIT_V(6); PG8_BAR; PG8_MMA(1, 1, At, B1); PG8_BAR;
        }
        E(acc, cur, wr, wc, fr, fq);
        if (!has_next) break;
#pragma unroll
        for (int a = 0; a < 2; ++a)
#pragma unroll
            for (int b = 0; b < 2; ++b)
#pragma unroll
                for (int m = 0; m < 4; ++m)
#pragma unroll
                    for (int n = 0; n < 2; ++n) acc[a][b][m][n] = (f32x4){0.f, 0.f, 0.f, 0.f};
        cur = nxt; cA = nA; cB = nB; ++ui;
    }
    PG8_WAIT_V(0);
    if (wr == 0) PG8_BAR;
    PG8_BAR;
#undef PG8_SA
#undef PG8_SB
#undef PG8_STAGE
#undef PG8_LDA
#undef PG8_LDB
#undef PG8_MMA
#undef PG8_WAIT_V
#undef PG8_WAIT_L
#undef PG8_BAR
#undef PG8_SCHED
}
}

struct Args {
    const float* in[30];
    float* out;
    unsigned char* ws;
    int ph_lo, ph_hi;
};

struct DecStore {
    int ldp, nbf, nf; bf16_t* Pd; float* BAd;
    __device__ __forceinline__ void operator()(int row, int col, float v0, float v1) const {
        if (col < nbf) { *(unsigned*)(Pd + (size_t)row * ldp + col) = pack2(v0, v1); }
        else if (col < nbf + nf) { BAd[row * 32 + col - nbf] = v0; BAd[row * 32 + col - nbf + 1] = v1; }
    }
};
__device__ __forceinline__ void small_gemm_item(LAS unsigned char* lds, const bf16_t* __restrict__ A, int lda, const bf16_t* __restrict__ Bt, int K, int item, const DecStore& st, int tid_in) {
    const int tid = tid_in, wid = tid >> 6, lane = tid & 63, fr = lane & 15, fq = lane >> 4;
    const int rg = item & 7, cgp = item >> 3;
    const int kw = K >> 3;
    const bf16_t* ap = A + (size_t)(rg * 16 + fr) * lda + wid * kw + fq * 8;
    const bf16_t* bp = Bt + (size_t)(cgp * 64 + fr) * K + wid * kw + fq * 8;
    f32x4 acc[4];
#pragma unroll
    for (int n = 0; n < 4; ++n) acc[n] = (f32x4){0.f, 0.f, 0.f, 0.f};
    int k0 = 0;
    for (; k0 + 128 <= kw; k0 += 128) {
        bf16x8 a[4], bq[4][4];
#pragma unroll
        for (int q = 0; q < 4; ++q) { a[q] = *(const bf16x8*)(ap + k0 + 32 * q);
#pragma unroll
            for (int n = 0; n < 4; ++n) bq[q][n] = *(const bf16x8*)(bp + (size_t)n * 16 * K + k0 + 32 * q); }
#pragma unroll
        for (int q = 0; q < 4; ++q)
#pragma unroll
            for (int n = 0; n < 4; ++n) acc[n] = mfma16(a[q], bq[q][n], acc[n]);
    }
    for (; k0 < kw; k0 += 32) {
        const bf16x8 a = *(const bf16x8*)(ap + k0);
#pragma unroll
        for (int n = 0; n < 4; ++n) { const bf16x8 b = *(const bf16x8*)(bp + (size_t)n * 16 * K + k0); acc[n] = mfma16(a, b, acc[n]); }
    }
    LAS float* red = (LAS float*)lds;
#pragma unroll
    for (int n = 0; n < 4; ++n)
#pragma unroll
        for (int r = 0; r < 4; ++r) red[wid * 1024 + (fq * 4 + r) * 64 + n * 16 + fr] = acc[n][r];
    __syncthreads();
    {
        const int row = tid >> 5, c2 = (tid & 31) * 2; float v0 = 0.f, v1 = 0.f;
#pragma unroll
        for (int w = 0; w < 8; ++w) { v0 += red[w * 1024 + row * 64 + c2]; v1 += red[w * 1024 + row * 64 + c2 + 1]; }
        st(rg * 16 + row, cgp * 64 + c2, v0, v1);
    }
    __syncthreads();
}

template <int NT>
__device__ __forceinline__ void narrow_item(const bf16_t* __restrict__ A, const bf16_t* __restrict__ Bt, int K, float* __restrict__ BAo, int item, int tid_in) {
    const int tid = tid_in, wid = tid >> 6, lane = tid & 63, fr = lane & 15, fq = lane >> 4;
    const int row0 = item * 128 + wid * 16;
    const bf16_t* ap = A + (size_t)(row0 + fr) * K + fq * 8;
    const bf16_t* bp = Bt + (size_t)fr * K + fq * 8;
    f32x4 acc[NT];
#pragma unroll
    for (int n = 0; n < NT; ++n) acc[n] = (f32x4){0.f, 0.f, 0.f, 0.f};
#pragma unroll 8
    for (int k = 0; k < K; k += 32) {
        const bf16x8 a = *(const bf16x8*)(ap + k);
#pragma unroll
        for (int n = 0; n < NT; ++n) { const bf16x8 bfr = *(const bf16x8*)(bp + (size_t)n * 16 * K + k); acc[n] = mfma16(bfr, a, acc[n]); }
    }
#pragma unroll
    for (int n = 0; n < NT; ++n) *(f32x4*)(BAo + (size_t)(row0 + fr) * 32 + n * 16 + fq * 4) = acc[n];
}

__device__ __forceinline__ void convert_rows16(const float* __restrict__ src, bf16_t* __restrict__ dst, int tid_in) {
#pragma unroll
    for (int i = 0; i < 8; ++i) { const int e = i * 512 + tid_in; const f32x4 v = __builtin_nontemporal_load((const f32x4*)src + e);
        u32x2 w; w.x = pack2(v[0], v[1]); w.y = pack2(v[2], v[3]); ((u32x2*)dst)[e] = w; }
}

__device__ __forceinline__ void unpack8(const u32x4 w, float (&f)[8]) {
    f[0] = lo_f(w.x); f[1] = hi_f(w.x); f[2] = lo_f(w.y); f[3] = hi_f(w.y); f[4] = lo_f(w.z); f[5] = hi_f(w.z); f[6] = lo_f(w.w); f[7] = hi_f(w.w);
}
__device__ __forceinline__ u32x4 pack8(const float (&f)[8]) { u32x4 w; w.x = pack2(f[0], f[1]); w.y = pack2(f[2], f[3]); w.z = pack2(f[4], f[5]); w.w = pack2(f[6], f[7]); return w; }
__device__ __forceinline__ void ln_row(const bf16_t* __restrict__ xres, const bf16_t* __restrict__ h, const float* __restrict__ gam, const float* __restrict__ bet,
                                       float* __restrict__ outF, bf16_t* __restrict__ outB, int lane) {
    float v[2][8]; float s = 0.f;
#pragma unroll
    for (int i = 0; i < 2; ++i) { float a[8], b[8]; unpack8(((const u32x4*)xres)[i * 64 + lane], a); unpack8(((const u32x4*)h)[i * 64 + lane], b);
#pragma unroll
        for (int j = 0; j < 8; ++j) { v[i][j] = a[j] * DN_ALPHA + b[j]; s += v[i][j]; } }
    const float mu = wave_sum(s) * (1.f / 1024.f); float q = 0.f;
#pragma unroll
    for (int i = 0; i < 2; ++i)
#pragma unroll
        for (int j = 0; j < 8; ++j) { v[i][j] -= mu; q += v[i][j] * v[i][j]; }
    const float rstd = __builtin_amdgcn_rsqf(wave_sum(q) * (1.f / 1024.f) + LN_EPS);
#pragma unroll
    for (int i = 0; i < 2; ++i) { float o[8];
#pragma unroll
        for (int hh = 0; hh < 2; ++hh) { const f32x4 g = ((const f32x4*)gam)[i * 128 + lane * 2 + hh], b = ((const f32x4*)bet)[i * 128 + lane * 2 + hh];
#pragma unroll
            for (int j = 0; j < 4; ++j) o[hh * 4 + j] = v[i][hh * 4 + j] * rstd * g[j] + b[j]; }
        if (outB) ((u32x4*)outB)[i * 64 + lane] = pack8(o);
        if (outF) { ((f32x4*)outF)[i * 128 + lane * 2] = (f32x4){o[0], o[1], o[2], o[3]}; ((f32x4*)outF)[i * 128 + lane * 2 + 1] = (f32x4){o[4], o[5], o[6], o[7]}; } }
}

__device__ __forceinline__ void ln_row2(const bf16_t* __restrict__ x0, const bf16_t* __restrict__ h0, const bf16_t* __restrict__ x1, const bf16_t* __restrict__ h1,
                                        const float* __restrict__ gam, const float* __restrict__ bet, float* oF0, bf16_t* oB0, float* oF1, bf16_t* oB1, int lane) {
    u32x4 xa[2][2], ha[2][2];
#pragma unroll
    for (int i = 0; i < 2; ++i) { xa[0][i] = ((const u32x4*)x0)[i * 64 + lane]; ha[0][i] = ((const u32x4*)h0)[i * 64 + lane]; xa[1][i] = ((const u32x4*)x1)[i * 64 + lane]; ha[1][i] = ((const u32x4*)h1)[i * 64 + lane]; }
#pragma unroll
    for (int rr = 0; rr < 2; ++rr) {
        float v[2][8]; float s = 0.f;
#pragma unroll
        for (int i = 0; i < 2; ++i) { float a[8], b[8]; unpack8(xa[rr][i], a); unpack8(ha[rr][i], b);
#pragma unroll
            for (int j = 0; j < 8; ++j) { v[i][j] = a[j] * DN_ALPHA + b[j]; s += v[i][j]; } }
        const float mu = wave_sum(s) * (1.f / 1024.f); float q = 0.f;
#pragma unroll
        for (int i = 0; i < 2; ++i)
#pragma unroll
            for (int j = 0; j < 8; ++j) { v[i][j] -= mu; q += v[i][j] * v[i][j]; }
        const float rstd = __builtin_amdgcn_rsqf(wave_sum(q) * (1.f / 1024.f) + LN_EPS);
        float* outF = rr ? oF1 : oF0; bf16_t* outB = rr ? oB1 : oB0;
#pragma unroll
        for (int i = 0; i < 2; ++i) { float o[8];
#pragma unroll
            for (int hh = 0; hh < 2; ++hh) { const f32x4 g = ((const f32x4*)gam)[i * 128 + lane * 2 + hh], b = ((const f32x4*)bet)[i * 128 + lane * 2 + hh];
#pragma unroll
                for (int j = 0; j < 4; ++j) o[hh * 4 + j] = v[i][hh * 4 + j] * rstd * g[j] + b[j]; }
            if (outB) ((u32x4*)outB)[i * 64 + lane] = pack8(o);
            if (outF) { __builtin_nontemporal_store((f32x4){o[0], o[1], o[2], o[3]}, (f32x4*)outF + i * 128 + lane * 2); __builtin_nontemporal_store((f32x4){o[4], o[5], o[6], o[7]}, (f32x4*)outF + i * 128 + lane * 2 + 1); } }
    }
}

__device__ __forceinline__ void ffn_fixup_item(const float* __restrict__ edge, const float* __restrict__ first, bf16_t* __restrict__ HB, const float* __restrict__ cw, int strip, int tid_in) {
    const int t = tid_in; if (t >= 352) return;
    const int c0 = t * 8;
    const bool has_hist = (strip & 31) != 0;
#pragma unroll
    for (int hh = 0; hh < 2; ++hh) {
        const int ch = c0 + 4 * hh;
        const f32x4 w0 = *(const f32x4*)(cw + ch), w1 = *(const f32x4*)(cw + DFF + ch);
        f32x4 e0 = (f32x4){0.f, 0.f, 0.f, 0.f}, e1 = e0;
        if (has_hist) { e0 = *(const f32x4*)(edge + ((size_t)(strip - 1) * 2 + 0) * DFF + ch); e1 = *(const f32x4*)(edge + ((size_t)(strip - 1) * 2 + 1) * DFF + ch); }
#pragma unroll
        for (int rr = 0; rr < 2; ++rr) {
            const float* fp = first + ((size_t)strip * 2 + rr) * (2 * DFF) + ch;
            const f32x4 pa = *(const f32x4*)fp, v = *(const f32x4*)(fp + DFF);
            const f32x4 y = (rr == 0) ? (pa + w0 * e0 + w1 * e1) : (pa + w0 * e1); f32x4 o;
#pragma unroll
            for (int j = 0; j < 4; ++j) o[j] = silu_f(y[j]) * v[j];
            *(u32x2*)(HB + ((size_t)strip * 64 + rr) * DFF + ch) = pack4(o);
        }
    }
}
__device__ __forceinline__ void ffn_gate_dec_item(const bf16_t* __restrict__ GVd, bf16_t* __restrict__ HBd, const float* __restrict__ cw, const float* __restrict__ cb,
                                                  const float* __restrict__ cache_in  , float* __restrict__ cache_out, int item, int tid_in) {
    const int t = tid_in; if (t >= 352) return;
    const int c0 = t * 8;
    float w0[8], w1[8], w2[8], bb[8];
#pragma unroll
    for (int j = 0; j < 8; ++j) { w0[j] = cw[c0 + j]; w1[j] = cw[DFF + c0 + j]; w2[j] = cw[2 * DFF + c0 + j]; bb[j] = cb[c0 + j]; }
    {
        const int row = item;
        float gcur[8], vv[8], o[8];
        const int cp = 256 * (c0 >> 7) + (c0 & 127);
        unpack8(*(const u32x4*)(GVd + (size_t)row * NUP + cp), gcur); unpack8(*(const u32x4*)(GVd + (size_t)row * NUP + cp + 128), vv);
        const float* ci = cache_in + (size_t)row * 2 * DFF + c0; float* co = cache_out + (size_t)row * 2 * DFF + c0;
#pragma unroll
        for (int j = 0; j < 8; ++j) { const float c0v = ci[j], c1v = ci[DFF + j]; const float y = bb[j] + w0[j] * c0v + w1[j] * c1v + w2[j] * gcur[j]; o[j] = silu_f(y) * vv[j];
            co[j] = c1v; co[DFF + j] = gcur[j]; }
        *(u32x4*)(HBd + (size_t)row * DFF + c0) = pack8(o);
    }
}

constexpr int GA_QS = 0, GA_KS = 17408, GA_VBT = 34816, GA_KBGT = 53248, GA_MS = 71680, GA_TS = 89088, GA_GC = 98304, GA_BT = 98560, GA_TL = 99328, GA_PB = 115712;
__device__ __forceinline__ void gdn_a_phase(LAS unsigned char* lds, const Args& A, int bid, int G, int tid_in) {
    const bf16_t* PROJ = (const bf16_t*)(A.ws + WS_PROJ);
    const float* BA = (const float*)(A.ws + WS_BA);
    float* EGL = (float*)(A.ws + WS_EGL);
    LAS unsigned* Qs = (LAS unsigned*)(lds + GA_QS); LAS unsigned* Ks = (LAS unsigned*)(lds + GA_KS);
    LAS float* Ms = (LAS float*)(lds + GA_MS); LAS bf16_t* Ts = (LAS bf16_t*)(lds + GA_TS);
    LAS float* gc = (LAS float*)(lds + GA_GC); LAS float* bt = (LAS float*)(lds + GA_BT);
    LAS float* Tl = (LAS float*)(lds + GA_TL); LAS float* Pb = (LAS float*)(lds + GA_PB);
    unsigned xw[3][11]; float pbr = 0.f, par = 0.f;
#define GA_IDS int tid = tid_in; asm volatile("" : "+v"(tid)); const int wid = tid >> 6, lane = tid & 63, fr = lane & 15, fq = lane >> 4, i0 = wid * 8, c = 2 * lane; (void)fr; (void)fq;
#define GA_LOAD(it) { const int _n = (it) & 31, _h = ((it) >> 5) & 7, _b = (it) >> 8; \
        _Pragma("unroll") for (int seg = 0; seg < 3; ++seg) _Pragma("unroll") for (int r = 0; r < 11; ++r) { const int t = _n * 64 + i0 + r - 3; \
            xw[seg][r] = *(const unsigned*)(PROJ + ((size_t)_b * SL + (t < 0 ? 0 : t)) * 4096 + seg * 1024 + _h * 128 + c); } \
        if (wid == 0) { const size_t _rb = (size_t)_b * SL + _n * 64 + lane; pbr = BA[_rb * 32 + _h]; par = BA[_rb * 32 + 8 + _h]; } }
    if (bid < 2048) { GA_IDS GA_LOAD(bid) }
    for (int item = bid; item < 2048; item += G) {
        GA_IDS
        const int n = item & 31, h = (item >> 5) & 7, b = item >> 8, chunk = (b * 8 + h) * 32 + n;
        bf16_t* UT = (bf16_t*)(A.ws + WS_UT) + (size_t)chunk * 8192; bf16_t* WN = (bf16_t*)(A.ws + WS_WN) + (size_t)chunk * 8192;
        bf16_t* QD = (bf16_t*)(A.ws + WS_QD) + (size_t)chunk * 8192; bf16_t* KDT = (bf16_t*)(A.ws + WS_KDT) + (size_t)chunk * 8192;
        bf16_t* QK = (bf16_t*)(A.ws + WS_QK) + (size_t)chunk * 4096;
        if (wid == 0) {
            const float g = -__expf(A.in[10][h]) * softplus_f(par + A.in[11][h]);
            const float gcum = wave_incl_scan(g, lane);
            gc[lane] = gcum; bt[lane] = sigmoid_f(pbr);
            if (lane == 63) EGL[chunk] = __expf(gcum);
        }
        lds_barrier();
        {
            const float glast = gc[63];
#pragma unroll
            for (int seg = 0; seg < 3; ++seg) {
                const int col = seg * 1024 + h * 128 + c;
                float w0[4], w1[4];
#pragma unroll
                for (int k = 0; k < 4; ++k) { const f32x2 t = *(const f32x2*)(A.in[8] + k * 3072 + col); w0[k] = t.x; w1[k] = t.y; }
                const f32x2 bb = *(const f32x2*)(A.in[9] + col);
                float x0[11], x1[11];
#pragma unroll
                for (int r = 0; r < 11; ++r) { const bool okr = (n * 64 + i0 + r - 3) >= 0; x0[r] = okr ? lo_f(xw[seg][r]) : 0.f; x1[r] = okr ? hi_f(xw[seg][r]) : 0.f; }
                if (n == 31 && wid == 7) {
#pragma unroll
                    for (int rr = 0; rr < 3; ++rr) *(f32x2*)(A.out + O_GCP + ((size_t)b * 3 + rr) * 3072 + col) = (f32x2){x0[8 + rr], x1[8 + rr]};
                }
                float y0[8], y1[8];
#pragma unroll
                for (int r = 0; r < 8; ++r) {
                    y0[r] = silu_f(bb.x + w0[0] * x0[r] + w0[1] * x0[r + 1] + w0[2] * x0[r + 2] + w0[3] * x0[r + 3]);
                    y1[r] = silu_f(bb.y + w1[0] * x1[r] + w1[1] * x1[r + 1] + w1[2] * x1[r + 2] + w1[3] * x1[r + 3]);
                }
                if (seg < 2) {
#pragma unroll
                    for (int r = 0; r < 8; ++r) { const float ss = wave_sum(y0[r] * y0[r] + y1[r] * y1[r]); const float rn = __builtin_amdgcn_rsqf(ss + 1e-6f) * (seg == 0 ? 0.08838834764831845f : 1.f); y0[r] *= rn; y1[r] *= rn; }
                }
                if (seg == 0) {
#pragma unroll
                    for (int r = 0; r < 8; ++r) { const int i = i0 + r; Qs[i * 68 + lane] = pack2(y0[r], y1[r]); const float eg = __expf(gc[i]);
                        *(unsigned*)(QD + i * 128 + c) = pack2(y0[r] * eg, y1[r] * eg); }
                } else if (seg == 1) {
                    float a0[8], a1[8], d0[8], d1[8];
#pragma unroll
                    for (int r = 0; r < 8; ++r) { const int i = i0 + r; Ks[i * 68 + lane] = pack2(y0[r], y1[r]); const float gi = gc[i], s1 = bt[i] * __expf(gi), s2 = __expf(glast - gi);
                        a0[r] = y0[r] * s1; a1[r] = y1[r] * s1; d0[r] = y0[r] * s2; d1[r] = y1[r] * s2; }
                    *(LAS u32x4*)(lds + GA_KBGT + (c * 72 + i0) * 2) = pack8(a0); *(LAS u32x4*)(lds + GA_KBGT + ((c + 1) * 72 + i0) * 2) = pack8(a1);
                    *(u32x4*)(KDT + c * 64 + i0) = pack8(d0); *(u32x4*)(KDT + (c + 1) * 64 + i0) = pack8(d1);
                } else {
                    float a0[8], a1[8];
#pragma unroll
                    for (int r = 0; r < 8; ++r) { const float be = bt[i0 + r]; a0[r] = y0[r] * be; a1[r] = y1[r] * be; }
                    *(LAS u32x4*)(lds + GA_VBT + (c * 72 + i0) * 2) = pack8(a0); *(LAS u32x4*)(lds + GA_VBT + ((c + 1) * 72 + i0) * 2) = pack8(a1);
                }
                __builtin_amdgcn_sched_barrier(0);
            }
        }
        lds_barrier();
        if (item + G < 2048) { GA_LOAD(item + G) }
        {
            const int ti = wid >> 1;
#pragma unroll
            for (int tjj = 0; tjj < 2; ++tjj) {
                const int tj = (wid & 1) * 2 + tjj;
                f32x4 ak = (f32x4){0.f, 0.f, 0.f, 0.f}, aq = (f32x4){0.f, 0.f, 0.f, 0.f};
                if (tj <= ti) {
#pragma unroll
                    for (int kk = 0; kk < 4; ++kk) {
                        const bf16x8 bk = *(const LAS bf16x8*)(lds + GA_KS + ((tj * 16 + fr) * 136 + kk * 32 + fq * 8) * 2);
                        const bf16x8 fk = *(const LAS bf16x8*)(lds + GA_KS + ((ti * 16 + fr) * 136 + kk * 32 + fq * 8) * 2);
                        const bf16x8 fqv = *(const LAS bf16x8*)(lds + GA_QS + ((ti * 16 + fr) * 136 + kk * 32 + fq * 8) * 2);
                        ak = mfma16(fk, bk, ak); aq = mfma16(fqv, bk, aq);
                    }
                }
                const int j = tj * 16 + fr; const float gj = gc[j];
#pragma unroll
                for (int r = 0; r < 4; ++r) { const int i = ti * 16 + fq * 4 + r; const float gi = gc[i];
                    const float e = (i >= j) ? __expf(gi - gj) : 0.f;
                    if (tj <= ti) Ms[i * 68 + j] = (i > j) ? bt[i] * ak[r] * e : 0.f;
                    QK[i * 64 + j] = (bf16_t)(pack2(aq[r] * e, 0.f) & 0xffffu); }
            }
        }
        lds_barrier();
        for (int ib = 0; ib < 4; ++ib) {
            if (ib > 0) {
                float p0 = 0.f, p1 = 0.f;
                const int ra = ib * 16 + 2 * wid;
                for (int j = 0; j < ib * 16; j += 4) {
                    const float t0 = Tl[j * 64 + lane], t1 = Tl[(j + 1) * 64 + lane], t2 = Tl[(j + 2) * 64 + lane], t3 = Tl[(j + 3) * 64 + lane];
                    const f32x4 m0 = *(const LAS f32x4*)(Ms + ra * 68 + j), m1 = *(const LAS f32x4*)(Ms + (ra + 1) * 68 + j);
                    p0 += (m0[0] * t0 + m0[1] * t1) + (m0[2] * t2 + m0[3] * t3);
                    p1 += (m1[0] * t0 + m1[1] * t1) + (m1[2] * t2 + m1[3] * t3);
                }
                Pb[(2 * wid) * 64 + lane] = p0; Pb[(2 * wid + 1) * 64 + lane] = p1;
                lds_barrier();
            }
            if (wid == 0) {
                float Tr[16];
#pragma unroll
                for (int r = 0; r < 16; ++r) {
                    float a = (ib > 0) ? -Pb[r * 64 + lane] : 0.f;
#pragma unroll
                    for (int q = 0; q < r; q += 4) {
                        const f32x4 m = *(const LAS f32x4*)(Ms + (ib * 16 + r) * 68 + ib * 16 + q);
                        a -= m[0] * Tr[q];
                        if (q + 1 < r) a -= m[1] * Tr[q + 1];
                        if (q + 2 < r) a -= m[2] * Tr[q + 2];
                        if (q + 3 < r) a -= m[3] * Tr[q + 3];
                    }
                    Tr[r] = a + ((lane == ib * 16 + r) ? 1.f : 0.f);
                    Tl[(ib * 16 + r) * 64 + lane] = Tr[r];
                    Ts[(ib * 16 + r) * 72 + lane] = (bf16_t)(pack2(Tr[r], 0.f) & 0xffffu);
                }
            }
            lds_barrier();
        }
        {
            const int td = wid;
            bf16x8 bv[2], bk[2];
#pragma unroll
            for (int kk = 0; kk < 2; ++kk) { bv[kk] = *(const LAS bf16x8*)(lds + GA_VBT + ((td * 16 + fr) * 72 + kk * 32 + fq * 8) * 2);
                bk[kk] = *(const LAS bf16x8*)(lds + GA_KBGT + ((td * 16 + fr) * 72 + kk * 32 + fq * 8) * 2); }
#pragma unroll
            for (int ti = 0; ti < 4; ++ti) {
                f32x4 au = (f32x4){0.f, 0.f, 0.f, 0.f}, aw = (f32x4){0.f, 0.f, 0.f, 0.f};
#pragma unroll
                for (int kk = 0; kk < 2; ++kk) { const bf16x8 ft = *(const LAS bf16x8*)(lds + GA_TS + ((ti * 16 + fr) * 72 + kk * 32 + fq * 8) * 2);
                    au = mfma16(ft, bv[kk], au);
                    aw = mfma16(bk[kk], ft, aw); }
                *(u32x2*)(UT + (td * 16 + fr) * 64 + ti * 16 + fq * 4) = pack4(au);
                *(u32x2*)(WN + (ti * 16 + fr) * 128 + td * 16 + fq * 4) = pack4(-aw);
            }
        }
        lds_barrier();
    }
#undef GA_LOAD
#undef GA_IDS
}

__device__ __forceinline__ void gdn_dec_item(LAS unsigned char* lds, const Args& A, int item, int tid_in) {
    const int tid = tid_in, wid = tid >> 6, lane = tid & 63;
    const int h = item & 7, b = item >> 3;
    const bf16_t* Pd = (const bf16_t*)(A.ws + WS_PROJD) + (size_t)b * NUP; const float* BAd = (const float*)(A.ws + WS_BAD) + b * 32;
    bf16_t* YBd = (bf16_t*)(A.ws + WS_YBD) + (size_t)b * DFF;
    LAS float* qs = (LAS float*)lds; LAS float* ks = qs + 128; LAS float* vs = qs + 256; LAS float* sc = qs + 384;
    LAS float* part = qs + 512;
    LAS float* os = qs + 512 + 1024;
    if (tid < 384) {
        const int seg = tid >> 7, d = tid & 127, col = seg * 1024 + h * 128 + d;
        const float* cin = A.in[2] + (size_t)b * 3 * 3072 + col;
        const float c0 = cin[0], c1 = cin[3072], c2 = cin[6144], nw = bf2f(Pd[col]);
        const float* cw = A.in[8] + col;
        const float y = A.in[9][col] + cw[0] * c0 + cw[3072] * c1 + cw[6144] * c2 + cw[9216] * nw;
        qs[tid] = silu_f(y);
        float* co = A.out + O_GCS + (size_t)b * 3 * 3072 + col; co[0] = c1; co[3072] = c2; co[6144] = nw;
    }
    __syncthreads();
    if (wid < 3) {
        const float q0 = qs[lane], q1 = qs[lane + 64], k0 = ks[lane], k1 = ks[lane + 64];
        const float v = (wid == 0) ? (q0 * q0 + q1 * q1) : (wid == 1) ? (k0 * k0 + k1 * k1) : (q0 * k0 + q1 * k1);
        const float s = wave_sum(v); if (lane == 0) sc[wid] = s;
    }
    __syncthreads();
    const float rq = __builtin_amdgcn_rsqf(sc[0] + 1e-6f) * 0.08838834764831845f, rk = __builtin_amdgcn_rsqf(sc[1] + 1e-6f), qk = sc[2] * rq * rk;
    const float g = -__expf(A.in[10][h]) * softplus_f(BAd[8 + h] + A.in[11][h]), eg = __expf(g), beta = sigmoid_f(BAd[h]);
    const int v = tid & 127, kg = tid >> 7;
    const float* Sin = A.in[3] + ((size_t)(b * 8 + h) * 128 + kg * 32) * 128 + v;
    float S[32]; float pk = 0.f, pq = 0.f;
#pragma unroll
    for (int k = 0; k < 32; ++k) S[k] = __builtin_nontemporal_load(Sin + k * 128);
#pragma unroll
    for (int k = 0; k < 32; ++k) { pk += ks[kg * 32 + k] * S[k]; pq += qs[kg * 32 + k] * S[k]; }
    part[kg * 128 + v] = pk * rk; part[512 + kg * 128 + v] = pq * rq;
    __syncthreads();
    const float kS = (part[v] + part[128 + v]) + (part[256 + v] + part[384 + v]);
    const float qS = (part[512 + v] + part[640 + v]) + (part[768 + v] + part[896 + v]);
    const float vnew = beta * (vs[v] - eg * kS);
    const float o = eg * qS + qk * vnew;
    float* Sout = A.out + O_GSS + ((size_t)(b * 8 + h) * 128 + kg * 32) * 128 + v;
#pragma unroll
    for (int k = 0; k < 32; ++k) __builtin_nontemporal_store(eg * S[k] + (ks[kg * 32 + k] * rk) * vnew, Sout + k * 128);
    if (kg == 0) os[v] = o;
    __syncthreads();
    if (wid == 0) {
        const float o0 = os[lane], o1 = os[lane + 64];
        const float rstd = __builtin_amdgcn_rsqf(wave_sum(o0 * o0 + o1 * o1) * (1.f / 128.f) + RMS_EPS);
        const float z0 = bf2f(Pd[3072 + h * 128 + lane]), z1 = bf2f(Pd[3072 + h * 128 + lane + 64]);
        const float r0 = o0 * rstd * A.in[12][lane] * silu_f(z0), r1 = o1 * rstd * A.in[12][lane + 64] * silu_f(z1);
        YBd[h * 128 + lane] = (bf16_t)(pack2(r0, 0.f) & 0xffffu); YBd[h * 128 + lane + 64] = (bf16_t)(pack2(r1, 0.f) & 0xffffu);
    }
    __syncthreads();
}

constexpr int GS_SB0 = 0, GS_SB1 = 8704, GS_VN = 17408;
__device__ __forceinline__ void gdn_scan_item(LAS unsigned char* lds, const Args& A, int item, int tid_in) {
    const int tid = tid_in, wid = tid >> 6, lane = tid & 63, fr = lane & 15, fq = lane >> 4;
    const int xcd = item & 7, slot = item >> 3, pair = xcd * 8 + (slot >> 2);
    const int vs = slot & 3, h = pair & 7, b = pair >> 3;
    const int ti = wid >> 1, tv = wid & 1;
    const bf16_t* UTb = (const bf16_t*)(A.ws + WS_UT); const bf16_t* WNb = (const bf16_t*)(A.ws + WS_WN);
    const bf16_t* QDb = (const bf16_t*)(A.ws + WS_QD); const bf16_t* KDTb = (const bf16_t*)(A.ws + WS_KDT);
    const bf16_t* QKb = (const bf16_t*)(A.ws + WS_QK); const float* EGL = (const float*)(A.ws + WS_EGL);
    float* O = (float*)(A.ws + WS_O);
    for (int e = tid; e < 8704 / 4; e += 512) ((LAS unsigned*)(lds + GS_SB0))[e] = 0u;
    f32x4 sacc[2]; sacc[0] = (f32x4){0.f, 0.f, 0.f, 0.f}; sacc[1] = sacc[0];
    __syncthreads();
    const int chunk0 = (b * 8 + h) * 32;
    bf16x8 nfw0[4], nfqd0[4], nfqk0[2], nfkd0[2]; u32x2 nuu0; float ndecay0;
    bf16x8 nfw1[4], nfqd1[4], nfqk1[2], nfkd1[2]; u32x2 nuu1; float ndecay1;
#define GS_LOAD(S, ch) { const size_t _c = (size_t)(ch); \
        _Pragma("unroll") for (int kk = 0; kk < 4; ++kk) { nfw##S[kk] = *(const bf16x8*)(WNb + _c * 8192 + (ti * 16 + fr) * 128 + kk * 32 + fq * 8); nfqd##S[kk] = *(const bf16x8*)(QDb + _c * 8192 + (ti * 16 + fr) * 128 + kk * 32 + fq * 8); } \
        _Pragma("unroll") for (int kk = 0; kk < 2; ++kk) { nfqk##S[kk] = *(const bf16x8*)(QKb + _c * 4096 + (ti * 16 + fr) * 64 + kk * 32 + fq * 8); nfkd##S[kk] = *(const bf16x8*)(KDTb + _c * 8192 + (wid * 16 + fr) * 64 + kk * 32 + fq * 8); } \
        nuu##S = *(const u32x2*)(UTb + _c * 8192 + (vs * 32 + tv * 16 + fr) * 64 + ti * 16 + fq * 4); ndecay##S = EGL[_c]; }
#define GS_STEP(S, nn, SBC, SBN, DOLOAD) { \
        bf16x8 fw[4], fqd[4], fqk[2], fkd[2]; \
        _Pragma("unroll") for (int kk = 0; kk < 4; ++kk) { fw[kk] = nfw##S[kk]; fqd[kk] = nfqd##S[kk]; } \
        _Pragma("unroll") for (int kk = 0; kk < 2; ++kk) { fqk[kk] = nfqk##S[kk]; fkd[kk] = nfkd##S[kk]; } \
        const u32x2 uu = nuu##S; const float decay = ndecay##S; \
        if (DOLOAD) { GS_LOAD(S, chunk0 + (nn) + 2) } \
        f32x4 acc = (f32x4){lo_f(uu.x), hi_f(uu.x), lo_f(uu.y), hi_f(uu.y)}; \
        bf16x8 fs[4]; \
        _Pragma("unroll") for (int kk = 0; kk < 4; ++kk) { fs[kk] = *(const LAS bf16x8*)(lds + (SBC) + ((tv * 16 + fr) * 136 + kk * 32 + fq * 8) * 2); acc = mfma16(fw[kk], fs[kk], acc); } \
        *(LAS u32x2*)(lds + GS_VN + ((tv * 16 + fr) * 72 + ti * 16 + fq * 4) * 2) = pack4(acc); \
        lds_barrier(); \
        f32x4 ao = (f32x4){0.f, 0.f, 0.f, 0.f}; \
        _Pragma("unroll") for (int kk = 0; kk < 4; ++kk) ao = mfma16(fs[kk], fqd[kk], ao); \
        bf16x8 fv[2][2]; \
        _Pragma("unroll") for (int t2 = 0; t2 < 2; ++t2) _Pragma("unroll") for (int kk = 0; kk < 2; ++kk) fv[t2][kk] = *(const LAS bf16x8*)(lds + GS_VN + ((t2 * 16 + fr) * 72 + kk * 32 + fq * 8) * 2); \
        _Pragma("unroll") for (int kk = 0; kk < 2; ++kk) { const bf16x8 fvo = *(const LAS bf16x8*)(lds + GS_VN + ((tv * 16 + fr) * 72 + kk * 32 + fq * 8) * 2); ao = mfma16(fvo, fqk[kk], ao); } \
        *(f32x4*)(O + ((size_t)b * SL + (nn) * 64 + ti * 16 + fr) * 1024 + h * 128 + vs * 32 + tv * 16 + fq * 4) = ao; \
        _Pragma("unroll") for (int t2 = 0; t2 < 2; ++t2) { sacc[t2] = sacc[t2] * decay; \
            _Pragma("unroll") for (int kk = 0; kk < 2; ++kk) sacc[t2] = mfma16(fkd[kk], fv[t2][kk], sacc[t2]); \
            *(LAS u32x2*)(lds + (SBN) + ((t2 * 16 + fr) * 136 + wid * 16 + fq * 4) * 2) = pack4(sacc[t2]); } \
        lds_barrier(); }
    GS_LOAD(0, chunk0) GS_LOAD(1, chunk0 + 1)
    for (int n = 0; n < 32; n += 8) {
        __builtin_amdgcn_s_waitcnt(0x0F70);
        GS_STEP(0, n, GS_SB0, GS_SB1, 1) GS_STEP(1, n + 1, GS_SB1, GS_SB0, 1) GS_STEP(0, n + 2, GS_SB0, GS_SB1, 1) GS_STEP(1, n + 3, GS_SB1, GS_SB0, 1)
        GS_STEP(0, n + 4, GS_SB0, GS_SB1, 1) GS_STEP(1, n + 5, GS_SB1, GS_SB0, 1) GS_STEP(0, n + 6, GS_SB0, GS_SB1, (n + 8 < 32)) GS_STEP(1, n + 7, GS_SB1, GS_SB0, (n + 9 < 32))
    }
#undef GS_STEP
#undef GS_LOAD
    float* So = A.out + O_GSP + (size_t)(b * 8 + h) * 16384;
#pragma unroll
    for (int t2 = 0; t2 < 2; ++t2)
#pragma unroll
        for (int r = 0; r < 4; ++r) So[(wid * 16 + fq * 4 + r) * 128 + vs * 32 + t2 * 16 + fr] = sacc[t2][r];
    __syncthreads();
}

__device__ __forceinline__ void gdn_gate_row(const Args& A, size_t row, int lane) {
    const float* O = (const float*)(A.ws + WS_O) + row * 1024 + lane * 16;
    const bf16_t* Z = (const bf16_t*)(A.ws + WS_PROJ) + row * 4096 + 3072 + lane * 16;
    bf16_t* Y = (bf16_t*)(A.ws + WS_YB) + row * 1024 + lane * 16;
    const float* nw = A.in[12] + (lane & 7) * 16;
    float o[16]; float ss = 0.f;
#pragma unroll
    for (int i = 0; i < 4; ++i) { const f32x4 v = ((const f32x4*)O)[i]; o[4 * i] = v[0]; o[4 * i + 1] = v[1]; o[4 * i + 2] = v[2]; o[4 * i + 3] = v[3]; ss += (v[0] * v[0] + v[1] * v[1]) + (v[2] * v[2] + v[3] * v[3]); }
    ss += __shfl_xor(ss, 1); ss += __shfl_xor(ss, 2); ss += __shfl_xor(ss, 4);
    const float rstd = __builtin_amdgcn_rsqf(ss * (1.f / 128.f) + RMS_EPS);
    float z[16]; { float t[8]; unpack8(((const u32x4*)Z)[0], t);
#pragma unroll
        for (int j = 0; j < 8; ++j) z[j] = t[j];
        unpack8(((const u32x4*)Z)[1], t);
#pragma unroll
        for (int j = 0; j < 8; ++j) z[8 + j] = t[j]; }
    float r[8];
#pragma unroll
    for (int hh = 0; hh < 2; ++hh) {
#pragma unroll
        for (int j = 0; j < 8; ++j) r[j] = o[hh * 8 + j] * rstd * nw[hh * 8 + j] * silu_f(z[hh * 8 + j]);
        ((u32x4*)Y)[hh] = pack8(r);
    }
}
__device__ __forceinline__ void gdn_gate_row2(const Args& A, size_t row, int lane) {
    const float* O = (const float*)(A.ws + WS_O) + row * 1024 + lane * 16;
    const bf16_t* Z = (const bf16_t*)(A.ws + WS_PROJ) + row * 4096 + 3072 + lane * 16;
    bf16_t* Y = (bf16_t*)(A.ws + WS_YB) + row * 1024 + lane * 16;
    const float* nw = A.in[12] + (lane & 7) * 16;
    f32x4 ov[2][4]; u32x4 zv[2][2];
#pragma unroll
    for (int rr = 0; rr < 2; ++rr) {
#pragma unroll
        for (int i = 0; i < 4; ++i) ov[rr][i] = ((const f32x4*)(O + rr * 1024))[i];
        zv[rr][0] = ((const u32x4*)(Z + rr * 4096))[0]; zv[rr][1] = ((const u32x4*)(Z + rr * 4096))[1];
    }
#pragma unroll
    for (int rr = 0; rr < 2; ++rr) {
        float ss = 0.f;
#pragma unroll
        for (int i = 0; i < 4; ++i) ss += (ov[rr][i][0] * ov[rr][i][0] + ov[rr][i][1] * ov[rr][i][1]) + (ov[rr][i][2] * ov[rr][i][2] + ov[rr][i][3] * ov[rr][i][3]);
        ss += __shfl_xor(ss, 1); ss += __shfl_xor(ss, 2); ss += __shfl_xor(ss, 4);
        const float rstd = __builtin_amdgcn_rsqf(ss * (1.f / 128.f) + RMS_EPS);
#pragma unroll
        for (int hh = 0; hh < 2; ++hh) { float z[8], r[8]; unpack8(zv[rr][hh], z);
#pragma unroll
            for (int j = 0; j < 8; ++j) r[j] = ov[rr][hh * 2 + (j >> 2)][j & 3] * rstd * nw[hh * 8 + j] * silu_f(z[j]);
            ((u32x4*)(Y + rr * 1024))[hh] = pack8(r); }
    }
}

__device__ __forceinline__ void ssd_conv_item(const Args& A, int item, int tid_in) {
    const int t = tid_in; if (t >= 384) return;
    const int c0 = t * 8, r0 = item * 16, tb = r0 & (SL - 1), b = r0 >> 11;
    const bf16_t* P = (const bf16_t*)(A.ws + WS_PROJ);
    bf16_t* XA = (bf16_t*)(A.ws + WS_XA); bf16_t* BCA = (bf16_t*)(A.ws + WS_BCA);
    u32x4 xq[19];
#pragma unroll
    for (int r = 0; r < 19; ++r) xq[r] = (tb == 0 && r < 3) ? (u32x4){0u, 0u, 0u, 0u} : *(const u32x4*)(P + (size_t)(r0 + r - 3) * 5120 + 2048 + c0);
    float w[4][8], bb[8];
#pragma unroll
    for (int j = 0; j < 8; ++j) { bb[j] = A.in[16][c0 + j];
#pragma unroll
        for (int k = 0; k < 4; ++k) w[k][j] = A.in[15][k * 3072 + c0 + j]; }
    float p3[8], p2[8], p1[8];
    unpack8(xq[0], p3); unpack8(xq[1], p2); unpack8(xq[2], p1);
#pragma unroll
    for (int r = 0; r < 16; ++r) {
        const size_t row = (size_t)(r0 + r);
        float cur[8], o[8];
        unpack8(xq[r + 3], cur);
#pragma unroll
        for (int j = 0; j < 8; ++j) o[j] = silu_f(bb[j] + w[0][j] * p3[j] + w[1][j] * p2[j] + w[2][j] * p1[j] + w[3][j] * cur[j]);
        if (c0 < 2048) *(u32x4*)(XA + row * 2048 + c0) = pack8(o); else *(u32x4*)(BCA + row * 1024 + (c0 - 2048)) = pack8(o);
        const int tt = tb + r;
        if (tt >= SL - 3) { float* cp = A.out + O_SCP + ((size_t)b * 3 + (tt - (SL - 3))) * 3072 + c0;
#pragma unroll
            for (int j = 0; j < 8; ++j) cp[j] = cur[j]; }
#pragma unroll
        for (int j = 0; j < 8; ++j) { p3[j] = p2[j]; p2[j] = p1[j]; p1[j] = cur[j]; }
    }
}

__device__ __forceinline__ void ssd_dec_item(LAS unsigned char* lds, const Args& A, int item, int tid_in) {
    const int tid = tid_in, wid = tid >> 6, lane = tid & 63;
    const int g = item & 3, b = item >> 2;
    const bf16_t* Pd = (const bf16_t*)(A.ws + WS_PROJD) + (size_t)b * NUP; const float* BAd = (const float*)(A.ws + WS_BAD) + b * 32;
    bf16_t* YBd = (bf16_t*)(A.ws + WS_YBD) + (size_t)b * DFF;
    LAS float* xs = (LAS float*)lds; LAS float* Bs = xs + 512; LAS float* Cs = xs + 640; LAS float* ys = xs + 768; LAS float* dts = xs + 1280; LAS float* dAs = xs + 1288; LAS float* red = xs + 1296;
    for (int c = tid; c < 768; c += 512) {
        const int xc = (c < 512) ? (g * 512 + c) : (c < 640) ? (2048 + g * 128 + (c - 512)) : (2560 + g * 128 + (c - 640));
        const float* cin = A.in[(4)] + (size_t)b * 3 * 3072 + xc;
        const float c0 = cin[0], c1 = cin[3072], c2 = cin[6144], nw = bf2f(Pd[2048 + xc]);
        const float* cw = A.in[(15)] + xc;
        xs[c] = silu_f(A.in[(16)][xc] + cw[0] * c0 + cw[3072] * c1 + cw[6144] * c2 + cw[9216] * nw);
        float* co = A.out + O_SCS + (size_t)b * 3 * 3072 + xc; co[0] = c1; co[3072] = c2; co[6144] = nw;
    }
    if (tid < 8) { const int h = g * 8 + tid; const float dt = softplus_f(BAd[h] + A.in[(18)][h]); dts[tid] = dt; dAs[tid] = __expf(-__expf(A.in[(17)][h]) * dt); }
    __syncthreads();
    const int sl = tid & 31, pr = tid >> 5;
    const f32x4 B4 = *(const LAS f32x4*)(Bs + sl * 4), C4 = *(const LAS f32x4*)(Cs + sl * 4);
    const float* Sin0 = A.in[(5)] + ((size_t)(b * 32 + g * 8) * 64) * 128 + sl * 4;
    float* Sout0 = A.out + O_SSS + ((size_t)(b * 32 + g * 8) * 64) * 128 + sl * 4;
    f32x4 Snx[4];
#pragma unroll
    for (int it = 0; it < 4; ++it) Snx[it] = __builtin_nontemporal_load((const f32x4*)(Sin0 + (it * 16 + pr) * 128));
#pragma unroll
    for (int j = 0; j < 8; ++j) {
        const float dt = dts[j], dA = dAs[j];
        f32x4 S[4];
#pragma unroll
        for (int it = 0; it < 4; ++it) S[it] = Snx[it];
        if (j + 1 < 8) {
#pragma unroll
            for (int it = 0; it < 4; ++it) Snx[it] = __builtin_nontemporal_load((const f32x4*)(Sin0 + (size_t)(j + 1) * 8192 + (it * 16 + pr) * 128));
        }
#pragma unroll
        for (int it = 0; it < 4; ++it) { const int p = it * 16 + pr; const float xd = xs[j * 64 + p] * dt;
            const f32x4 Sn = S[it] * dA + B4 * xd; __builtin_nontemporal_store(Sn, (f32x4*)(Sout0 + (size_t)j * 8192 + p * 128));
            float y = (Sn[0] * C4[0] + Sn[1] * C4[1]) + (Sn[2] * C4[2] + Sn[3] * C4[3]);
            y += DPP_F(y, 0xB1, 0xf); y += DPP_F(y, 0x4E, 0xf); y += DPP_F(y, 0x141, 0xf); y += DPP_F(y, 0x140, 0xf); y += DPP_F(y, 0x142, 0xa);
            if (sl == 31) ys[j * 64 + p] = y; }
    }
    __syncthreads();
    {
        const int c = tid, h = g * 8 + (c >> 6);
        const float y = (ys[c] + A.in[(19)][h] * xs[c]) * silu_f(bf2f(Pd[g * 512 + c]));
        const float s = wave_sum(y * y); if (lane == 0) red[wid] = s;
        __syncthreads();
        float tot = 0.f;
#pragma unroll
        for (int w = 0; w < 8; ++w) tot += red[w];
        const float r = y * __builtin_amdgcn_rsqf(tot * (1.f / 512.f) + RMS_EPS) * A.in[(20)][g * 512 + c];
        YBd[g * 512 + c] = (bf16_t)(pack2(r, 0.f) & 0xffffu);
    }
    __syncthreads();
}

constexpr int SS_XT = 0, SS_XDT = 9216, SS_BT = 18432, SS_SC = 36864, SS_SB0 = 46080, SS_SB1 = 63488, SS_BS = 80896, SS_CS = 98304, SS_AC = 115712, SS_DT = 115968;
__device__ __forceinline__ void ssd_step(LAS unsigned char* lds, bf16_t* __restrict__ Y, const size_t t0, const int h, const int sbc, const int sbn,
                                         const u32x4 px, const u32x4 pb0, const u32x4 pb1, const u32x4 pc0, const u32x4 pc1, const float pdt,
                                         const float aneg, const float dtb, const float Dh, f32x4 (&sacc)[4], const int tid) {
    const int wid = tid >> 6, lane = tid & 63, fr = lane & 15, fq = lane >> 4, ti = wid >> 1;
    const int jx = tid >> 3, xm = tid & 7, jb0 = tid >> 4, jb1 = 32 + (tid >> 4), bm = tid & 15;
    LAS float* acum = (LAS float*)(lds + SS_AC); LAS float* dtv = (LAS float*)(lds + SS_DT);
        if (wid == 0) { const float dt = softplus_f(pdt + dtb); const float ac = wave_incl_scan(dt * aneg, lane); acum[lane] = ac; dtv[lane] = dt; }
        *(LAS u32x4*)(lds + SS_BS + (jb0 * 136 + bm * 8) * 2) = pb0; *(LAS u32x4*)(lds + SS_BS + (jb1 * 136 + bm * 8) * 2) = pb1;
        *(LAS u32x4*)(lds + SS_CS + (jb0 * 136 + bm * 8) * 2) = pc0; *(LAS u32x4*)(lds + SS_CS + (jb1 * 136 + bm * 8) * 2) = pc1;
        lds_barrier();
        const float alast = acum[63];
        {
            const float sx = dtv[jx] * __expf(alast - acum[jx]);
            const int colx = (((jx >> 3) ^ xm) * 8 + (jx & 7)) * 2;
            const unsigned wx[4] = {px.x, px.y, px.z, px.w};
#pragma unroll
            for (int q = 0; q < 8; ++q) { const unsigned w = wx[q >> 1]; const unsigned short raw = (q & 1) ? (unsigned short)(w >> 16) : (unsigned short)(w & 0xffffu);
                const float xv = bf2f(raw); const int rowb = (xm * 8 + q) * 144;
                *(LAS unsigned short*)(lds + SS_XT + rowb + colx) = raw;
                *(LAS unsigned short*)(lds + SS_XDT + rowb + colx) = (unsigned short)(pack2(xv * sx, 0.f) & 0xffffu); }
            const int colb0 = (((jb0 >> 3) ^ (bm & 7)) * 8 + (jb0 & 7)) * 2, colb1 = (((jb1 >> 3) ^ (bm & 7)) * 8 + (jb1 & 7)) * 2;
            const unsigned wb0[4] = {pb0.x, pb0.y, pb0.z, pb0.w}, wb1[4] = {pb1.x, pb1.y, pb1.z, pb1.w};
#pragma unroll
            for (int q = 0; q < 8; ++q) { const int rowb = (bm * 8 + q) * 144;
                *(LAS unsigned short*)(lds + SS_BT + rowb + colb0) = (q & 1) ? (unsigned short)(wb0[q >> 1] >> 16) : (unsigned short)(wb0[q >> 1] & 0xffffu);
                *(LAS unsigned short*)(lds + SS_BT + rowb + colb1) = (q & 1) ? (unsigned short)(wb1[q >> 1] >> 16) : (unsigned short)(wb1[q >> 1] & 0xffffu); }
        }
        bf16x8 fc[4];
#pragma unroll
        for (int kk = 0; kk < 4; ++kk) fc[kk] = *(const LAS bf16x8*)(lds + SS_CS + ((ti * 16 + fr) * 136 + kk * 32 + fq * 8) * 2);
#pragma unroll
        for (int tjj = 0; tjj < 2; ++tjj) {
            const int tj = (wid & 1) * 2 + tjj;
            f32x4 acc = (f32x4){0.f, 0.f, 0.f, 0.f};
            if (tj <= ti) {
#pragma unroll
                for (int kk = 0; kk < 4; ++kk) { const bf16x8 fb = *(const LAS bf16x8*)(lds + SS_BS + ((tj * 16 + fr) * 136 + kk * 32 + fq * 8) * 2); acc = mfma16(fb, fc[kk], acc); }
            }
            const int i = ti * 16 + fr; const float ai = acum[i]; f32x4 sc;
#pragma unroll
            for (int r = 0; r < 4; ++r) { const int j = tj * 16 + fq * 4 + r; sc[r] = (i >= j) ? acc[r] * __expf(ai - acum[j]) * dtv[j] : 0.f; }
            *(LAS u32x2*)(lds + SS_SC + (i * 72 + tj * 16 + fq * 4) * 2) = pack4(sc);
        }
        lds_barrier();
        {
            bf16x8 fsc[2];
#pragma unroll
            for (int kk = 0; kk < 2; ++kk) fsc[kk] = *(const LAS bf16x8*)(lds + SS_SC + ((ti * 16 + fr) * 72 + kk * 32 + fq * 8) * 2);
            const int i = ti * 16 + fr; const float ea = __expf(acum[i]);
#pragma unroll
            for (int tpp = 0; tpp < 2; ++tpp) {
                const int tp = (wid & 1) * 2 + tpp, prow = tp * 16 + fr, psw = (prow >> 3) & 7;
                f32x4 a1 = (f32x4){0.f, 0.f, 0.f, 0.f}, a2 = (f32x4){0.f, 0.f, 0.f, 0.f};
#pragma unroll
                for (int kk = 0; kk < 2; ++kk) { const bf16x8 fx = *(const LAS bf16x8*)(lds + SS_XT + (prow * 72 + (((kk * 4 + fq) ^ psw) * 8)) * 2); a1 = mfma16(fx, fsc[kk], a1); }
#pragma unroll
                for (int kk = 0; kk < 4; ++kk) { const bf16x8 fs = *(const LAS bf16x8*)(lds + sbc + (prow * 136 + kk * 32 + fq * 8) * 2); a2 = mfma16(fs, fc[kk], a2); }
                const int p0 = tp * 16 + fq * 4;
                const int xcol = (((i >> 3) ^ ((p0 >> 3) & 7)) * 8 + (i & 7)) * 2;
                f32x4 y = a1 + a2 * ea;
#pragma unroll
                for (int r = 0; r < 4; ++r) y[r] += Dh * bf2f(*(const LAS unsigned short*)(lds + SS_XT + (p0 + r) * 144 + xcol));
                *(u32x2*)(Y + (t0 + i) * 2048 + h * 64 + p0) = pack4(y);
            }
        }
        {
            const int tp = wid >> 1, prow = tp * 16 + fr, psw = (prow >> 3) & 7; const float el = __expf(alast);
            bf16x8 fxd[2];
#pragma unroll
            for (int kk = 0; kk < 2; ++kk) fxd[kk] = *(const LAS bf16x8*)(lds + SS_XDT + (prow * 72 + (((kk * 4 + fq) ^ psw) * 8)) * 2);
#pragma unroll
            for (int q = 0; q < 4; ++q) { const int ts = (wid & 1) * 4 + q, srow = ts * 16 + fr, ssw = (srow >> 3) & 7; sacc[q] = sacc[q] * el;
#pragma unroll
                for (int kk = 0; kk < 2; ++kk) { const bf16x8 fb = *(const LAS bf16x8*)(lds + SS_BT + (srow * 72 + (((kk * 4 + fq) ^ ssw) * 8)) * 2); sacc[q] = mfma16(fb, fxd[kk], sacc[q]); }
                *(LAS u32x2*)(lds + sbn + (prow * 136 + ts * 16 + fq * 4) * 2) = pack4(sacc[q]); }
        }
        lds_barrier();
}

__device__ __forceinline__ void ssd_scan_item(LAS unsigned char* lds, const Args& A, int item, int tid_in) {
    const int tid = tid_in, wid = tid >> 6, lane = tid & 63, fr = lane & 15, fq = lane >> 4;
    const int xcd = item & 7, slot = item >> 3, grp = xcd * 4 + (slot >> 3);
    const int b = grp >> 2, g = grp & 3, h = g * 8 + (slot & 7);
    const bf16_t* XA = (const bf16_t*)(A.ws + WS_XA); const bf16_t* BCA = (const bf16_t*)(A.ws + WS_BCA); const float* BA = (const float*)(A.ws + WS_BA);
    bf16_t* Y = (bf16_t*)(A.ws + WS_YB);
    LAS float* acum = (LAS float*)(lds + SS_AC); LAS float* dtv = (LAS float*)(lds + SS_DT);
    const float aneg = -__expf(A.in[17][h]), dtb = A.in[18][h], Dh = A.in[19][h];
    for (int e = tid; e < 17408 / 4; e += 512) ((LAS unsigned*)(lds + SS_SB0))[e] = 0u;
    f32x4 sacc[4];
#pragma unroll
    for (int q = 0; q < 4; ++q) sacc[q] = (f32x4){0.f, 0.f, 0.f, 0.f};
    int cur = 0;
    const int ti = wid >> 1;
    const int jx = tid >> 3, xm = tid & 7;
    const int jb0 = tid >> 4, jb1 = 32 + (tid >> 4), bm = tid & 15;
    u32x4 npx0, npb00, npb10, npc00, npc10; float npdt0 = 0.f;
    u32x4 npx1, npb01, npb11, npc01, npc11; float npdt1 = 0.f;
#define SS_LOAD(S, nn) { const size_t _t0 = (size_t)b * SL + (nn) * 64; \
        npx##S = *(const u32x4*)(XA + (_t0 + jx) * 2048 + h * 64 + xm * 8); \
        npb0##S = *(const u32x4*)(BCA + (_t0 + jb0) * 1024 + g * 128 + bm * 8); npb1##S = *(const u32x4*)(BCA + (_t0 + jb1) * 1024 + g * 128 + bm * 8); \
        npc0##S = *(const u32x4*)(BCA + (_t0 + jb0) * 1024 + 512 + g * 128 + bm * 8); npc1##S = *(const u32x4*)(BCA + (_t0 + jb1) * 1024 + 512 + g * 128 + bm * 8); \
        if (wid == 0) npdt##S = BA[(_t0 + lane) * 32 + h]; }
#define SS_STEP(S, nn, DOLOAD) { \
        const size_t t0 = (size_t)b * SL + (nn) * 64; \
        const int sbc = cur ? SS_SB1 : SS_SB0, sbn = cur ? SS_SB0 : SS_SB1; \
        const u32x4 px = npx##S, pb0 = npb0##S, pb1 = npb1##S, pc0 = npc0##S, pc1 = npc1##S; const float pdt = npdt##S; \
        if (DOLOAD) { SS_LOAD(S, (nn) + 2) } \
        ssd_step(lds, Y, t0, h, sbc, sbn, px, pb0, pb1, pc0, pc1, pdt, aneg, dtb, Dh, sacc, tid); \
        cur ^= 1; }
    SS_LOAD(0, 0) SS_LOAD(1, 1)
    __syncthreads();
    for (int n = 0; n < 28; n += 4) {
        __builtin_amdgcn_s_waitcnt(0x0F70);
        SS_STEP(0, n, 1) SS_STEP(1, n + 1, 1) SS_STEP(0, n + 2, 1) SS_STEP(1, n + 3, 1)
    }
    __builtin_amdgcn_s_waitcnt(0x0F70);
    SS_STEP(0, 28, 1) SS_STEP(1, 29, 1) SS_STEP(0, 30, 0) SS_STEP(1, 31, 0)
#undef SS_STEP
#undef SS_LOAD
    {
        const int tp = wid >> 1; float* So = A.out + O_SSP + (size_t)(b * 32 + h) * 8192;
#pragma unroll
        for (int q = 0; q < 4; ++q) { const int ts = (wid & 1) * 4 + q; *(f32x4*)(So + (tp * 16 + fr) * 128 + ts * 16 + fq * 4) = sacc[q]; }
    }
    __syncthreads();
}

__device__ __forceinline__ void ssd_gate_row(const Args& A, size_t row, int lane) {
    bf16_t* Y = (bf16_t*)(A.ws + WS_YB) + row * 2048; const bf16_t* Z = (const bf16_t*)(A.ws + WS_PROJ) + row * 5120;
    u32x4 yq[4], zq[4];
#pragma unroll
    for (int g = 0; g < 4; ++g) { yq[g] = *(const u32x4*)(Y + g * 512 + lane * 8); zq[g] = *(const u32x4*)(Z + g * 512 + lane * 8); }
#pragma unroll
    for (int g = 0; g < 4; ++g) {
        const int c0 = g * 512 + lane * 8; float y[8], z[8];
        unpack8(yq[g], y); unpack8(zq[g], z);
        float ss = 0.f;
#pragma unroll
        for (int j = 0; j < 8; ++j) { y[j] *= silu_f(z[j]); ss += y[j] * y[j]; }
        const float rstd = __builtin_amdgcn_rsqf(wave_sum(ss) * (1.f / 512.f) + RMS_EPS);
        const float* nw = A.in[20] + c0;
#pragma unroll
        for (int j = 0; j < 8; ++j) y[j] = y[j] * rstd * nw[j];
        *(u32x4*)(Y + c0) = pack8(y);
    }
}


__constant__ int P0_BASE[8] = {0, 544, 672, 1344, 1600, 2304, 3008, 3360};
__constant__ int P0_IN[8] = {7, 13, 14, 21, 22, 22, 25, 25};
__constant__ unsigned P0_INOFF[8] = {0, 0, 0, 0, 0, 1024u * 5632u, 0, 2816u * 1024u};
__constant__ unsigned P0_WOFS[8] = {(unsigned)WS_WGI, (unsigned)WS_WGO, (unsigned)WS_WSI, (unsigned)WS_WSO, (unsigned)WS_WUP0, (unsigned)WS_WUP1, (unsigned)WS_WDN0, (unsigned)WS_WDN1};
__constant__ int P0_K[8] = {1024, 1024, 1024, 2048, 1024, 1024, 2816, 2816};
__constant__ int P0_N[8] = {4112, 1024, 5152, 1024, 5632, 5632, 1024, 1024};

#define XB_TMO      128
#define XB_XCNT(j)  (256  + 64 * (j))
#define XB_XSUB(j)  (1280 + 64 * (j))
#define XB_XGEN(j)  (2304 + 64 * (j))
#define XB_TOP      3328
#define XB_TOPGEN   3392
#define XCD_BAR_WORDS 3456
#define XB_SPIN_CAP (1u << 18)
__device__ __forceinline__ unsigned xb_ld(unsigned* p)              { return __hip_atomic_load(p, __ATOMIC_RELAXED, __HIP_MEMORY_SCOPE_AGENT); }
__device__ __forceinline__ unsigned xb_add(unsigned* p, unsigned v) { return __hip_atomic_fetch_add(p, v, __ATOMIC_RELAXED, __HIP_MEMORY_SCOPE_AGENT); }
__device__ __forceinline__ unsigned xb_xcc_id() { return (unsigned)__builtin_amdgcn_s_getreg((3 << 11) | 20) & 0xFu; }
#define XB_SPIN(cond, bar) do { unsigned _sp = 0; while (cond) { __builtin_amdgcn_s_sleep(1); \
    if ((++_sp & 255u) == 0u) { if (xb_ld(&(bar)[XB_TMO])) break; if (_sp > XB_SPIN_CAP) { atomicAdd(&(bar)[XB_TMO], 1u); break; } } } } while (0)
struct XcdBarrier { unsigned* bar; unsigned x; volatile LAS unsigned* st; };
__device__ __forceinline__ XcdBarrier xcd_barrier_post(unsigned* bar, volatile LAS unsigned* st) {
    XcdBarrier b; b.bar = bar; b.x = xb_xcc_id(); b.st = st;
    if (threadIdx.x == 0) (void)xb_add(&bar[XB_XCNT(b.x)], 1u);
    return b;
}
__device__ __forceinline__ void xcd_barrier_complete(unsigned* bar, unsigned x, unsigned& nloc, unsigned& nx) {
    const unsigned G = gridDim.x * gridDim.y * gridDim.z;
    unsigned sum, cnt, mine, sp = 0u;
    for (;;) {
        sum = 0u; cnt = 0u; mine = 0u;
#pragma unroll
        for (unsigned j = 0; j < 16; ++j) { const unsigned c = xb_ld(&bar[XB_XCNT(j)]); sum += c; cnt += (c > 0u) ? 1u : 0u; mine = (j == x) ? c : mine; }
        if (sum == G) break;
        __builtin_amdgcn_s_sleep(1);
        if ((++sp & 255u) == 0u) { if (xb_ld(&bar[XB_TMO])) break; if (sp > XB_SPIN_CAP) { atomicAdd(&bar[XB_TMO], 1u); break; } }
    }
    nloc = mine > 0u ? mine : 1u; nx = cnt > 0u ? cnt : 1u;
}
__device__ __forceinline__ void xcd_barrier(const XcdBarrier& b, int tid) {
    asm volatile("s_waitcnt vmcnt(0)" ::: "memory");
    __syncthreads();
    if (tid == 0) {
        unsigned* bar = b.bar;
        __builtin_amdgcn_s_waitcnt(0);
        unsigned nloc = b.st[0], nx = b.st[1];
        if (nloc == 0u) { xcd_barrier_complete(bar, b.x, nloc, nx); b.st[0] = nloc; b.st[1] = nx; }
        const unsigned old = xb_add(&bar[XB_XSUB(b.x)], 1u);
        const unsigned gen = old / nloc;
        if (old + 1u == (gen + 1u) * nloc) {
            __builtin_amdgcn_fence(__ATOMIC_RELEASE, "agent");
            asm volatile("s_waitcnt vmcnt(0)" ::: "memory");
            const unsigned og = xb_add(&bar[XB_TOP], 1u);
            const unsigned tg = og / nx;
            if (og + 1u == (tg + 1u) * nx) xb_add(&bar[XB_TOPGEN], 1u);
            else XB_SPIN(xb_ld(&bar[XB_TOPGEN]) == tg, bar);
            __builtin_amdgcn_fence(__ATOMIC_ACQUIRE, "agent");
            xb_add(&bar[XB_XGEN(b.x)], 1u);
            asm volatile("s_waitcnt vmcnt(0)" ::: "memory");
        } else {
            XB_SPIN(xb_ld(&bar[XB_XGEN(b.x)]) == gen, bar);
            __builtin_amdgcn_fence(__ATOMIC_ACQUIRE, "agent");
            asm volatile("s_waitcnt vmcnt(0)" ::: "memory");
        }
    }
    __syncthreads();
}

#ifndef PHMASK
#define PHMASK 0xffffff
#endif
#define EN(k) ((PHMASK >> (k)) & 1)
constexpr int NPHASE = 21;
__global__ void __launch_bounds__(512, 2) fwd_kernel(Args A) {
    __shared__ __attribute__((aligned(16))) unsigned char lds_raw[LDS_BYTES];
    LAS unsigned char* lds = (LAS unsigned char*)lds_raw;
    const int wave_s = __builtin_amdgcn_readfirstlane((int)threadIdx.x >> 6);
#define TID make_tid(wave_s)
    if (threadIdx.x < 4) ((LAS unsigned*)(lds + 131072))[threadIdx.x] = 0u;
    __syncthreads();
    (void)xcd_barrier_post((unsigned*)(A.ws + WS_BARR), (volatile LAS unsigned*)(lds + 131072));
    if (A.ph_hi > NPHASE) cg::this_grid().sync();
#ifndef REPMASK
#define REPMASK 0
#endif
    const int ph_end = __builtin_amdgcn_readfirstlane(A.ph_hi);
    int rep_done = 0;
    for (int ph = __builtin_amdgcn_readfirstlane(A.ph_lo); ph < ph_end; ) {
        {
        int G = gridDim.x, bid = blockIdx.x; asm volatile("" : "+s"(G), "+s"(bid));
        unsigned long long zoff = 0; asm volatile("" : "+s"(zoff));
        unsigned char* ws = A.ws + zoff;
        const bool is_gemm = (ph == 1) | (ph == 5) | (ph == 7) | (ph == 9) | (ph == 11) | (ph == 15) | (ph == 17) | (ph == 19);
        const bool is_ln = (ph == 6) | (ph == 10) | (ph == 16) | (ph == 20);
        if (EN(1) && is_gemm) {
            const bf16_t* Ap = (const bf16_t*)(ws + WS_XB); const bf16_t* Ad = (const bf16_t*)(ws + WS_XBD); int ldad = 1024;
            size_t wofs = WS_WGI, oofs = WS_PROJ, dofs = WS_PROJD; int N = 4096, K = 1024, ldo = 4096, nbf = 4096, nf = 16, ncg = 65, ldp = NUP;
            if (ph == 5) { Ap = (const bf16_t*)(ws + WS_YB); Ad = (const bf16_t*)(ws + WS_YBD); ldad = DFF; wofs = WS_WGO; N = 1024; K = 1024; }
            else if (ph == 7 || ph == 17) { wofs = (ph == 7) ? WS_WUP0 : WS_WUP1; N = NUP; K = 1024; ldo = NUP; nbf = NUP; nf = 0; ncg = 88; }
            else if (ph == 9 || ph == 19) { Ap = (const bf16_t*)(ws + WS_YB); Ad = (const bf16_t*)(ws + WS_YBD); ldad = DFF; wofs = (ph == 9) ? WS_WDN0 : WS_WDN1; N = 1024; K = DFF; }
            else if (ph == 11) { wofs = WS_WSI; N = 5120; K = 1024; ldo = 5120; nbf = 5120; nf = 32; ncg = 81; }
            else if (ph == 15) { Ap = (const bf16_t*)(ws + WS_YB); Ad = (const bf16_t*)(ws + WS_YBD); ldad = DFF; wofs = WS_WSO; N = 1024; K = 2048; }
            if (N == 1024) { oofs = WS_H; dofs = WS_HD; ldo = 1024; nbf = 1024; nf = 0; ncg = 16; ldp = 1024; }
            const bf16_t* Bt = (const bf16_t*)(ws + wofs);
            pg8::Gemm g{Ap, Bt, MP, N, K}; pg8::StaticOrder S; S.init(MP, N, G, bid);
            const bool gated = (ph == 7) | (ph == 17); const int lyr = (ph == 17);
            if (gated) oofs = WS_YB;
            pg8::EpiUni E{gated ? 2 : 1, (bf16_t*)(ws + oofs), ldo,
                          A.in[23] + (size_t)lyr * 3 * DFF, A.in[24] + (size_t)lyr * DFF, (float*)(ws + WS_XF), A.out + O_FCP + (size_t)lyr * 8 * 2 * DFF};
            pg8::gemm_phase(lds, g, S, E, TID);
            DecStore st{ldp, nbf, nf, (bf16_t*)(ws + dofs), (float*)(ws + WS_BAD)};
            {
                const int rxt = S.nwg % G, nfree = G - rxt;
                if (bid >= rxt) for (int it = bid - rxt; it < 8 * ncg; it += nfree) small_gemm_item(lds, Ad, ldad, Bt, K, it, st, TID);
            }
            if (ph == 1) { for (int it = bid; it < MP / 128; it += G) narrow_item<1>(Ap, Bt + (size_t)4096 * 1024, 1024, (float*)(ws + WS_BA), it, TID); }
            if (ph == 11) { for (int it = bid; it < MP / 128; it += G) narrow_item<2>(Ap, Bt + (size_t)5120 * 1024, 1024, (float*)(ws + WS_BA), it, TID); }
        } else if (EN(6) && is_ln) {
            const int tid = TID, wid = tid >> 6, lane = tid & 63; (void)tid;
            const int layer = (ph >= 16); const bool fin = (ph == 20), is2 = (ph == 10) | (ph == 20);
            const float* gam = A.in[is2 ? 28 : 26] + layer * 1024; const float* bet = A.in[is2 ? 29 : 27] + layer * 1024;
            bf16_t* XB = (bf16_t*)(ws + WS_XB); bf16_t* XBd = (bf16_t*)(ws + WS_XBD);
            const bf16_t* H = (const bf16_t*)(ws + WS_H); const bf16_t* Hd = (const bf16_t*)(ws + WS_HD);
            for (int it = bid; it < (MP + DB) / 16; it += G) { const int row = it * 16 + wid * 2;
                if (row < MP) { const size_t o0 = (size_t)row * 1024, o1 = o0 + 1024;
                    ln_row2(XB + o0, H + o0, XB + o1, H + o1, gam, bet, fin ? A.out + O_YP + o0 : (float*)nullptr, fin ? (bf16_t*)nullptr : XB + o0, fin ? A.out + O_YP + o1 : (float*)nullptr, fin ? (bf16_t*)nullptr : XB + o1, lane); }
                else { const size_t o0 = (size_t)(row - MP) * 1024, o1 = o0 + 1024;
                    ln_row2(XBd + o0, Hd + o0, XBd + o1, Hd + o1, gam, bet, fin ? A.out + O_YS + o0 : (float*)nullptr, fin ? (bf16_t*)nullptr : XBd + o0, fin ? A.out + O_YS + o1 : (float*)nullptr, fin ? (bf16_t*)nullptr : XBd + o1, lane); } }
        } else if (EN(0) && ph == 0) {
            const int tid = TID, wid = tid >> 6, lane = tid & 63; (void)tid; (void)wid; (void)lane;
#define P0_DESC(it) \
            int mi = 0; \
            _Pragma("unroll") for (int q = 1; q < 8; ++q) mi += ((it) >= P0_BASE[q]) ? 1 : 0; \
            const float* W = A.in[P0_IN[mi]] + P0_INOFF[mi]; bf16_t* Wt = (bf16_t*)(ws + P0_WOFS[mi]); const int K = P0_K[mi], N = P0_N[mi]; \
            const int idx = (it) - P0_BASE[mi], nk = K / 128, k0 = (idx % nk) * 128, n0 = (idx / nk) * 64; \
            const int ns0 = (mi == 4 || mi == 5) ? (((n0 >> 7) & 1) * DFF + (n0 >> 8) * 128 + (n0 & 127)) : n0;
            for (int it = bid; it < 1032; it += G) {
                if (it < 1024) convert_rows16(A.in[0] + (size_t)it * 16 * 1024, (bf16_t*)(ws + WS_XB) + (size_t)it * 16 * 1024, TID);
                else convert_rows16(A.in[1] + (size_t)(it - 1024) * 16 * 1024, (bf16_t*)(ws + WS_XBD) + (size_t)(it - 1024) * 16 * 1024, TID);
            }
            LAS float* s = (LAS float*)lds;
            float rr[16];
            if (bid < 3712) { P0_DESC(bid)
#pragma unroll
                for (int i = 0; i < 16; ++i) { const int e = i * 512 + tid, kk = e >> 6, nn = e & 63, n = ns0 + nn; rr[i] = (n < N) ? __builtin_nontemporal_load(W + (size_t)(k0 + kk) * N + n) : 0.f; } }
            for (int it = bid; it < 3712; it += G) {
#pragma unroll
                for (int i = 0; i < 16; ++i) { const int e = i * 512 + tid, kk = e >> 6, nn = e & 63; s[nn * 129 + kk] = rr[i]; }
                __syncthreads();
                if (it + G < 3712) { P0_DESC(it + G)
#pragma unroll
                    for (int i = 0; i < 16; ++i) { const int e = i * 512 + tid, kk = e >> 6, nn = e & 63, n = ns0 + nn; rr[i] = (n < N) ? __builtin_nontemporal_load(W + (size_t)(k0 + kk) * N + n) : 0.f; } }
                { P0_DESC(it)
#pragma unroll
                    for (int i = 0; i < 8; ++i) { const int e = i * 512 + tid, nn = e >> 6, kp = e & 63;
                        *(unsigned*)(Wt + (size_t)(n0 + nn) * K + k0 + 2 * kp) = pack2(s[nn * 129 + 2 * kp], s[nn * 129 + 2 * kp + 1]); } }
                __syncthreads();
            }
#undef P0_DESC
        } else if (EN(2) && ph == 2) {
            gdn_a_phase(lds, A, bid, G, TID);
#ifndef NO_DEC
            for (int it = bid; it < 1024; it += G) gdn_dec_item(lds, A, it, TID);
#endif
        } else if (EN(3) && ph == 3) {
            for (int it = bid; it < 256; it += G) gdn_scan_item(lds, A, it, TID);
        } else if (EN(4) && ph == 4) {
            const int tid = TID, wid = tid >> 6, lane = tid & 63; (void)tid; (void)wid; (void)lane;
            for (int it = bid; it < MP / 16; it += G) gdn_gate_row2(A, (size_t)it * 16 + wid * 2, lane);
        } else if (EN(8) && (ph == 8 || ph == 18)) {
            const int layer = (ph == 18);
            const float* cw = A.in[23] + (size_t)layer * 3 * DFF; const float* cb = A.in[24] + (size_t)layer * DFF;
            for (int it = bid; it < 256 + DB; it += G) {
                if (it < 256) ffn_fixup_item((const float*)(ws + WS_XF), (const float*)(ws + WS_XF) + (size_t)256 * 2 * DFF, (bf16_t*)(ws + WS_YB), cw, it, TID);
                else ffn_gate_dec_item((const bf16_t*)(ws + WS_PROJD), (bf16_t*)(ws + WS_YBD), cw, cb, A.in[6] + (size_t)layer * 128 * 2 * DFF, A.out + O_FCS + (size_t)layer * 128 * 2 * DFF, it - 256, TID); }
        } else if (EN(12) && ph == 12) {
            for (int it = bid; it < MP / 16; it += G) ssd_conv_item(A, it, TID);
            __syncthreads();
            for (int it = bid; it < 512; it += G) ssd_dec_item(lds, A, it, TID);
        } else if (EN(13) && ph == 13) {
            for (int it = bid; it < 256; it += G) ssd_scan_item(lds, A, it, TID);
        } else if (EN(14) && ph == 14) {
            const int tid = TID, wid = tid >> 6, lane = tid & 63; (void)tid; (void)wid; (void)lane;
            for (int it = bid; it < MP / 8; it += G) ssd_gate_row(A, (size_t)it * 8 + wid, lane);
        }
        }
        const bool again = (((unsigned)REPMASK >> ph) & 1u) && !rep_done;
        rep_done = again ? 1 : 0;
        const int phn = __builtin_amdgcn_readfirstlane(again ? ph : ph + 1);
        if (phn < ph_end) {
            { XcdBarrier xbar; xbar.bar = (unsigned*)(A.ws + WS_BARR); xbar.x = xb_xcc_id(); xbar.st = (volatile LAS unsigned*)(lds + 131072); xcd_barrier(xbar, TID); }
        }
        ph = phn;
    }
}

extern "C" void kernel_launch(void* const* d_in, const int* in_sizes, int n_in, void* d_out, int out_size, void* d_ws, size_t ws_size, hipStream_t stream) {
    static int grid = 0;
    if (grid == 0) {
        if (n_in != 30 || ws_size < WS_END) { fprintf(stderr, "kernel_launch: need 30 inputs and >= %zu bytes of workspace (got %d, %zu)\n", (size_t)WS_END, n_in, ws_size); grid = -1; return; }
        int dev = 0, cus = 0, per_cu = 0;
        (void)hipGetDevice(&dev); (void)hipDeviceGetAttribute(&cus, hipDeviceAttributeMultiprocessorCount, dev);
        if (hipOccupancyMaxActiveBlocksPerMultiprocessor(&per_cu, (const void*)fwd_kernel, 512, 0) != hipSuccess || per_cu < 1) { fprintf(stderr, "kernel_launch: occupancy query failed (%d)\n", per_cu); per_cu = 1; (void)hipGetLastError(); }
        grid = cus * per_cu;
    }
    if (grid < 0) return;
    if (hipMemsetAsync((char*)d_ws + WS_BARR, 0, 16384, stream) != hipSuccess) { fprintf(stderr, "kernel_launch: memset of barrier words failed\n"); return; }
    Args a{};
    for (int i = 0; i < 30; ++i) a.in[i] = (const float*)d_in[i];
    a.out = (float*)d_out; a.ws = (unsigned char*)d_ws;
#if ONE_LAUNCH
    a.ph_lo = 0; a.ph_hi = NPHASE;
    void* args[] = {&a};
    hipError_t e = hipLaunchCooperativeKernel((const void*)fwd_kernel, dim3(grid), dim3(512), args, 0, stream);
    if (e != hipSuccess) fprintf(stderr, "cooperative launch failed: %s (grid %d)\n", hipGetErrorString(e), grid);
#else
#ifndef NPH_RUN
#define NPH_RUN NPHASE
#endif
    for (int p = 0; p < NPH_RUN; ++p) { a.ph_lo = p; a.ph_hi = p + 1; hipLaunchKernelGGL(fwd_kernel, dim3(grid), dim3(512), 0, stream, a); }
#endif
}
```

```cpp
#include <hip/hip_runtime.h>
#include <hip/hip_cooperative_groups.h>
#include <cstdio>
namespace cg = cooperative_groups;

#ifndef ONE_LAUNCH
#define ONE_LAUNCH 1
#endif

#define LAS __attribute__((address_space(3)))
typedef unsigned short bf16_t;
typedef short bf16x8 __attribute__((ext_vector_type(8)));
typedef float f32x4 __attribute__((ext_vector_type(4)));
typedef float f32x2 __attribute__((ext_vector_type(2)));
typedef unsigned u32x4 __attribute__((ext_vector_type(4)));
typedef unsigned u32x2 __attribute__((ext_vector_type(2)));

constexpr int D = 1024, BP = 8, SL = 2048, MP = BP * SL, DB = 128;
constexpr int GH = 8, GIN = 4112, GINP = 4352;
constexpr int SIN = 5152, SINP = 5376, SINNER = 2048, SHEADS = 32;
constexpr int DFF = 2816, NUP = 5632;
constexpr float DN_ALPHA = 1.4142135623730951f;
constexpr float LN_EPS = 1e-5f, RMS_EPS = 1e-6f;

constexpr size_t MB = 1u << 20;
constexpr size_t WS_WGI = 0, WS_WGO = 17 * MB / 2, WS_WSI = 21 * MB / 2, WS_WSO = 21 * MB, WS_WUP0 = 25 * MB, WS_WUP1 = 36 * MB,
                 WS_WDN0 = 47 * MB, WS_WDN1 = 105 * MB / 2, WS_XB = 58 * MB, WS_XF = 90 * MB, WS_PROJ = 154 * MB, WS_H = 330 * MB,
                 WS_YB = 394 * MB, WS_BA = 482 * MB, WS_DEC = 484 * MB;
constexpr size_t WS_XBD = WS_DEC, WS_XFD = WS_XBD + 256 * 1024, WS_PROJD = WS_XFD + 512 * 1024, WS_BAD = WS_PROJD + 1441792,
                 WS_HD = WS_BAD + 16384, WS_YBD = WS_HD + 512 * 1024, WS_EGL = WS_YBD + 720896, WS_BARR = WS_EGL + 8192, WS_END = WS_BARR + 16384;
constexpr size_t WS_UT = WS_YB, WS_WN = WS_YB + 32 * MB, WS_QK = WS_YB + 64 * MB, WS_QD = WS_PROJ + 128 * MB, WS_KDT = WS_XF;
constexpr size_t WS_O = WS_H, WS_XA = WS_H, WS_BCA = WS_XF;

constexpr size_t O_YP = 0, O_YS = 16777216, O_GCP = 16908288, O_GCS = 16982016, O_GSP = 18161664, O_GSS = 19210240, O_SCP = 35987456,
                 O_SCS = 36061184, O_SSP = 37240832, O_SSS = 39337984, O_FCP = 72892416, O_FCS = 72982528;

constexpr int LDS_BYTES = 131072 + 2048;

__device__ __forceinline__ int make_tid(int wave_s) { unsigned ones = ~0u; asm volatile("" : "+s"(ones)); int t = wave_s * 64 + (int)__builtin_amdgcn_mbcnt_hi(ones, __builtin_amdgcn_mbcnt_lo(ones, 0u)); asm volatile("" : "+v"(t)); return t; }
__device__ __forceinline__ float bf2f(unsigned b) { return __uint_as_float(b << 16); }
typedef __bf16 bf16x2_t __attribute__((ext_vector_type(2)));
__device__ __forceinline__ unsigned pack2(float lo, float hi) { const f32x2 v = {lo, hi}; const bf16x2_t b = __builtin_convertvector(v, bf16x2_t); return __builtin_bit_cast(unsigned, b); }
__device__ __forceinline__ float lo_f(unsigned w) { return __uint_as_float(w << 16); }
__device__ __forceinline__ float hi_f(unsigned w) { return __uint_as_float(w & 0xffff0000u); }
__device__ __forceinline__ float silu_f(float x) { return x * __builtin_amdgcn_rcpf(1.f + __expf(-x)); }
__device__ __forceinline__ float sigmoid_f(float x) { return __builtin_amdgcn_rcpf(1.f + __expf(-x)); }
__device__ __forceinline__ float softplus_f(float x) { return x > 20.f ? x : log1pf(__expf(x)); }
#define DPP_F(x, ctrl, rmask) __builtin_bit_cast(float, __builtin_amdgcn_update_dpp(0, __builtin_bit_cast(int, (x)), (ctrl), (rmask), 0xf, false))
__device__ __forceinline__ float wave_sum(float v) {
    v += DPP_F(v, 0xB1, 0xf);
    v += DPP_F(v, 0x4E, 0xf);
    v += DPP_F(v, 0x141, 0xf);
    v += DPP_F(v, 0x140, 0xf);
    v += DPP_F(v, 0x142, 0xa);
    v += DPP_F(v, 0x143, 0xc);
    return __builtin_bit_cast(float, __builtin_amdgcn_readlane(__builtin_bit_cast(int, v), 63));
}
__device__ __forceinline__ float wave_incl_scan(float v, int lane) {
#pragma unroll
    for (int o = 1; o < 64; o <<= 1) { float t = __shfl_up(v, o); if (lane >= o) v += t; }
    return v;
}
__device__ __forceinline__ f32x4 mfma16(bf16x8 a, bf16x8 b, f32x4 c) { return __builtin_amdgcn_mfma_f32_16x16x32_bf16(a, b, c, 0, 0, 0); }
__device__ __forceinline__ void lds_barrier() { asm volatile("s_waitcnt lgkmcnt(0)" ::: "memory"); __builtin_amdgcn_s_barrier(); asm volatile("" ::: "memory"); }
__device__ __forceinline__ u32x2 pack4(f32x4 v) { u32x2 r; r.x = pack2(v[0], v[1]); r.y = pack2(v[2], v[3]); return r; }

namespace pg8 {
constexpr int BM = 256, BK = 64, HALF = 128, HTB = HALF * BK * 2, STAGE_BYTES = 8 * HTB, NXCD = 8, WGM = 8;
__device__ __forceinline__ int lds_byte(int r, int c) { const int st = (r >> 4) * 2 + (c >> 5), rr = r & 15, cc = c & 31, ob = rr * 64 + cc * 2; return st * 1024 + (ob ^ (((ob >> 9) & 1) << 5)); }
__device__ __forceinline__ void stage_rc(int b, int& R, int& C) { const int st = b / 1024, sb = b % 1024, swz = sb ^ (((sb >> 9) & 1) << 5); R = (st >> 1) * 16 + swz / 64; C = (st & 1) * 32 + (swz % 64) / 2; }
__device__ __forceinline__ int perm32(int rho) { const int n = rho >> 4, i = rho & 15; return 8 * (i >> 2) + 4 * n + (i & 3); }
struct Unit { int pm, pn; };
struct Gemm { const bf16_t* A; const bf16_t* Bt; int M, N, K; };
struct StaticOrder {
    int nM, nN, nwg, G, c;
    __device__ void init(int M, int N, int G_, int c_) { nM = M / BM; nN = N / BM; nwg = nM * nN; G = G_; c = c_; }
    __device__ bool next(int i, Unit& u) const {
        const long L = (long)i * G + c; if (L >= nwg) return false;
        int wgid = (int)L; { const int q = nwg / NXCD, r = nwg % NXCD, xcd = wgid % NXCD, off = wgid / NXCD; wgid = (xcd < r ? xcd * (q + 1) : r * (q + 1) + (xcd - r) * q) + off; }
        const int nig = WGM * nN, gid = wgid / nig, fm = gid * WGM, gsz = (nM - fm) < WGM ? (nM - fm) : WGM;
        u.pm = fm + ((wgid % nig) % gsz); u.pn = (wgid % nig) / gsz; return true;
    }
};
struct EpiF32 {
    static constexpr bool PERM = false;
    float* C; int ldc;
    __device__ __forceinline__ void operator()(const f32x4 (&acc)[2][2][4][2], const Unit& u, int wr, int wc, int fr, int fq) const {
        const int row0 = u.pm * BM + wr * 64 + fr, col0 = u.pn * BM + wc * 32 + 4 * fq;
#pragma unroll
        for (int ai = 0; ai < 2; ++ai)
#pragma unroll
            for (int m = 0; m < 4; ++m) { float* rowp = C + (size_t)(row0 + ai * HALF + m * 16) * ldc + col0;
#pragma unroll
                for (int bj = 0; bj < 2; ++bj)
#pragma unroll
                    for (int n = 0; n < 2; ++n) *(f32x4*)(rowp + bj * HALF + n * 16) = acc[ai][bj][m][n]; }
    }
};
struct EpiBf16 {
    static constexpr bool PERM = true;
    bf16_t* O; int ldo;
    __device__ __forceinline__ void operator()(const f32x4 (&acc)[2][2][4][2], const Unit& u, int wr, int wc, int fr, int fq) const {
        const int row0 = u.pm * BM + wr * 64 + fr, col0 = u.pn * BM + wc * 32 + 8 * fq;
#pragma unroll
        for (int ai = 0; ai < 2; ++ai)
#pragma unroll
            for (int m = 0; m < 4; ++m) { bf16_t* rowp = O + (size_t)(row0 + ai * HALF + m * 16) * ldo + col0;
#pragma unroll
                for (int bj = 0; bj < 2; ++bj) { const f32x4 v0 = acc[ai][bj][m][0], v1 = acc[ai][bj][m][1];
                    u32x4 w; w.x = pack2(v0[0], v0[1]); w.y = pack2(v0[2], v0[3]); w.z = pack2(v1[0], v1[1]); w.w = pack2(v1[2], v1[3]);
                    *(u32x4*)(rowp + bj * HALF) = w; } }
    }
};
__device__ __forceinline__ float dpp_ror1(float x) { return __builtin_bit_cast(float, __builtin_amdgcn_update_dpp(0, __builtin_bit_cast(int, x), 0x121, 0xf, 0xf, false)); }
__device__ __forceinline__ float dpp_ror2(float x) { return __builtin_bit_cast(float, __builtin_amdgcn_update_dpp(0, __builtin_bit_cast(int, x), 0x122, 0xf, 0xf, false)); }
struct EpiGate {
    bf16_t* HB; const float* cw; const float* cb; float* edge; float* first; float* cache;
    __device__ __forceinline__ void operator()(const f32x4 (&acc)[2][2][4][2], const Unit& u, int wr, int wc, int fr_, int fq_) const {
        int fr = fr_, fq = fq_; asm volatile("" : "+v"(fr), "+v"(fq));
#pragma unroll
        for (int n = 0; n < 2; ++n) {
            const int ch = u.pn * 128 + wc * 32 + 8 * fq + 4 * n;
            const f32x4 w0 = *(const f32x4*)(cw + ch), w1 = *(const f32x4*)(cw + DFF + ch), w2 = *(const f32x4*)(cw + 2 * DFF + ch), bb = *(const f32x4*)(cb + ch);
#pragma unroll
            for (int ai = 0; ai < 2; ++ai) {
                const int strip = u.pm * 4 + ai * 2 + wr;
                f32x4 pr1 = (f32x4){0.f, 0.f, 0.f, 0.f}, pr2 = pr1;
#pragma unroll
                for (int m = 0; m < 4; ++m) {
                    const f32x4 g = acc[ai][0][m][n], v = acc[ai][1][m][n];
                    f32x4 c1, c2;
#pragma unroll
                    for (int j = 0; j < 4; ++j) { c1[j] = dpp_ror1(g[j]); c2[j] = dpp_ror2(g[j]); }
                    const f32x4 p1 = (m == 0 || fr >= 1) ? c1 : pr1;
                    const f32x4 p2 = (m == 0 || fr >= 2) ? c2 : pr2;
                    pr1 = c1; pr2 = c2;
                    const size_t row = (size_t)u.pm * 256 + ai * 128 + wr * 64 + m * 16 + fr;
                    if (m == 0 && fr < 2) {
                        const f32x4 pa = (fr == 0) ? (bb + w2 * g) : (bb + w1 * p1 + w2 * g);
                        float* fp = first + ((size_t)strip * 2 + fr) * (2 * DFF) + ch;
                        *(f32x4*)fp = pa; *(f32x4*)(fp + DFF) = v;
                    } else {
                        const f32x4 y = bb + w0 * p2 + w1 * p1 + w2 * g; f32x4 o;
#pragma unroll
                        for (int j = 0; j < 4; ++j) o[j] = silu_f(y[j]) * v[j];
                        *(u32x2*)(HB + row * DFF + ch) = pack4(o);
                    }
                    if (m == 3 && fr >= 14) {
                        *(f32x4*)(edge + ((size_t)strip * 2 + (fr - 14)) * DFF + ch) = g;
                        if ((strip & 31) == 31) *(f32x4*)(cache + ((size_t)(strip >> 5) * 2 + (fr - 14)) * DFF + ch) = g;
                    }
                }
            }
        }
    }
};
struct EpiUni {
    int mode; bf16_t* O; int ldo; const float* cw; const float* cb; float* aux; float* cache;
    __device__ __forceinline__ void operator()(const f32x4 (&acc)[2][2][4][2], const Unit& u, int wr, int wc, int fr_, int fq_) const {
        (void)fr_; (void)fq_;
        unsigned ones = ~0u; asm volatile("" : "+s"(ones));
        const int lane_e = (int)__builtin_amdgcn_mbcnt_hi(ones, __builtin_amdgcn_mbcnt_lo(ones, 0u)), fr = lane_e & 15, fq = lane_e >> 4;
        if (mode == 2) { EpiGate e{O, cw, cb, aux, aux + (size_t)256 * 2 * DFF, cache}; e(acc, u, wr, wc, fr, fq); }
        else { EpiBf16 e{O, ldo}; e(acc, u, wr, wc, fr, fq); }
    }
};

template <class Epi, class Sched>
__device__ __forceinline__ void gemm_phase(LAS unsigned char* lds, const Gemm g, const Sched& S, const Epi& E, int tid_in) {
    const int tid = tid_in, wid = __builtin_amdgcn_readfirstlane(tid >> 6), lane = tid & 63, wr = wid >> 2, wc = wid & 3, fr = lane & 15, fq = lane >> 4;
    const int K = g.K, nt = K / BK;
    unsigned voffA[2], voffB[2];
#pragma unroll
    for (int i = 0; i < 2; ++i) { int R, C; stage_rc(tid * 16 + i * 8192, R, C); const int Rb = (E.mode != 0) ? ((R & ~31) + perm32(R & 31)) : R;
        voffA[i] = (unsigned)(R * K + C) * 2u; voffB[i] = (unsigned)(Rb * K + C) * 2u; }
    const size_t kstep = (size_t)(BK * 2);
    const size_t hstep = (size_t)HALF * K * 2;
    const size_t tstep = 2 * hstep;
    const unsigned ldsw = (unsigned)wid * 1024u;
    const int aoff = lds_byte(wr * 64 + fr, fq * 8), boff = lds_byte(wc * 32 + fr, fq * 8);
#define PG8_SA(b, h) (((b) * 2 + (h)) * HTB)
#define PG8_SB(b, h) ((4 + (b) * 2 + (h)) * HTB)
#define PG8_STAGE(bufoff, gbase, voff) do { _Pragma("unroll") for (int _i = 0; _i < 2; ++_i) \
        __builtin_amdgcn_global_load_lds((const unsigned*)((const char*)(gbase) + (voff)[_i]), (LAS unsigned*)(lds + (bufoff) + ldsw + _i * 8192), 16, 0, 0); } while (0)
#define PG8_LDA(dst, b, h) do { _Pragma("unroll") for (int m = 0; m < 4; ++m) _Pragma("unroll") for (int k = 0; k < 2; ++k) dst[m][k] = *(const LAS bf16x8*)(lds + PG8_SA(b, h) + aoff + m * 2048 + k * 1024); } while (0)
#define PG8_LDB(dst, b, h) do { _Pragma("unroll") for (int n = 0; n < 2; ++n) _Pragma("unroll") for (int k = 0; k < 2; ++k) dst[n][k] = *(const LAS bf16x8*)(lds + PG8_SB(b, h) + boff + n * 2048 + k * 1024); } while (0)
#define PG8_MMA(ai, bj, At, Bt) do { __builtin_amdgcn_s_setprio(1); _Pragma("unroll") for (int m = 0; m < 4; ++m) _Pragma("unroll") for (int n = 0; n < 2; ++n) _Pragma("unroll") for (int k = 0; k < 2; ++k) \
        acc[ai][bj][m][n] = __builtin_amdgcn_mfma_f32_16x16x32_bf16(Bt[n][k], At[m][k], acc[ai][bj][m][n], 0, 0, 0); __builtin_amdgcn_s_setprio(0); } while (0)
#define PG8_WAIT_V(n) asm volatile("s_waitcnt vmcnt(" #n ")" ::: "memory")
#define PG8_WAIT_L(n) asm volatile("s_waitcnt lgkmcnt(" #n ")" ::: "memory")
#define PG8_BAR __builtin_amdgcn_s_barrier()
#define PG8_SCHED __builtin_amdgcn_sched_barrier(0)
    Unit cur, nxt; int ui = 0;
    if (!S.next(0, cur)) return;
    f32x4 acc[2][2][4][2];
#pragma unroll
    for (int a = 0; a < 2; ++a)
#pragma unroll
        for (int b = 0; b < 2; ++b)
#pragma unroll
            for (int m = 0; m < 4; ++m)
#pragma unroll
                for (int n = 0; n < 2; ++n) acc[a][b][m][n] = (f32x4){0.f, 0.f, 0.f, 0.f};
    bf16x8 At[4][2], B0[2][2], B1[2][2];
    const char* cA = (const char*)g.A + (size_t)cur.pm * tstep; const char* cB = (const char*)g.Bt + (size_t)cur.pn * tstep;
    PG8_STAGE(PG8_SB(0, 0), cB, voffB); PG8_STAGE(PG8_SA(0, 0), cA, voffA); PG8_STAGE(PG8_SB(0, 1), cB + hstep, voffB); PG8_STAGE(PG8_SA(0, 1), cA + hstep, voffA);
    if (wr == 1) PG8_BAR;
    PG8_WAIT_V(4); PG8_BAR;
    PG8_STAGE(PG8_SB(1, 0), cB + kstep, voffB); PG8_STAGE(PG8_SA(1, 0), cA + kstep, voffA); PG8_STAGE(PG8_SB(1, 1), cB + hstep + kstep, voffB);
    PG8_WAIT_V(6); PG8_BAR;
    for (;;) {
        const bool has_next = S.next(ui + 1, nxt);
        const char* nA = has_next ? (const char*)g.A + (size_t)nxt.pm * tstep : cA; const char* nB = has_next ? (const char*)g.Bt + (size_t)nxt.pn * tstep : cB;
        for (int t = 0; t < nt; t += 2) {
            const bool last = (t == nt - 2);
            const char* a1 = cA + (size_t)(t + 1) * kstep;
            const char* a2 = last ? nA : cA + (size_t)(t + 2) * kstep; const char* b2 = last ? nB : cB + (size_t)(t + 2) * kstep;
            const char* a3 = a2 + kstep; const char* b3 = b2 + kstep;
            PG8_LDB(B0, 0, 0); PG8_SCHED; PG8_LDA(At, 0, 0); PG8_STAGE(PG8_SA(1, 1), a1 + hstep, voffA);
            PG8_WAIT_L(8); PG8_BAR; PG8_WAIT_L(0); PG8_MMA(0, 0, At, B0); PG8_BAR; PG8_SCHED;
            PG8_LDB(B1, 0, 1); PG8_STAGE(PG8_SB(0, 0), b2, voffB);
            PG8_BAR; PG8_WAIT_L(0); PG8_MMA(0, 1, At, B1); PG8_BAR;
            PG8_LDA(At, 0, 1); PG8_STAGE(PG8_SA(0, 0), a2, voffA);
            PG8_BAR; PG8_WAIT_L(0); PG8_MMA(1, 0, At, B0); PG8_BAR; PG8_SCHED;
            PG8_STAGE(PG8_SB(0, 1), b2 + hstep, voffB);
            PG8_WAIT_V(6); PG8_BAR; PG8_MMA(1, 1, At, B1); PG8_BAR;
            PG8_LDB(B0, 1, 0); PG8_SCHED; PG8_LDA(At, 1, 0); PG8_STAGE(PG8_SA(0, 1), a2 + hstep, voffA);
            PG8_WAIT_L(8); PG8_BAR; PG8_WAIT_L(0); PG8_MMA(0, 0, At, B0); PG8_BAR; PG8_SCHED;
            PG8_LDB(B1, 1, 1); PG8_STAGE(PG8_SB(1, 0), b3, voffB);
            PG8_BAR; PG8_WAIT_L(0); PG8_MMA(0, 1, At, B1); PG8_BAR;
            PG8_LDA(At, 1, 1); PG8_STAGE(PG8_SA(1, 0), a3, voffA);
            PG8_BAR; PG8_WAIT_L(0); PG8_MMA(1, 0, At, B0); PG8_BAR; PG8_SCHED;
            PG8_STAGE(PG8_SB(1, 1), b3 + hstep, voffB);
            PG8_WAIT_V(6); PG8_BAR; PG8_MMA(1, 1, At, B1); PG8_BAR;
        }
        E(acc, cur, wr, wc, fr, fq);
        if (!has_next) break;
#pragma unroll
        for (int a = 0; a < 2; ++a)
#pragma unroll
            for (int b = 0; b < 2; ++b)
#pragma unroll
                for (int m = 0; m < 4; ++m)
#pragma unroll
                    for (int n = 0; n < 2; ++n) acc[a][b][m][n] = (f32x4){0.f, 0.f, 0.f, 0.f};
        cur = nxt; cA = nA; cB = nB; ++ui;
    }
    PG8_WAIT_V(0);
    if (wr == 0) PG8_BAR;
    PG8_BAR;
#undef PG8_SA
#undef PG8_SB
#undef PG8_STAGE
#undef PG8_LDA
#undef PG8_LDB
#undef PG8_MMA
#undef PG8_WAIT_V
#undef PG8_WAIT_L
#undef PG8_BAR
#undef PG8_SCHED
}
}

struct Args {
    const float* in[30];
    float* out;
    unsigned char* ws;
    int ph_lo, ph_hi;
};

struct DecStore {
    int ldp, nbf, nf; bf16_t* Pd; float* BAd;
    __device__ __forceinline__ void operator()(int row, int col, float v0, float v1) const {
        if (col < nbf) { *(unsigned*)(Pd + (size_t)row * ldp + col) = pack2(v0, v1); }
        else if (col < nbf + nf) { BAd[row * 32 + col - nbf] = v0; BAd[row * 32 + col - nbf + 1] = v1; }
    }
};
__device__ __forceinline__ void small_gemm_item(LAS unsigned char* lds, const bf16_t* __restrict__ A, int lda, const bf16_t* __restrict__ Bt, int K, int item, const DecStore& st, int tid_in) {
    const int tid = tid_in, wid = tid >> 6, lane = tid & 63, fr = lane & 15, fq = lane >> 4;
    const int rg = item & 7, cgp = item >> 3;
    const int kw = K >> 3;
    const bf16_t* ap = A + (size_t)(rg * 16 + fr) * lda + wid * kw + fq * 8;
    const bf16_t* bp = Bt + (size_t)(cgp * 64 + fr) * K + wid * kw + fq * 8;
    f32x4 acc[4];
#pragma unroll
    for (int n = 0; n < 4; ++n) acc[n] = (f32x4){0.f, 0.f, 0.f, 0.f};
    int k0 = 0;
    for (; k0 + 128 <= kw; k0 += 128) {
        bf16x8 a[4], bq[4][4];
#pragma unroll
        for (int q = 0; q < 4; ++q) { a[q] = *(const bf16x8*)(ap + k0 + 32 * q);
#pragma unroll
            for (int n = 0; n < 4; ++n) bq[q][n] = *(const bf16x8*)(bp + (size_t)n * 16 * K + k0 + 32 * q); }
#pragma unroll
        for (int q = 0; q < 4; ++q)
#pragma unroll
            for (int n = 0; n < 4; ++n) acc[n] = mfma16(a[q], bq[q][n], acc[n]);
    }
    for (; k0 < kw; k0 += 32) {
        const bf16x8 a = *(const bf16x8*)(ap + k0);
#pragma unroll
        for (int n = 0; n < 4; ++n) { const bf16x8 b = *(const bf16x8*)(bp + (size_t)n * 16 * K + k0); acc[n] = mfma16(a, b, acc[n]); }
    }
    LAS float* red = (LAS float*)lds;
#pragma unroll
    for (int n = 0; n < 4; ++n)
#pragma unroll
        for (int r = 0; r < 4; ++r) red[wid * 1024 + (fq * 4 + r) * 64 + n * 16 + fr] = acc[n][r];
    __syncthreads();
    {
        const int row = tid >> 5, c2 = (tid & 31) * 2; float v0 = 0.f, v1 = 0.f;
#pragma unroll
        for (int w = 0; w < 8; ++w) { v0 += red[w * 1024 + row * 64 + c2]; v1 += red[w * 1024 + row * 64 + c2 + 1]; }
        st(rg * 16 + row, cgp * 64 + c2, v0, v1);
    }
    __syncthreads();
}

template <int NT>
__device__ __forceinline__ void narrow_item(const bf16_t* __restrict__ A, const bf16_t* __restrict__ Bt, int K, float* __restrict__ BAo, int item, int tid_in) {
    const int tid = tid_in, wid = tid >> 6, lane = tid & 63, fr = lane & 15, fq = lane >> 4;
    const int row0 = item * 128 + wid * 16;
    const bf16_t* ap = A + (size_t)(row0 + fr) * K + fq * 8;
    const bf16_t* bp = Bt + (size_t)fr * K + fq * 8;
    f32x4 acc[NT];
#pragma unroll
    for (int n = 0; n < NT; ++n) acc[n] = (f32x4){0.f, 0.f, 0.f, 0.f};
#pragma unroll 8
    for (int k = 0; k < K; k += 32) {
        const bf16x8 a = *(const bf16x8*)(ap + k);
#pragma unroll
        for (int n = 0; n < NT; ++n) { const bf16x8 bfr = *(const bf16x8*)(bp + (size_t)n * 16 * K + k); acc[n] = mfma16(bfr, a, acc[n]); }
    }
#pragma unroll
    for (int n = 0; n < NT; ++n) *(f32x4*)(BAo + (size_t)(row0 + fr) * 32 + n * 16 + fq * 4) = acc[n];
}

__device__ __forceinline__ void convert_rows16(const float* __restrict__ src, bf16_t* __restrict__ dst, int tid_in) {
#pragma unroll
    for (int i = 0; i < 8; ++i) { const int e = i * 512 + tid_in; const f32x4 v = __builtin_nontemporal_load((const f32x4*)src + e);
        u32x2 w; w.x = pack2(v[0], v[1]); w.y = pack2(v[2], v[3]); ((u32x2*)dst)[e] = w; }
}

__device__ __forceinline__ void unpack8(const u32x4 w, float (&f)[8]) {
    f[0] = lo_f(w.x); f[1] = hi_f(w.x); f[2] = lo_f(w.y); f[3] = hi_f(w.y); f[4] = lo_f(w.z); f[5] = hi_f(w.z); f[6] = lo_f(w.w); f[7] = hi_f(w.w);
}
__device__ __forceinline__ u32x4 pack8(const float (&f)[8]) { u32x4 w; w.x = pack2(f[0], f[1]); w.y = pack2(f[2], f[3]); w.z = pack2(f[4], f[5]); w.w = pack2(f[6], f[7]); return w; }
__device__ __forceinline__ void ln_row(const bf16_t* __restrict__ xres, const bf16_t* __restrict__ h, const float* __restrict__ gam, const float* __restrict__ bet,
                                       float* __restrict__ outF, bf16_t* __restrict__ outB, int lane) {
    float v[2][8]; float s = 0.f;
#pragma unroll
    for (int i = 0; i < 2; ++i) { float a[8], b[8]; unpack8(((const u32x4*)xres)[i * 64 + lane], a); unpack8(((const u32x4*)h)[i * 64 + lane], b);
#pragma unroll
        for (int j = 0; j < 8; ++j) { v[i][j] = a[j] * DN_ALPHA + b[j]; s += v[i][j]; } }
    const float mu = wave_sum(s) * (1.f / 1024.f); float q = 0.f;
#pragma unroll
    for (int i = 0; i < 2; ++i)
#pragma unroll
        for (int j = 0; j < 8; ++j) { v[i][j] -= mu; q += v[i][j] * v[i][j]; }
    const float rstd = __builtin_amdgcn_rsqf(wave_sum(q) * (1.f / 1024.f) + LN_EPS);
#pragma unroll
    for (int i = 0; i < 2; ++i) { float o[8];
#pragma unroll
        for (int hh = 0; hh < 2; ++hh) { const f32x4 g = ((const f32x4*)gam)[i * 128 + lane * 2 + hh], b = ((const f32x4*)bet)[i * 128 + lane * 2 + hh];
#pragma unroll
            for (int j = 0; j < 4; ++j) o[hh * 4 + j] = v[i][hh * 4 + j] * rstd * g[j] + b[j]; }
        if (outB) ((u32x4*)outB)[i * 64 + lane] = pack8(o);
        if (outF) { ((f32x4*)outF)[i * 128 + lane * 2] = (f32x4){o[0], o[1], o[2], o[3]}; ((f32x4*)outF)[i * 128 + lane * 2 + 1] = (f32x4){o[4], o[5], o[6], o[7]}; } }
}

__device__ __forceinline__ void ln_row2(const bf16_t* __restrict__ x0, const bf16_t* __restrict__ h0, const bf16_t* __restrict__ x1, const bf16_t* __restrict__ h1,
                                        const float* __restrict__ gam, const float* __restrict__ bet, float* oF0, bf16_t* oB0, float* oF1, bf16_t* oB1, int lane) {
    u32x4 xa[2][2], ha[2][2];
#pragma unroll
    for (int i = 0; i < 2; ++i) { xa[0][i] = ((const u32x4*)x0)[i * 64 + lane]; ha[0][i] = ((const u32x4*)h0)[i * 64 + lane]; xa[1][i] = ((const u32x4*)x1)[i * 64 + lane]; ha[1][i] = ((const u32x4*)h1)[i * 64 + lane]; }
#pragma unroll
    for (int rr = 0; rr < 2; ++rr) {
        float v[2][8]; float s = 0.f;
#pragma unroll
        for (int i = 0; i < 2; ++i) { float a[8], b[8]; unpack8(xa[rr][i], a); unpack8(ha[rr][i], b);
#pragma unroll
            for (int j = 0; j < 8; ++j) { v[i][j] = a[j] * DN_ALPHA + b[j]; s += v[i][j]; } }
        const float mu = wave_sum(s) * (1.f / 1024.f); float q = 0.f;
#pragma unroll
        for (int i = 0; i < 2; ++i)
#pragma unroll
            for (int j = 0; j < 8; ++j) { v[i][j] -= mu; q += v[i][j] * v[i][j]; }
        const float rstd = __builtin_amdgcn_rsqf(wave_sum(q) * (1.f / 1024.f) + LN_EPS);
        float* outF = rr ? oF1 : oF0; bf16_t* outB = rr ? oB1 : oB0;
#pragma unroll
        for (int i = 0; i < 2; ++i) { float o[8];
#pragma unroll
            for (int hh = 0; hh < 2; ++hh) { const f32x4 g = ((const f32x4*)gam)[i * 128 + lane * 2 + hh], b = ((const f32x4*)bet)[i * 128 + lane * 2 + hh];
#pragma unroll
                for (int j = 0; j < 4; ++j) o[hh * 4 + j] = v[i][hh * 4 + j] * rstd * g[j] + b[j]; }
            if (outB) ((u32x4*)outB)[i * 64 + lane] = pack8(o);
            if (outF) { __builtin_nontemporal_store((f32x4){o[0], o[1], o[2], o[3]}, (f32x4*)outF + i * 128 + lane * 2); __builtin_nontemporal_store((f32x4){o[4], o[5], o[6], o[7]}, (f32x4*)outF + i * 128 + lane * 2 + 1); } }
    }
}
__device__ __forceinline__ void ln_row3(const bf16_t* __restrict__ x0, const bf16_t* __restrict__ h0, const bf16_t* __restrict__ x1, const bf16_t* __restrict__ h1, const bf16_t* __restrict__ x2, const bf16_t* __restrict__ h2,
                                        const float* __restrict__ gam, const float* __restrict__ bet, float* oF0, bf16_t* oB0, float* oF1, bf16_t* oB1, float* oF2, bf16_t* oB2, int lane) {
    u32x4 xa[3][2], ha[3][2];
#pragma unroll
    for (int i = 0; i < 2; ++i) { xa[0][i] = ((const u32x4*)x0)[i * 64 + lane]; ha[0][i] = ((const u32x4*)h0)[i * 64 + lane]; xa[1][i] = ((const u32x4*)x1)[i * 64 + lane]; ha[1][i] = ((const u32x4*)h1)[i * 64 + lane]; xa[2][i] = ((const u32x4*)x2)[i * 64 + lane]; ha[2][i] = ((const u32x4*)h2)[i * 64 + lane]; }
#pragma unroll
    for (int rr = 0; rr < 3; ++rr) {
        float v[2][8]; float s = 0.f;
#pragma unroll
        for (int i = 0; i < 2; ++i) { float a[8], b[8]; unpack8(xa[rr][i], a); unpack8(ha[rr][i], b);
#pragma unroll
            for (int j = 0; j < 8; ++j) { v[i][j] = a[j] * DN_ALPHA + b[j]; s += v[i][j]; } }
        const float mu = wave_sum(s) * (1.f / 1024.f); float q = 0.f;
#pragma unroll
        for (int i = 0; i < 2; ++i)
#pragma unroll
            for (int j = 0; j < 8; ++j) { v[i][j] -= mu; q += v[i][j] * v[i][j]; }
        const float rstd = __builtin_amdgcn_rsqf(wave_sum(q) * (1.f / 1024.f) + LN_EPS);
        float* outF = rr == 0 ? oF0 : (rr == 1 ? oF1 : oF2); bf16_t* outB = rr == 0 ? oB0 : (rr == 1 ? oB1 : oB2);
#pragma unroll
        for (int i = 0; i < 2; ++i) { float o[8];
#pragma unroll
            for (int hh = 0; hh < 2; ++hh) { const f32x4 g = ((const f32x4*)gam)[i * 128 + lane * 2 + hh], b = ((const f32x4*)bet)[i * 128 + lane * 2 + hh];
#pragma unroll
                for (int j = 0; j < 4; ++j) o[hh * 4 + j] = v[i][hh * 4 + j] * rstd * g[j] + b[j]; }
            if (outB) ((u32x4*)outB)[i * 64 + lane] = pack8(o);
            if (outF) { __builtin_nontemporal_store((f32x4){o[0], o[1], o[2], o[3]}, (f32x4*)outF + i * 128 + lane * 2); __builtin_nontemporal_store((f32x4){o[4], o[5], o[6], o[7]}, (f32x4*)outF + i * 128 + lane * 2 + 1); } }
    }
}

__device__ __forceinline__ void ffn_fixup_item(const float* __restrict__ edge, const float* __restrict__ first, bf16_t* __restrict__ HB, const float* __restrict__ cw, int strip, int tid_in) {
    const int t = tid_in; if (t >= 352) return;
    const int c0 = t * 8;
    const bool has_hist = (strip & 31) != 0;
#pragma unroll
    for (int hh = 0; hh < 2; ++hh) {
        const int ch = c0 + 4 * hh;
        const f32x4 w0 = *(const f32x4*)(cw + ch), w1 = *(const f32x4*)(cw + DFF + ch);
        f32x4 e0 = (f32x4){0.f, 0.f, 0.f, 0.f}, e1 = e0;
        if (has_hist) { e0 = *(const f32x4*)(edge + ((size_t)(strip - 1) * 2 + 0) * DFF + ch); e1 = *(const f32x4*)(edge + ((size_t)(strip - 1) * 2 + 1) * DFF + ch); }
#pragma unroll
        for (int rr = 0; rr < 2; ++rr) {
            const float* fp = first + ((size_t)strip * 2 + rr) * (2 * DFF) + ch;
            const f32x4 pa = *(const f32x4*)fp, v = *(const f32x4*)(fp + DFF);
            const f32x4 y = (rr == 0) ? (pa + w0 * e0 + w1 * e1) : (pa + w0 * e1); f32x4 o;
#pragma unroll
            for (int j = 0; j < 4; ++j) o[j] = silu_f(y[j]) * v[j];
            *(u32x2*)(HB + ((size_t)strip * 64 + rr) * DFF + ch) = pack4(o);
        }
    }
}
__device__ __forceinline__ void ffn_gate_dec_item(const bf16_t* __restrict__ GVd, bf16_t* __restrict__ HBd, const float* __restrict__ cw, const float* __restrict__ cb,
                                                  const float* __restrict__ cache_in  , float* __restrict__ cache_out, int item, int tid_in) {
    const int t = tid_in; if (t >= 352) return;
    const int c0 = t * 8;
    float w0[8], w1[8], w2[8], bb[8];
#pragma unroll
    for (int j = 0; j < 8; ++j) { w0[j] = cw[c0 + j]; w1[j] = cw[DFF + c0 + j]; w2[j] = cw[2 * DFF + c0 + j]; bb[j] = cb[c0 + j]; }
    {
        const int row = item;
        float gcur[8], vv[8], o[8];
        const int cp = 256 * (c0 >> 7) + (c0 & 127);
        unpack8(*(const u32x4*)(GVd + (size_t)row * NUP + cp), gcur); unpack8(*(const u32x4*)(GVd + (size_t)row * NUP + cp + 128), vv);
        const float* ci = cache_in + (size_t)row * 2 * DFF + c0; float* co = cache_out + (size_t)row * 2 * DFF + c0;
#pragma unroll
        for (int j = 0; j < 8; ++j) { const float c0v = ci[j], c1v = ci[DFF + j]; const float y = bb[j] + w0[j] * c0v + w1[j] * c1v + w2[j] * gcur[j]; o[j] = silu_f(y) * vv[j];
            co[j] = c1v; co[DFF + j] = gcur[j]; }
        *(u32x4*)(HBd + (size_t)row * DFF + c0) = pack8(o);
    }
}

constexpr int GA_QS = 0, GA_KS = 17408, GA_VBT = 34816, GA_KBGT = 53248, GA_MS = 71680, GA_TS = 89088, GA_GC = 98304, GA_BT = 98560, GA_TL = 99328, GA_PB = 115712;
__device__ __forceinline__ void gdn_a_phase(LAS unsigned char* lds, const Args& A, int bid, int G, int tid_in) {
    const bf16_t* PROJ = (const bf16_t*)(A.ws + WS_PROJ);
    const float* BA = (const float*)(A.ws + WS_BA);
    float* EGL = (float*)(A.ws + WS_EGL);
    LAS unsigned* Qs = (LAS unsigned*)(lds + GA_QS); LAS unsigned* Ks = (LAS unsigned*)(lds + GA_KS);
    LAS float* Ms = (LAS float*)(lds + GA_MS); LAS bf16_t* Ts = (LAS bf16_t*)(lds + GA_TS);
    LAS float* gc = (LAS float*)(lds + GA_GC); LAS float* bt = (LAS float*)(lds + GA_BT);
    LAS float* Tl = (LAS float*)(lds + GA_TL); LAS float* Pb = (LAS float*)(lds + GA_PB);
    unsigned xw[3][11]; float pbr = 0.f, par = 0.f;
#define GA_IDS int tid = tid_in; asm volatile("" : "+v"(tid)); const int wid = tid >> 6, lane = tid & 63, fr = lane & 15, fq = lane >> 4, i0 = wid * 8, c = 2 * lane; (void)fr; (void)fq;
#define GA_LOAD(it) { const int _n = (it) & 31, _h = ((it) >> 5) & 7, _b = (it) >> 8; \
        _Pragma("unroll") for (int seg = 0; seg < 3; ++seg) _Pragma("unroll") for (int r = 0; r < 11; ++r) { const int t = _n * 64 + i0 + r - 3; \
            xw[seg][r] = *(const unsigned*)(PROJ + ((size_t)_b * SL + (t < 0 ? 0 : t)) * 4096 + seg * 1024 + _h * 128 + c); } \
        if (wid == 0) { const size_t _rb = (size_t)_b * SL + _n * 64 + lane; pbr = BA[_rb * 32 + _h]; par = BA[_rb * 32 + 8 + _h]; } }
    if (bid < 2048) { GA_IDS GA_LOAD(bid) }
    for (int item = bid; item < 2048; item += G) {
        GA_IDS
        const int n = item & 31, h = (item >> 5) & 7, b = item >> 8, chunk = (b * 8 + h) * 32 + n;
        bf16_t* UT = (bf16_t*)(A.ws + WS_UT) + (size_t)chunk * 8192; bf16_t* WN = (bf16_t*)(A.ws + WS_WN) + (size_t)chunk * 8192;
        bf16_t* QD = (bf16_t*)(A.ws + WS_QD) + (size_t)chunk * 8192; bf16_t* KDT = (bf16_t*)(A.ws + WS_KDT) + (size_t)chunk * 8192;
        bf16_t* QK = (bf16_t*)(A.ws + WS_QK) + (size_t)chunk * 4096;
        if (wid == 0) {
            const float g = -__expf(A.in[10][h]) * softplus_f(par + A.in[11][h]);
            const float gcum = wave_incl_scan(g, lane);
            gc[lane] = gcum; bt[lane] = sigmoid_f(pbr);
            if (lane == 63) EGL[chunk] = __expf(gcum);
        }
        lds_barrier();
        {
            const float glast = gc[63];
#pragma unroll
            for (int seg = 0; seg < 3; ++seg) {
                const int col = seg * 1024 + h * 128 + c;
                float w0[4], w1[4];
#pragma unroll
                for (int k = 0; k < 4; ++k) { const f32x2 t = *(const f32x2*)(A.in[8] + k * 3072 + col); w0[k] = t.x; w1[k] = t.y; }
                const f32x2 bb = *(const f32x2*)(A.in[9] + col);
                float x0[11], x1[11];
#pragma unroll
                for (int r = 0; r < 11; ++r) { const bool okr = (n * 64 + i0 + r - 3) >= 0; x0[r] = okr ? lo_f(xw[seg][r]) : 0.f; x1[r] = okr ? hi_f(xw[seg][r]) : 0.f; }
                if (n == 31 && wid == 7) {
#pragma unroll
                    for (int rr = 0; rr < 3; ++rr) *(f32x2*)(A.out + O_GCP + ((size_t)b * 3 + rr) * 3072 + col) = (f32x2){x0[8 + rr], x1[8 + rr]};
                }
                float y0[8], y1[8];
#pragma unroll
                for (int r = 0; r < 8; ++r) {
                    y0[r] = silu_f(bb.x + w0[0] * x0[r] + w0[1] * x0[r + 1] + w0[2] * x0[r + 2] + w0[3] * x0[r + 3]);
                    y1[r] = silu_f(bb.y + w1[0] * x1[r] + w1[1] * x1[r + 1] + w1[2] * x1[r + 2] + w1[3] * x1[r + 3]);
                }
                if (seg < 2) {
#pragma unroll
                    for (int r = 0; r < 8; ++r) { const float ss = wave_sum(y0[r] * y0[r] + y1[r] * y1[r]); const float rn = __builtin_amdgcn_rsqf(ss + 1e-6f) * (seg == 0 ? 0.08838834764831845f : 1.f); y0[r] *= rn; y1[r] *= rn; }
                }
                if (seg == 0) {
#pragma unroll
                    for (int r = 0; r < 8; ++r) { const int i = i0 + r; Qs[i * 68 + lane] = pack2(y0[r], y1[r]); const float eg = __expf(gc[i]);
                        *(unsigned*)(QD + i * 128 + c) = pack2(y0[r] * eg, y1[r] * eg); }
                } else if (seg == 1) {
                    float a0[8], a1[8], d0[8], d1[8];
#pragma unroll
                    for (int r = 0; r < 8; ++r) { const int i = i0 + r; Ks[i * 68 + lane] = pack2(y0[r], y1[r]); const float gi = gc[i], s1 = bt[i] * __expf(gi), s2 = __expf(glast - gi);
                        a0[r] = y0[r] * s1; a1[r] = y1[r] * s1; d0[r] = y0[r] * s2; d1[r] = y1[r] * s2; }
                    *(LAS u32x4*)(lds + GA_KBGT + (c * 72 + i0) * 2) = pack8(a0); *(LAS u32x4*)(lds + GA_KBGT + ((c + 1) * 72 + i0) * 2) = pack8(a1);
                    *(u32x4*)(KDT + c * 64 + i0) = pack8(d0); *(u32x4*)(KDT + (c + 1) * 64 + i0) = pack8(d1);
                } else {
                    float a0[8], a1[8];
#pragma unroll
                    for (int r = 0; r < 8; ++r) { const float be = bt[i0 + r]; a0[r] = y0[r] * be; a1[r] = y1[r] * be; }
                    *(LAS u32x4*)(lds + GA_VBT + (c * 72 + i0) * 2) = pack8(a0); *(LAS u32x4*)(lds + GA_VBT + ((c + 1) * 72 + i0) * 2) = pack8(a1);
                }
                __builtin_amdgcn_sched_barrier(0);
            }
        }
        lds_barrier();
        if (item + G < 2048) { GA_LOAD(item + G) }
        {
            const int ti = wid >> 1;
#pragma unroll
            for (int tjj = 0; tjj < 2; ++tjj) {
                const int tj = (wid & 1) * 2 + tjj;
                f32x4 ak = (f32x4){0.f, 0.f, 0.f, 0.f}, aq = (f32x4){0.f, 0.f, 0.f, 0.f};
                if (tj <= ti) {
#pragma unroll
                    for (int kk = 0; kk < 4; ++kk) {
                        const bf16x8 bk = *(const LAS bf16x8*)(lds + GA_KS + ((tj * 16 + fr) * 136 + kk * 32 + fq * 8) * 2);
                        const bf16x8 fk = *(const LAS bf16x8*)(lds + GA_KS + ((ti * 16 + fr) * 136 + kk * 32 + fq * 8) * 2);
                        const bf16x8 fqv = *(const LAS bf16x8*)(lds + GA_QS + ((ti * 16 + fr) * 136 + kk * 32 + fq * 8) * 2);
                        ak = mfma16(fk, bk, ak); aq = mfma16(fqv, bk, aq);
                    }
                }
                const int j = tj * 16 + fr; const float gj = gc[j];
#pragma unroll
                for (int r = 0; r < 4; ++r) { const int i = ti * 16 + fq * 4 + r; const float gi = gc[i];
                    const float e = (i >= j) ? __expf(gi - gj) : 0.f;
                    if (tj <= ti) Ms[i * 68 + j] = (i > j) ? bt[i] * ak[r] * e : 0.f;
                    QK[i * 64 + j] = (bf16_t)(pack2(aq[r] * e, 0.f) & 0xffffu); }
            }
        }
        lds_barrier();
        for (int ib = 0; ib < 4; ++ib) {
            if (ib > 0) {
                float p0 = 0.f, p1 = 0.f;
                const int ra = ib * 16 + 2 * wid;
                for (int j = 0; j < ib * 16; j += 4) {
                    const float t0 = Tl[j * 64 + lane], t1 = Tl[(j + 1) * 64 + lane], t2 = Tl[(j + 2) * 64 + lane], t3 = Tl[(j + 3) * 64 + lane];
                    const f32x4 m0 = *(const LAS f32x4*)(Ms + ra * 68 + j), m1 = *(const LAS f32x4*)(Ms + (ra + 1) * 68 + j);
                    p0 += (m0[0] * t0 + m0[1] * t1) + (m0[2] * t2 + m0[3] * t3);
                    p1 += (m1[0] * t0 + m1[1] * t1) + (m1[2] * t2 + m1[3] * t3);
                }
                Pb[(2 * wid) * 64 + lane] = p0; Pb[(2 * wid + 1) * 64 + lane] = p1;
                lds_barrier();
            }
            if (wid == 0) {
                float Tr[16];
#pragma unroll
                for (int r = 0; r < 16; ++r) {
                    float a = (ib > 0) ? -Pb[r * 64 + lane] : 0.f;
#pragma unroll
                    for (int q = 0; q < r; q += 4) {
                        const f32x4 m = *(const LAS f32x4*)(Ms + (ib * 16 + r) * 68 + ib * 16 + q);
                        a -= m[0] * Tr[q];
                        if (q + 1 < r) a -= m[1] * Tr[q + 1];
                        if (q + 2 < r) a -= m[2] * Tr[q + 2];
                        if (q + 3 < r) a -= m[3] * Tr[q + 3];
                    }
                    Tr[r] = a + ((lane == ib * 16 + r) ? 1.f : 0.f);
                    Tl[(ib * 16 + r) * 64 + lane] = Tr[r];
                    Ts[(ib * 16 + r) * 72 + lane] = (bf16_t)(pack2(Tr[r], 0.f) & 0xffffu);
                }
            }
            lds_barrier();
        }
        {
            const int td = wid;
            bf16x8 bv[2], bk[2];
#pragma unroll
            for (int kk = 0; kk < 2; ++kk) { bv[kk] = *(const LAS bf16x8*)(lds + GA_VBT + ((td * 16 + fr) * 72 + kk * 32 + fq * 8) * 2);
                bk[kk] = *(const LAS bf16x8*)(lds + GA_KBGT + ((td * 16 + fr) * 72 + kk * 32 + fq * 8) * 2); }
#pragma unroll
            for (int ti = 0; ti < 4; ++ti) {
                f32x4 au = (f32x4){0.f, 0.f, 0.f, 0.f}, aw = (f32x4){0.f, 0.f, 0.f, 0.f};
#pragma unroll
                for (int kk = 0; kk < 2; ++kk) { const bf16x8 ft = *(const LAS bf16x8*)(lds + GA_TS + ((ti * 16 + fr) * 72 + kk * 32 + fq * 8) * 2);
                    au = mfma16(ft, bv[kk], au);
                    aw = mfma16(bk[kk], ft, aw); }
                *(u32x2*)(UT + (td * 16 + fr) * 64 + ti * 16 + fq * 4) = pack4(au);
                *(u32x2*)(WN + (ti * 16 + fr) * 128 + td * 16 + fq * 4) = pack4(-aw);
            }
        }
        lds_barrier();
    }
#undef GA_LOAD
#undef GA_IDS
}

__device__ __forceinline__ void gdn_dec_item(LAS unsigned char* lds, const Args& A, int item, int tid_in) {
    const int tid = tid_in, wid = tid >> 6, lane = tid & 63;
    const int h = item & 7, b = item >> 3;
    const bf16_t* Pd = (const bf16_t*)(A.ws + WS_PROJD) + (size_t)b * NUP; const float* BAd = (const float*)(A.ws + WS_BAD) + b * 32;
    bf16_t* YBd = (bf16_t*)(A.ws + WS_YBD) + (size_t)b * DFF;
    LAS float* qs = (LAS float*)lds; LAS float* ks = qs + 128; LAS float* vs = qs + 256; LAS float* sc = qs + 384;
    LAS float* part = qs + 512;
    LAS float* os = qs + 512 + 1024;
    if (tid < 384) {
        const int seg = tid >> 7, d = tid & 127, col = seg * 1024 + h * 128 + d;
        const float* cin = A.in[2] + (size_t)b * 3 * 3072 + col;
        const float c0 = cin[0], c1 = cin[3072], c2 = cin[6144], nw = bf2f(Pd[col]);
        const float* cw = A.in[8] + col;
        const float y = A.in[9][col] + cw[0] * c0 + cw[3072] * c1 + cw[6144] * c2 + cw[9216] * nw;
        qs[tid] = silu_f(y);
        float* co = A.out + O_GCS + (size_t)b * 3 * 3072 + col; co[0] = c1; co[3072] = c2; co[6144] = nw;
    }
    __syncthreads();
    if (wid < 3) {
        const float q0 = qs[lane], q1 = qs[lane + 64], k0 = ks[lane], k1 = ks[lane + 64];
        const float v = (wid == 0) ? (q0 * q0 + q1 * q1) : (wid == 1) ? (k0 * k0 + k1 * k1) : (q0 * k0 + q1 * k1);
        const float s = wave_sum(v); if (lane == 0) sc[wid] = s;
    }
    __syncthreads();
    const float rq = __builtin_amdgcn_rsqf(sc[0] + 1e-6f) * 0.08838834764831845f, rk = __builtin_amdgcn_rsqf(sc[1] + 1e-6f), qk = sc[2] * rq * rk;
    const float g = -__expf(A.in[10][h]) * softplus_f(BAd[8 + h] + A.in[11][h]), eg = __expf(g), beta = sigmoid_f(BAd[h]);
    const int v = tid & 127, kg = tid >> 7;
    const float* Sin = A.in[3] + ((size_t)(b * 8 + h) * 128 + kg * 32) * 128 + v;
    float S[32]; float pk = 0.f, pq = 0.f;
#pragma unroll
    for (int k = 0; k < 32; ++k) S[k] = __builtin_nontemporal_load(Sin + k * 128);
#pragma unroll
    for (int k = 0; k < 32; ++k) { pk += ks[kg * 32 + k] * S[k]; pq += qs[kg * 32 + k] * S[k]; }
    part[kg * 128 + v] = pk * rk; part[512 + kg * 128 + v] = pq * rq;
    __syncthreads();
    const float kS = (part[v] + part[128 + v]) + (part[256 + v] + part[384 + v]);
    const float qS = (part[512 + v] + part[640 + v]) + (part[768 + v] + part[896 + v]);
    const float vnew = beta * (vs[v] - eg * kS);
    const float o = eg * qS + qk * vnew;
    float* Sout = A.out + O_GSS + ((size_t)(b * 8 + h) * 128 + kg * 32) * 128 + v;
#pragma unroll
    for (int k = 0; k < 32; ++k) __builtin_nontemporal_store(eg * S[k] + (ks[kg * 32 + k] * rk) * vnew, Sout + k * 128);
    if (kg == 0) os[v] = o;
    __syncthreads();
    if (wid == 0) {
        const float o0 = os[lane], o1 = os[lane + 64];
        const float rstd = __builtin_amdgcn_rsqf(wave_sum(o0 * o0 + o1 * o1) * (1.f / 128.f) + RMS_EPS);
        const float z0 = bf2f(Pd[3072 + h * 128 + lane]), z1 = bf2f(Pd[3072 + h * 128 + lane + 64]);
        const float r0 = o0 * rstd * A.in[12][lane] * silu_f(z0), r1 = o1 * rstd * A.in[12][lane + 64] * silu_f(z1);
        YBd[h * 128 + lane] = (bf16_t)(pack2(r0, 0.f) & 0xffffu); YBd[h * 128 + lane + 64] = (bf16_t)(pack2(r1, 0.f) & 0xffffu);
    }
    __syncthreads();
}

constexpr int GS_SB0 = 0, GS_SB1 = 8704, GS_VN = 17408;
__device__ __forceinline__ void gdn_scan_item(LAS unsigned char* lds, const Args& A, int item, int tid_in) {
    const int tid = tid_in, wid = tid >> 6, lane = tid & 63, fr = lane & 15, fq = lane >> 4;
    const int xcd = item & 7, slot = item >> 3, pair = xcd * 8 + (slot >> 2);
    const int vs = slot & 3, h = pair & 7, b = pair >> 3;
    const int ti = wid >> 1, tv = wid & 1;
    const bf16_t* UTb = (const bf16_t*)(A.ws + WS_UT); const bf16_t* WNb = (const bf16_t*)(A.ws + WS_WN);
    const bf16_t* QDb = (const bf16_t*)(A.ws + WS_QD); const bf16_t* KDTb = (const bf16_t*)(A.ws + WS_KDT);
    const bf16_t* QKb = (const bf16_t*)(A.ws + WS_QK); const float* EGL = (const float*)(A.ws + WS_EGL);
    float* O = (float*)(A.ws + WS_O);
    for (int e = tid; e < 8704 / 4; e += 512) ((LAS unsigned*)(lds + GS_SB0))[e] = 0u;
    f32x4 sacc[2]; sacc[0] = (f32x4){0.f, 0.f, 0.f, 0.f}; sacc[1] = sacc[0];
    __syncthreads();
    const int chunk0 = (b * 8 + h) * 32;
    bf16x8 nfw0[4], nfqd0[4], nfqk0[2], nfkd0[2]; u32x2 nuu0; float ndecay0;
    bf16x8 nfw1[4], nfqd1[4], nfqk1[2], nfkd1[2]; u32x2 nuu1; float ndecay1;
#define GS_LOAD(S, ch) { const size_t _c = (size_t)(ch); \
        _Pragma("unroll") for (int kk = 0; kk < 4; ++kk) { nfw##S[kk] = *(const bf16x8*)(WNb + _c * 8192 + (ti * 16 + fr) * 128 + kk * 32 + fq * 8); nfqd##S[kk] = *(const bf16x8*)(QDb + _c * 8192 + (ti * 16 + fr) * 128 + kk * 32 + fq * 8); } \
        _Pragma("unroll") for (int kk = 0; kk < 2; ++kk) { nfqk##S[kk] = *(const bf16x8*)(QKb + _c * 4096 + (ti * 16 + fr) * 64 + kk * 32 + fq * 8); nfkd##S[kk] = *(const bf16x8*)(KDTb + _c * 8192 + (wid * 16 + fr) * 64 + kk * 32 + fq * 8); } \
        nuu##S = *(const u32x2*)(UTb + _c * 8192 + (vs * 32 + tv * 16 + fr) * 64 + ti * 16 + fq * 4); ndecay##S = EGL[_c]; }
#define GS_STEP(S, nn, SBC, SBN, DOLOAD) { \
        bf16x8 fw[4], fqd[4], fqk[2], fkd[2]; \
        _Pragma("unroll") for (int kk = 0; kk < 4; ++kk) { fw[kk] = nfw##S[kk]; fqd[kk] = nfqd##S[kk]; } \
        _Pragma("unroll") for (int kk = 0; kk < 2; ++kk) { fqk[kk] = nfqk##S[kk]; fkd[kk] = nfkd##S[kk]; } \
        const u32x2 uu = nuu##S; const float decay = ndecay##S; \
        if (DOLOAD) { GS_LOAD(S, chunk0 + (nn) + 2) } \
        f32x4 acc = (f32x4){lo_f(uu.x), hi_f(uu.x), lo_f(uu.y), hi_f(uu.y)}; \
        bf16x8 fs[4]; \
        _Pragma("unroll") for (int kk = 0; kk < 4; ++kk) { fs[kk] = *(const LAS bf16x8*)(lds + (SBC) + ((tv * 16 + fr) * 136 + kk * 32 + fq * 8) * 2); acc = mfma16(fw[kk], fs[kk], acc); } \
        *(LAS u32x2*)(lds + GS_VN + ((tv * 16 + fr) * 72 + ti * 16 + fq * 4) * 2) = pack4(acc); \
        lds_barrier(); \
        f32x4 ao = (f32x4){0.f, 0.f, 0.f, 0.f}; \
        _Pragma("unroll") for (int kk = 0; kk < 4; ++kk) ao = mfma16(fs[kk], fqd[kk], ao); \
        bf16x8 fv[2][2]; \
        _Pragma("unroll") for (int t2 = 0; t2 < 2; ++t2) _Pragma("unroll") for (int kk = 0; kk < 2; ++kk) fv[t2][kk] = *(const LAS bf16x8*)(lds + GS_VN + ((t2 * 16 + fr) * 72 + kk * 32 + fq * 8) * 2); \
        _Pragma("unroll") for (int kk = 0; kk < 2; ++kk) { const bf16x8 fvo = *(const LAS bf16x8*)(lds + GS_VN + ((tv * 16 + fr) * 72 + kk * 32 + fq * 8) * 2); ao = mfma16(fvo, fqk[kk], ao); } \
        *(f32x4*)(O + ((size_t)b * SL + (nn) * 64 + ti * 16 + fr) * 1024 + h * 128 + vs * 32 + tv * 16 + fq * 4) = ao; \
        _Pragma("unroll") for (int t2 = 0; t2 < 2; ++t2) { sacc[t2] = sacc[t2] * decay; \
            _Pragma("unroll") for (int kk = 0; kk < 2; ++kk) sacc[t2] = mfma16(fkd[kk], fv[t2][kk], sacc[t2]); \
            *(LAS u32x2*)(lds + (SBN) + ((t2 * 16 + fr) * 136 + wid * 16 + fq * 4) * 2) = pack4(sacc[t2]); } \
        lds_barrier(); }
    GS_LOAD(0, chunk0) GS_LOAD(1, chunk0 + 1)
    for (int n = 0; n < 32; n += 8) {
        __builtin_amdgcn_s_waitcnt(0x0F70);
        GS_STEP(0, n, GS_SB0, GS_SB1, 1) GS_STEP(1, n + 1, GS_SB1, GS_SB0, 1) GS_STEP(0, n + 2, GS_SB0, GS_SB1, 1) GS_STEP(1, n + 3, GS_SB1, GS_SB0, 1)
        GS_STEP(0, n + 4, GS_SB0, GS_SB1, 1) GS_STEP(1, n + 5, GS_SB1, GS_SB0, 1) GS_STEP(0, n + 6, GS_SB0, GS_SB1, (n + 8 < 32)) GS_STEP(1, n + 7, GS_SB1, GS_SB0, (n + 9 < 32))
    }
#undef GS_STEP
#undef GS_LOAD
    float* So = A.out + O_GSP + (size_t)(b * 8 + h) * 16384;
#pragma unroll
    for (int t2 = 0; t2 < 2; ++t2)
#pragma unroll
        for (int r = 0; r < 4; ++r) So[(wid * 16 + fq * 4 + r) * 128 + vs * 32 + t2 * 16 + fr] = sacc[t2][r];
    __syncthreads();
}

__device__ __forceinline__ void gdn_gate_row(const Args& A, size_t row, int lane) {
    const float* O = (const float*)(A.ws + WS_O) + row * 1024 + lane * 16;
    const bf16_t* Z = (const bf16_t*)(A.ws + WS_PROJ) + row * 4096 + 3072 + lane * 16;
    bf16_t* Y = (bf16_t*)(A.ws + WS_YB) + row * 1024 + lane * 16;
    const float* nw = A.in[12] + (lane & 7) * 16;
    float o[16]; float ss = 0.f;
#pragma unroll
    for (int i = 0; i < 4; ++i) { const f32x4 v = ((const f32x4*)O)[i]; o[4 * i] = v[0]; o[4 * i + 1] = v[1]; o[4 * i + 2] = v[2]; o[4 * i + 3] = v[3]; ss += (v[0] * v[0] + v[1] * v[1]) + (v[2] * v[2] + v[3] * v[3]); }
    ss += __shfl_xor(ss, 1); ss += __shfl_xor(ss, 2); ss += __shfl_xor(ss, 4);
    const float rstd = __builtin_amdgcn_rsqf(ss * (1.f / 128.f) + RMS_EPS);
    float z[16]; { float t[8]; unpack8(((const u32x4*)Z)[0], t);
#pragma unroll
        for (int j = 0; j < 8; ++j) z[j] = t[j];
        unpack8(((const u32x4*)Z)[1], t);
#pragma unroll
        for (int j = 0; j < 8; ++j) z[8 + j] = t[j]; }
    float r[8];
#pragma unroll
    for (int hh = 0; hh < 2; ++hh) {
#pragma unroll
        for (int j = 0; j < 8; ++j) r[j] = o[hh * 8 + j] * rstd * nw[hh * 8 + j] * silu_f(z[hh * 8 + j]);
        ((u32x4*)Y)[hh] = pack8(r);
    }
}
__device__ __forceinline__ void gdn_gate_row2(const Args& A, size_t row, int lane) {
    const float* O = (const float*)(A.ws + WS_O) + row * 1024 + lane * 16;
    const bf16_t* Z = (const bf16_t*)(A.ws + WS_PROJ) + row * 4096 + 3072 + lane * 16;
    bf16_t* Y = (bf16_t*)(A.ws + WS_YB) + row * 1024 + lane * 16;
    const float* nw = A.in[12] + (lane & 7) * 16;
    f32x4 ov[2][4]; u32x4 zv[2][2];
#pragma unroll
    for (int rr = 0; rr < 2; ++rr) {
#pragma unroll
        for (int i = 0; i < 4; ++i) ov[rr][i] = ((const f32x4*)(O + rr * 1024))[i];
        zv[rr][0] = ((const u32x4*)(Z + rr * 4096))[0]; zv[rr][1] = ((const u32x4*)(Z + rr * 4096))[1];
    }
#pragma unroll
    for (int rr = 0; rr < 2; ++rr) {
        float ss = 0.f;
#pragma unroll
        for (int i = 0; i < 4; ++i) ss += (ov[rr][i][0] * ov[rr][i][0] + ov[rr][i][1] * ov[rr][i][1]) + (ov[rr][i][2] * ov[rr][i][2] + ov[rr][i][3] * ov[rr][i][3]);
        ss += __shfl_xor(ss, 1); ss += __shfl_xor(ss, 2); ss += __shfl_xor(ss, 4);
        const float rstd = __builtin_amdgcn_rsqf(ss * (1.f / 128.f) + RMS_EPS);
#pragma unroll
        for (int hh = 0; hh < 2; ++hh) { float z[8], r[8]; unpack8(zv[rr][hh], z);
#pragma unroll
            for (int j = 0; j < 8; ++j) r[j] = ov[rr][hh * 2 + (j >> 2)][j & 3] * rstd * nw[hh * 8 + j] * silu_f(z[j]);
            ((u32x4*)(Y + rr * 1024))[hh] = pack8(r); }
    }
}

__device__ __forceinline__ void ssd_conv_item(const Args& A, int item, int tid_in) {
    const int t = tid_in; if (t >= 384) return;
    const int c0 = t * 8, r0 = item * 16, tb = r0 & (SL - 1), b = r0 >> 11;
    const bf16_t* P = (const bf16_t*)(A.ws + WS_PROJ);
    bf16_t* XA = (bf16_t*)(A.ws + WS_XA); bf16_t* BCA = (bf16_t*)(A.ws + WS_BCA);
    u32x4 xq[19];
#pragma unroll
    for (int r = 0; r < 19; ++r) xq[r] = (tb == 0 && r < 3) ? (u32x4){0u, 0u, 0u, 0u} : *(const u32x4*)(P + (size_t)(r0 + r - 3) * 5120 + 2048 + c0);
    float w[4][8], bb[8];
#pragma unroll
    for (int j = 0; j < 8; ++j) { bb[j] = A.in[16][c0 + j];
#pragma unroll
        for (int k = 0; k < 4; ++k) w[k][j] = A.in[15][k * 3072 + c0 + j]; }
    float p3[8], p2[8], p1[8];
    unpack8(xq[0], p3); unpack8(xq[1], p2); unpack8(xq[2], p1);
#pragma unroll
    for (int r = 0; r < 16; ++r) {
        const size_t row = (size_t)(r0 + r);
        float cur[8], o[8];
        unpack8(xq[r + 3], cur);
#pragma unroll
        for (int j = 0; j < 8; ++j) o[j] = silu_f(bb[j] + w[0][j] * p3[j] + w[1][j] * p2[j] + w[2][j] * p1[j] + w[3][j] * cur[j]);
        if (c0 < 2048) *(u32x4*)(XA + row * 2048 + c0) = pack8(o); else *(u32x4*)(BCA + row * 1024 + (c0 - 2048)) = pack8(o);
        const int tt = tb + r;
        if (tt >= SL - 3) { float* cp = A.out + O_SCP + ((size_t)b * 3 + (tt - (SL - 3))) * 3072 + c0;
#pragma unroll
            for (int j = 0; j < 8; ++j) cp[j] = cur[j]; }
#pragma unroll
        for (int j = 0; j < 8; ++j) { p3[j] = p2[j]; p2[j] = p1[j]; p1[j] = cur[j]; }
    }
}

__device__ __forceinline__ void ssd_dec_item(LAS unsigned char* lds, const Args& A, int item, int tid_in) {
    const int tid = tid_in, wid = tid >> 6, lane = tid & 63;
    const int g = item & 3, b = item >> 2;
    const bf16_t* Pd = (const bf16_t*)(A.ws + WS_PROJD) + (size_t)b * NUP; const float* BAd = (const float*)(A.ws + WS_BAD) + b * 32;
    bf16_t* YBd = (bf16_t*)(A.ws + WS_YBD) + (size_t)b * DFF;
    LAS float* xs = (LAS float*)lds; LAS float* Bs = xs + 512; LAS float* Cs = xs + 640; LAS float* ys = xs + 768; LAS float* dts = xs + 1280; LAS float* dAs = xs + 1288; LAS float* red = xs + 1296;
    for (int c = tid; c < 768; c += 512) {
        const int xc = (c < 512) ? (g * 512 + c) : (c < 640) ? (2048 + g * 128 + (c - 512)) : (2560 + g * 128 + (c - 640));
        const float* cin = A.in[(4)] + (size_t)b * 3 * 3072 + xc;
        const float c0 = cin[0], c1 = cin[3072], c2 = cin[6144], nw = bf2f(Pd[2048 + xc]);
        const float* cw = A.in[(15)] + xc;
        xs[c] = silu_f(A.in[(16)][xc] + cw[0] * c0 + cw[3072] * c1 + cw[6144] * c2 + cw[9216] * nw);
        float* co = A.out + O_SCS + (size_t)b * 3 * 3072 + xc; co[0] = c1; co[3072] = c2; co[6144] = nw;
    }
    if (tid < 8) { const int h = g * 8 + tid; const float dt = softplus_f(BAd[h] + A.in[(18)][h]); dts[tid] = dt; dAs[tid] = __expf(-__expf(A.in[(17)][h]) * dt); }
    __syncthreads();
    const int sl = tid & 31, pr = tid >> 5;
    const f32x4 B4 = *(const LAS f32x4*)(Bs + sl * 4), C4 = *(const LAS f32x4*)(Cs + sl * 4);
    const float* Sin0 = A.in[(5)] + ((size_t)(b * 32 + g * 8) * 64) * 128 + sl * 4;
    float* Sout0 = A.out + O_SSS + ((size_t)(b * 32 + g * 8) * 64) * 128 + sl * 4;
    f32x4 Snx[4];
#pragma unroll
    for (int it = 0; it < 4; ++it) Snx[it] = __builtin_nontemporal_load((const f32x4*)(Sin0 + (it * 16 + pr) * 128));
#pragma unroll
    for (int j = 0; j < 8; ++j) {
        const float dt = dts[j], dA = dAs[j];
        f32x4 S[4];
#pragma unroll
        for (int it = 0; it < 4; ++it) S[it] = Snx[it];
        if (j + 1 < 8) {
#pragma unroll
            for (int it = 0; it < 4; ++it) Snx[it] = __builtin_nontemporal_load((const f32x4*)(Sin0 + (size_t)(j + 1) * 8192 + (it * 16 + pr) * 128));
        }
#pragma unroll
        for (int it = 0; it < 4; ++it) { const int p = it * 16 + pr; const float xd = xs[j * 64 + p] * dt;
            const f32x4 Sn = S[it] * dA + B4 * xd; __builtin_nontemporal_store(Sn, (f32x4*)(Sout0 + (size_t)j * 8192 + p * 128));
            float y = (Sn[0] * C4[0] + Sn[1] * C4[1]) + (Sn[2] * C4[2] + Sn[3] * C4[3]);
            y += DPP_F(y, 0xB1, 0xf); y += DPP_F(y, 0x4E, 0xf); y += DPP_F(y, 0x141, 0xf); y += DPP_F(y, 0x140, 0xf); y += DPP_F(y, 0x142, 0xa);
            if (sl == 31) ys[j * 64 + p] = y; }
    }
    __syncthreads();
    {
        const int c = tid, h = g * 8 + (c >> 6);
        const float y = (ys[c] + A.in[(19)][h] * xs[c]) * silu_f(bf2f(Pd[g * 512 + c]));
        const float s = wave_sum(y * y); if (lane == 0) red[wid] = s;
        __syncthreads();
        float tot = 0.f;
#pragma unroll
        for (int w = 0; w < 8; ++w) tot += red[w];
        const float r = y * __builtin_amdgcn_rsqf(tot * (1.f / 512.f) + RMS_EPS) * A.in[(20)][g * 512 + c];
        YBd[g * 512 + c] = (bf16_t)(pack2(r, 0.f) & 0xffffu);
    }
    __syncthreads();
}

constexpr int SS_XT = 0, SS_XDT = 9216, SS_BT = 18432, SS_SC = 36864, SS_SB0 = 46080, SS_SB1 = 63488, SS_BS = 80896, SS_CS = 98304, SS_AC = 115712, SS_DT = 115968;
__device__ __forceinline__ void ssd_step(LAS unsigned char* lds, bf16_t* __restrict__ Y, const size_t t0, const int h, const int sbc, const int sbn,
                                         const u32x4 px, const u32x4 pb0, const u32x4 pb1, const u32x4 pc0, const u32x4 pc1, const float pdt,
                                         const float aneg, const float dtb, const float Dh, f32x4 (&sacc)[4], const int tid) {
    const int wid = tid >> 6, lane = tid & 63, fr = lane & 15, fq = lane >> 4, ti = wid >> 1;
    const int jx = tid >> 3, xm = tid & 7, jb0 = tid >> 4, jb1 = 32 + (tid >> 4), bm = tid & 15;
    LAS float* acum = (LAS float*)(lds + SS_AC); LAS float* dtv = (LAS float*)(lds + SS_DT);
        if (wid == 0) { const float dt = softplus_f(pdt + dtb); const float ac = wave_incl_scan(dt * aneg, lane); acum[lane] = ac; dtv[lane] = dt; }
        *(LAS u32x4*)(lds + SS_BS + (jb0 * 136 + bm * 8) * 2) = pb0; *(LAS u32x4*)(lds + SS_BS + (jb1 * 136 + bm * 8) * 2) = pb1;
        *(LAS u32x4*)(lds + SS_CS + (jb0 * 136 + bm * 8) * 2) = pc0; *(LAS u32x4*)(lds + SS_CS + (jb1 * 136 + bm * 8) * 2) = pc1;
        lds_barrier();
        const float alast = acum[63];
        {
            const float sx = dtv[jx] * __expf(alast - acum[jx]);
            const int colx = (((jx >> 3) ^ xm) * 8 + (jx & 7)) * 2;
            const unsigned wx[4] = {px.x, px.y, px.z, px.w};
#pragma unroll
            for (int q = 0; q < 8; ++q) { const unsigned w = wx[q >> 1]; const unsigned short raw = (q & 1) ? (unsigned short)(w >> 16) : (unsigned short)(w & 0xffffu);
                const float xv = bf2f(raw); const int rowb = (xm * 8 + q) * 144;
                *(LAS unsigned short*)(lds + SS_XT + rowb + colx) = raw;
                *(LAS unsigned short*)(lds + SS_XDT + rowb + colx) = (unsigned short)(pack2(xv * sx, 0.f) & 0xffffu); }
            const int colb0 = (((jb0 >> 3) ^ (bm & 7)) * 8 + (jb0 & 7)) * 2, colb1 = (((jb1 >> 3) ^ (bm & 7)) * 8 + (jb1 & 7)) * 2;
            const unsigned wb0[4] = {pb0.x, pb0.y, pb0.z, pb0.w}, wb1[4] = {pb1.x, pb1.y, pb1.z, pb1.w};
#pragma unroll
            for (int q = 0; q < 8; ++q) { const int rowb = (bm * 8 + q) * 144;
                *(LAS unsigned short*)(lds + SS_BT + rowb + colb0) = (q & 1) ? (unsigned short)(wb0[q >> 1] >> 16) : (unsigned short)(wb0[q >> 1] & 0xffffu);
                *(LAS unsigned short*)(lds + SS_BT + rowb + colb1) = (q & 1) ? (unsigned short)(wb1[q >> 1] >> 16) : (unsigned short)(wb1[q >> 1] & 0xffffu); }
        }
        bf16x8 fc[4];
#pragma unroll
        for (int kk = 0; kk < 4; ++kk) fc[kk] = *(const LAS bf16x8*)(lds + SS_CS + ((ti * 16 + fr) * 136 + kk * 32 + fq * 8) * 2);
#pragma unroll
        for (int tjj = 0; tjj < 2; ++tjj) {
            const int tj = (wid & 1) * 2 + tjj;
            f32x4 acc = (f32x4){0.f, 0.f, 0.f, 0.f};
            if (tj <= ti) {
#pragma unroll
                for (int kk = 0; kk < 4; ++kk) { const bf16x8 fb = *(const LAS bf16x8*)(lds + SS_BS + ((tj * 16 + fr) * 136 + kk * 32 + fq * 8) * 2); acc = mfma16(fb, fc[kk], acc); }
            }
            const int i = ti * 16 + fr; const float ai = acum[i]; f32x4 sc;
#pragma unroll
            for (int r = 0; r < 4; ++r) { const int j = tj * 16 + fq * 4 + r; sc[r] = (i >= j) ? acc[r] * __expf(ai - acum[j]) * dtv[j] : 0.f; }
            *(LAS u32x2*)(lds + SS_SC + (i * 72 + tj * 16 + fq * 4) * 2) = pack4(sc);
        }
        lds_barrier();
        {
            bf16x8 fsc[2];
#pragma unroll
            for (int kk = 0; kk < 2; ++kk) fsc[kk] = *(const LAS bf16x8*)(lds + SS_SC + ((ti * 16 + fr) * 72 + kk * 32 + fq * 8) * 2);
            const int i = ti * 16 + fr; const float ea = __expf(acum[i]);
#pragma unroll
            for (int tpp = 0; tpp < 2; ++tpp) {
                const int tp = (wid & 1) * 2 + tpp, prow = tp * 16 + fr, psw = (prow >> 3) & 7;
                f32x4 a1 = (f32x4){0.f, 0.f, 0.f, 0.f}, a2 = (f32x4){0.f, 0.f, 0.f, 0.f};
#pragma unroll
                for (int kk = 0; kk < 2; ++kk) { const bf16x8 fx = *(const LAS bf16x8*)(lds + SS_XT + (prow * 72 + (((kk * 4 + fq) ^ psw) * 8)) * 2); a1 = mfma16(fx, fsc[kk], a1); }
#pragma unroll
                for (int kk = 0; kk < 4; ++kk) { const bf16x8 fs = *(const LAS bf16x8*)(lds + sbc + (prow * 136 + kk * 32 + fq * 8) * 2); a2 = mfma16(fs, fc[kk], a2); }
                const int p0 = tp * 16 + fq * 4;
                const int xcol = (((i >> 3) ^ ((p0 >> 3) & 7)) * 8 + (i & 7)) * 2;
                f32x4 y = a1 + a2 * ea;
#pragma unroll
                for (int r = 0; r < 4; ++r) y[r] += Dh * bf2f(*(const LAS unsigned short*)(lds + SS_XT + (p0 + r) * 144 + xcol));
                *(u32x2*)(Y + (t0 + i) * 2048 + h * 64 + p0) = pack4(y);
            }
        }
        {
            const int tp = wid >> 1, prow = tp * 16 + fr, psw = (prow >> 3) & 7; const float el = __expf(alast);
            bf16x8 fxd[2];
#pragma unroll
            for (int kk = 0; kk < 2; ++kk) fxd[kk] = *(const LAS bf16x8*)(lds + SS_XDT + (prow * 72 + (((kk * 4 + fq) ^ psw) * 8)) * 2);
#pragma unroll
            for (int q = 0; q < 4; ++q) { const int ts = (wid & 1) * 4 + q, srow = ts * 16 + fr, ssw = (srow >> 3) & 7; sacc[q] = sacc[q] * el;
#pragma unroll
                for (int kk = 0; kk < 2; ++kk) { const bf16x8 fb = *(const LAS bf16x8*)(lds + SS_BT + (srow * 72 + (((kk * 4 + fq) ^ ssw) * 8)) * 2); sacc[q] = mfma16(fb, fxd[kk], sacc[q]); }
                *(LAS u32x2*)(lds + sbn + (prow * 136 + ts * 16 + fq * 4) * 2) = pack4(sacc[q]); }
        }
        lds_barrier();
}

__device__ __forceinline__ void ssd_scan_item(LAS unsigned char* lds, const Args& A, int item, int tid_in) {
    const int tid = tid_in, wid = tid >> 6, lane = tid & 63, fr = lane & 15, fq = lane >> 4;
    const int xcd = item & 7, slot = item >> 3, grp = xcd * 4 + (slot >> 3);
    const int b = grp >> 2, g = grp & 3, h = g * 8 + (slot & 7);
    const bf16_t* XA = (const bf16_t*)(A.ws + WS_XA); const bf16_t* BCA = (const bf16_t*)(A.ws + WS_BCA); const float* BA = (const float*)(A.ws + WS_BA);
    bf16_t* Y = (bf16_t*)(A.ws + WS_YB);
    LAS float* acum = (LAS float*)(lds + SS_AC); LAS float* dtv = (LAS float*)(lds + SS_DT);
    const float aneg = -__expf(A.in[17][h]), dtb = A.in[18][h], Dh = A.in[19][h];
    for (int e = tid; e < 17408 / 4; e += 512) ((LAS unsigned*)(lds + SS_SB0))[e] = 0u;
    f32x4 sacc[4];
#pragma unroll
    for (int q = 0; q < 4; ++q) sacc[q] = (f32x4){0.f, 0.f, 0.f, 0.f};
    int cur = 0;
    const int ti = wid >> 1;
    const int jx = tid >> 3, xm = tid & 7;
    const int jb0 = tid >> 4, jb1 = 32 + (tid >> 4), bm = tid & 15;
    u32x4 npx0, npb00, npb10, npc00, npc10; float npdt0 = 0.f;
    u32x4 npx1, npb01, npb11, npc01, npc11; float npdt1 = 0.f;
#define SS_LOAD(S, nn) { const size_t _t0 = (size_t)b * SL + (nn) * 64; \
        npx##S = *(const u32x4*)(XA + (_t0 + jx) * 2048 + h * 64 + xm * 8); \
        npb0##S = *(const u32x4*)(BCA + (_t0 + jb0) * 1024 + g * 128 + bm * 8); npb1##S = *(const u32x4*)(BCA + (_t0 + jb1) * 1024 + g * 128 + bm * 8); \
        npc0##S = *(const u32x4*)(BCA + (_t0 + jb0) * 1024 + 512 + g * 128 + bm * 8); npc1##S = *(const u32x4*)(BCA + (_t0 + jb1) * 1024 + 512 + g * 128 + bm * 8); \
        if (wid == 0) npdt##S = BA[(_t0 + lane) * 32 + h]; }
#define SS_STEP(S, nn, DOLOAD) { \
        const size_t t0 = (size_t)b * SL + (nn) * 64; \
        const int sbc = cur ? SS_SB1 : SS_SB0, sbn = cur ? SS_SB0 : SS_SB1; \
        const u32x4 px = npx##S, pb0 = npb0##S, pb1 = npb1##S, pc0 = npc0##S, pc1 = npc1##S; const float pdt = npdt##S; \
        if (DOLOAD) { SS_LOAD(S, (nn) + 2) } \
        ssd_step(lds, Y, t0, h, sbc, sbn, px, pb0, pb1, pc0, pc1, pdt, aneg, dtb, Dh, sacc, tid); \
        cur ^= 1; }
    SS_LOAD(0, 0) SS_LOAD(1, 1)
    __syncthreads();
    for (int n = 0; n < 28; n += 4) {
        __builtin_amdgcn_s_waitcnt(0x0F70);
        SS_STEP(0, n, 1) SS_STEP(1, n + 1, 1) SS_STEP(0, n + 2, 1) SS_STEP(1, n + 3, 1)
    }
    __builtin_amdgcn_s_waitcnt(0x0F70);
    SS_STEP(0, 28, 1) SS_STEP(1, 29, 1) SS_STEP(0, 30, 0) SS_STEP(1, 31, 0)
#undef SS_STEP
#undef SS_LOAD
    {
        const int tp = wid >> 1; float* So = A.out + O_SSP + (size_t)(b * 32 + h) * 8192;
#pragma unroll
        for (int q = 0; q < 4; ++q) { const int ts = (wid & 1) * 4 + q; *(f32x4*)(So + (tp * 16 + fr) * 128 + ts * 16 + fq * 4) = sacc[q]; }
    }
    __syncthreads();
}

__device__ __forceinline__ void ssd_gate_row(const Args& A, size_t row, int lane) {
    bf16_t* Y = (bf16_t*)(A.ws + WS_YB) + row * 2048; const bf16_t* Z = (const bf16_t*)(A.ws + WS_PROJ) + row * 5120;
    u32x4 yq[4], zq[4];
#pragma unroll
    for (int g = 0; g < 4; ++g) { yq[g] = *(const u32x4*)(Y + g * 512 + lane * 8); zq[g] = *(const u32x4*)(Z + g * 512 + lane * 8); }
#pragma unroll
    for (int g = 0; g < 4; ++g) {
        const int c0 = g * 512 + lane * 8; float y[8], z[8];
        unpack8(yq[g], y); unpack8(zq[g], z);
        float ss = 0.f;
#pragma unroll
        for (int j = 0; j < 8; ++j) { y[j] *= silu_f(z[j]); ss += y[j] * y[j]; }
        const float rstd = __builtin_amdgcn_rsqf(wave_sum(ss) * (1.f / 512.f) + RMS_EPS);
        const float* nw = A.in[20] + c0;
#pragma unroll
        for (int j = 0; j < 8; ++j) y[j] = y[j] * rstd * nw[j];
        *(u32x4*)(Y + c0) = pack8(y);
    }
}


__constant__ int P0_BASE[8] = {0, 544, 672, 1344, 1600, 2304, 3008, 3360};
__constant__ int P0_IN[8] = {7, 13, 14, 21, 22, 22, 25, 25};
__constant__ unsigned P0_INOFF[8] = {0, 0, 0, 0, 0, 1024u * 5632u, 0, 2816u * 1024u};
__constant__ unsigned P0_WOFS[8] = {(unsigned)WS_WGI, (unsigned)WS_WGO, (unsigned)WS_WSI, (unsigned)WS_WSO, (unsigned)WS_WUP0, (unsigned)WS_WUP1, (unsigned)WS_WDN0, (unsigned)WS_WDN1};
__constant__ int P0_K[8] = {1024, 1024, 1024, 2048, 1024, 1024, 2816, 2816};
__constant__ int P0_N[8] = {4112, 1024, 5152, 1024, 5632, 5632, 1024, 1024};

#define XB_TMO      128
#define XB_XCNT(j)  (256  + 64 * (j))
#define XB_XSUB(j)  (1280 + 64 * (j))
#define XB_XGEN(j)  (2304 + 64 * (j))
#define XB_TOP      3328
#define XB_TOPGEN   3392
#define XCD_BAR_WORDS 3456
#define XB_SPIN_CAP (1u << 18)
__device__ __forceinline__ unsigned xb_ld(unsigned* p)              { return __hip_atomic_load(p, __ATOMIC_RELAXED, __HIP_MEMORY_SCOPE_AGENT); }
__device__ __forceinline__ unsigned xb_add(unsigned* p, unsigned v) { return __hip_atomic_fetch_add(p, v, __ATOMIC_RELAXED, __HIP_MEMORY_SCOPE_AGENT); }
__device__ __forceinline__ unsigned xb_xcc_id() { return (unsigned)__builtin_amdgcn_s_getreg((3 << 11) | 20) & 0xFu; }
#define XB_SPIN(cond, bar) do { unsigned _sp = 0; while (cond) { __builtin_amdgcn_s_sleep(1); \
    if ((++_sp & 255u) == 0u) { if (xb_ld(&(bar)[XB_TMO])) break; if (_sp > XB_SPIN_CAP) { atomicAdd(&(bar)[XB_TMO], 1u); break; } } } } while (0)
struct XcdBarrier { unsigned* bar; unsigned x; volatile LAS unsigned* st; };
__device__ __forceinline__ XcdBarrier xcd_barrier_post(unsigned* bar, volatile LAS unsigned* st) {
    XcdBarrier b; b.bar = bar; b.x = xb_xcc_id(); b.st = st;
    if (threadIdx.x == 0) (void)xb_add(&bar[XB_XCNT(b.x)], 1u);
    return b;
}
__device__ __forceinline__ void xcd_barrier_complete(unsigned* bar, unsigned x, unsigned& nloc, unsigned& nx) {
    const unsigned G = gridDim.x * gridDim.y * gridDim.z;
    unsigned sum, cnt, mine, sp = 0u;
    for (;;) {
        sum = 0u; cnt = 0u; mine = 0u;
#pragma unroll
        for (unsigned j = 0; j < 16; ++j) { const unsigned c = xb_ld(&bar[XB_XCNT(j)]); sum += c; cnt += (c > 0u) ? 1u : 0u; mine = (j == x) ? c : mine; }
        if (sum == G) break;
        __builtin_amdgcn_s_sleep(1);
        if ((++sp & 255u) == 0u) { if (xb_ld(&bar[XB_TMO])) break; if (sp > XB_SPIN_CAP) { atomicAdd(&bar[XB_TMO], 1u); break; } }
    }
    nloc = mine > 0u ? mine : 1u; nx = cnt > 0u ? cnt : 1u;
}
__device__ __forceinline__ void xcd_barrier(const XcdBarrier& b, int tid) {
    asm volatile("s_waitcnt vmcnt(0)" ::: "memory");
    __syncthreads();
    if (tid == 0) {
        unsigned* bar = b.bar;
        __builtin_amdgcn_s_waitcnt(0);
        unsigned nloc = b.st[0], nx = b.st[1];
        if (nloc == 0u) { xcd_barrier_complete(bar, b.x, nloc, nx); b.st[0] = nloc; b.st[1] = nx; }
        const unsigned old = xb_add(&bar[XB_XSUB(b.x)], 1u);
        const unsigned gen = old / nloc;
        if (old + 1u == (gen + 1u) * nloc) {
            __builtin_amdgcn_fence(__ATOMIC_RELEASE, "agent");
            asm volatile("s_waitcnt vmcnt(0)" ::: "memory");
            const unsigned og = xb_add(&bar[XB_TOP], 1u);
            const unsigned tg = og / nx;
            if (og + 1u == (tg + 1u) * nx) xb_add(&bar[XB_TOPGEN], 1u);
            else XB_SPIN(xb_ld(&bar[XB_TOPGEN]) == tg, bar);
            __builtin_amdgcn_fence(__ATOMIC_ACQUIRE, "agent");
            xb_add(&bar[XB_XGEN(b.x)], 1u);
            asm volatile("s_waitcnt vmcnt(0)" ::: "memory");
        } else {
            XB_SPIN(xb_ld(&bar[XB_XGEN(b.x)]) == gen, bar);
            __builtin_amdgcn_fence(__ATOMIC_ACQUIRE, "agent");
            asm volatile("s_waitcnt vmcnt(0)" ::: "memory");
        }
    }
    __syncthreads();
}

#ifndef PHMASK
#define PHMASK 0xffffff
#endif
#define EN(k) ((PHMASK >> (k)) & 1)
constexpr int NPHASE = 21;
__global__ void __launch_bounds__(512, 2) fwd_kernel(Args A) {
    __shared__ __attribute__((aligned(16))) unsigned char lds_raw[LDS_BYTES];
    LAS unsigned char* lds = (LAS unsigned char*)lds_raw;
    const int wave_s = __builtin_amdgcn_readfirstlane((int)threadIdx.x >> 6);
#define TID make_tid(wave_s)
    if (threadIdx.x < 4) ((LAS unsigned*)(lds + 131072))[threadIdx.x] = 0u;
    __syncthreads();
    (void)xcd_barrier_post((unsigned*)(A.ws + WS_BARR), (volatile LAS unsigned*)(lds + 131072));
    if (A.ph_hi > NPHASE) cg::this_grid().sync();
#ifndef REPMASK
#define REPMASK 0
#endif
    const int ph_end = __builtin_amdgcn_readfirstlane(A.ph_hi);
    int rep_done = 0;
    for (int ph = __builtin_amdgcn_readfirstlane(A.ph_lo); ph < ph_end; ) {
        {
        int G = gridDim.x, bid = blockIdx.x; asm volatile("" : "+s"(G), "+s"(bid));
        unsigned long long zoff = 0; asm volatile("" : "+s"(zoff));
        unsigned char* ws = A.ws + zoff;
        const bool is_gemm = (ph == 1) | (ph == 5) | (ph == 7) | (ph == 9) | (ph == 11) | (ph == 15) | (ph == 17) | (ph == 19);
        const bool is_ln = (ph == 6) | (ph == 10) | (ph == 16) | (ph == 20);
        if (EN(1) && is_gemm) {
            const bf16_t* Ap = (const bf16_t*)(ws + WS_XB); const bf16_t* Ad = (const bf16_t*)(ws + WS_XBD); int ldad = 1024;
            size_t wofs = WS_WGI, oofs = WS_PROJ, dofs = WS_PROJD; int N = 4096, K = 1024, ldo = 4096, nbf = 4096, nf = 16, ncg = 65, ldp = NUP;
            if (ph == 5) { Ap = (const bf16_t*)(ws + WS_YB); Ad = (const bf16_t*)(ws + WS_YBD); ldad = DFF; wofs = WS_WGO; N = 1024; K = 1024; }
            else if (ph == 7 || ph == 17) { wofs = (ph == 7) ? WS_WUP0 : WS_WUP1; N = NUP; K = 1024; ldo = NUP; nbf = NUP; nf = 0; ncg = 88; }
            else if (ph == 9 || ph == 19) { Ap = (const bf16_t*)(ws + WS_YB); Ad = (const bf16_t*)(ws + WS_YBD); ldad = DFF; wofs = (ph == 9) ? WS_WDN0 : WS_WDN1; N = 1024; K = DFF; }
            else if (ph == 11) { wofs = WS_WSI; N = 5120; K = 1024; ldo = 5120; nbf = 5120; nf = 32; ncg = 81; }
            else if (ph == 15) { Ap = (const bf16_t*)(ws + WS_YB); Ad = (const bf16_t*)(ws + WS_YBD); ldad = DFF; wofs = WS_WSO; N = 1024; K = 2048; }
            if (N == 1024) { oofs = WS_H; dofs = WS_HD; ldo = 1024; nbf = 1024; nf = 0; ncg = 16; ldp = 1024; }
            const bf16_t* Bt = (const bf16_t*)(ws + wofs);
            pg8::Gemm g{Ap, Bt, MP, N, K}; pg8::StaticOrder S; S.init(MP, N, G, bid);
            const bool gated = (ph == 7) | (ph == 17); const int lyr = (ph == 17);
            if (gated) oofs = WS_YB;
            pg8::EpiUni E{gated ? 2 : 1, (bf16_t*)(ws + oofs), ldo,
                          A.in[23] + (size_t)lyr * 3 * DFF, A.in[24] + (size_t)lyr * DFF, (float*)(ws + WS_XF), A.out + O_FCP + (size_t)lyr * 8 * 2 * DFF};
            pg8::gemm_phase(lds, g, S, E, TID);
            DecStore st{ldp, nbf, nf, (bf16_t*)(ws + dofs), (float*)(ws + WS_BAD)};
            {
                const int rxt = S.nwg % G, nfree = G - rxt;
                if (bid >= rxt) for (int it = bid - rxt; it < 8 * ncg; it += nfree) small_gemm_item(lds, Ad, ldad, Bt, K, it, st, TID);
            }
            if (ph == 1) { for (int it = bid; it < MP / 128; it += G) narrow_item<1>(Ap, Bt + (size_t)4096 * 1024, 1024, (float*)(ws + WS_BA), it, TID); }
            if (ph == 11) { for (int it = bid; it < MP / 128; it += G) narrow_item<2>(Ap, Bt + (size_t)5120 * 1024, 1024, (float*)(ws + WS_BA), it, TID); }
        } else if (EN(6) && is_ln) {
            const int tid = TID, wid = tid >> 6, lane = tid & 63; (void)tid;
            const int layer = (ph >= 16); const bool fin = (ph == 20), is2 = (ph == 10) | (ph == 20);
            const float* gam = A.in[is2 ? 28 : 26] + layer * 1024; const float* bet = A.in[is2 ? 29 : 27] + layer * 1024;
            bf16_t* XB = (bf16_t*)(ws + WS_XB); bf16_t* XBd = (bf16_t*)(ws + WS_XBD);
            const bf16_t* H = (const bf16_t*)(ws + WS_H); const bf16_t* Hd = (const bf16_t*)(ws + WS_HD);
            const bool fold = (G == 256); const int nit = fold ? MP / 16 : (MP + DB) / 16;
            for (int it = bid; it < nit; it += G) { const int row = it * 16 + wid * 2;
                if (row < MP) { const size_t o0 = (size_t)row * 1024, o1 = o0 + 1024;
                    const bool x3 = fold && (it + G >= nit) && (bid < 64) && (wid < 2);
                    if (x3) { const size_t o2 = (size_t)(bid * 2 + wid) * 1024;
                        ln_row3(XB + o0, H + o0, XB + o1, H + o1, XBd + o2, Hd + o2, gam, bet, fin ? A.out + O_YP + o0 : (float*)nullptr, fin ? (bf16_t*)nullptr : XB + o0,
                                fin ? A.out + O_YP + o1 : (float*)nullptr, fin ? (bf16_t*)nullptr : XB + o1, fin ? A.out + O_YS + o2 : (float*)nullptr, fin ? (bf16_t*)nullptr : XBd + o2, lane); }
                    else ln_row2(XB + o0, H + o0, XB + o1, H + o1, gam, bet, fin ? A.out + O_YP + o0 : (float*)nullptr, fin ? (bf16_t*)nullptr : XB + o0, fin ? A.out + O_YP + o1 : (float*)nullptr, fin ? (bf16_t*)nullptr : XB + o1, lane); }
                else { const size_t o0 = (size_t)(row - MP) * 1024, o1 = o0 + 1024;
                    ln_row2(XBd + o0, Hd + o0, XBd + o1, Hd + o1, gam, bet, fin ? A.out + O_YS + o0 : (float*)nullptr, fin ? (bf16_t*)nullptr : XBd + o0, fin ? A.out + O_YS + o1 : (float*)nullptr, fin ? (bf16_t*)nullptr : XBd + o1, lane); } }
        } else if (EN(0) && ph == 0) {
            const int tid = TID, wid = tid >> 6, lane = tid & 63; (void)tid; (void)wid; (void)lane;
#define P0_DESC(it) \
            int mi = 0; \
            _Pragma("unroll") for (int q = 1; q < 8; ++q) mi += ((it) >= P0_BASE[q]) ? 1 : 0; \
            const float* W = A.in[P0_IN[mi]] + P0_INOFF[mi]; bf16_t* Wt = (bf16_t*)(ws + P0_WOFS[mi]); const int K = P0_K[mi], N = P0_N[mi]; \
            const int idx = (it) - P0_BASE[mi], nk = K / 128, k0 = (idx % nk) * 128, n0 = (idx / nk) * 64; \
            const int ns0 = (mi == 4 || mi == 5) ? (((n0 >> 7) & 1) * DFF + (n0 >> 8) * 128 + (n0 & 127)) : n0;
            for (int it = bid; it < 1032; it += G) {
                if (it < 1024) convert_rows16(A.in[0] + (size_t)it * 16 * 1024, (bf16_t*)(ws + WS_XB) + (size_t)it * 16 * 1024, TID);
                else convert_rows16(A.in[1] + (size_t)(it - 1024) * 16 * 1024, (bf16_t*)(ws + WS_XBD) + (size_t)(it - 1024) * 16 * 1024, TID);
            }
            LAS float* s = (LAS float*)lds;
            float rr[16];
            if (bid < 3712) { P0_DESC(bid)
#pragma unroll
                for (int i = 0; i < 16; ++i) { const int e = i * 512 + tid, kk = e >> 6, nn = e & 63, n = ns0 + nn; rr[i] = (n < N) ? __builtin_nontemporal_load(W + (size_t)(k0 + kk) * N + n) : 0.f; } }
            for (int it = bid; it < 3712; it += G) {
#pragma unroll
                for (int i = 0; i < 16; ++i) { const int e = i * 512 + tid, kk = e >> 6, nn = e & 63; s[nn * 129 + kk] = rr[i]; }
                __syncthreads();
                if (it + G < 3712) { P0_DESC(it + G)
#pragma unroll
                    for (int i = 0; i < 16; ++i) { const int e = i * 512 + tid, kk = e >> 6, nn = e & 63, n = ns0 + nn; rr[i] = (n < N) ? __builtin_nontemporal_load(W + (size_t)(k0 + kk) * N + n) : 0.f; } }
                { P0_DESC(it)
#pragma unroll
                    for (int i = 0; i < 8; ++i) { const int e = i * 512 + tid, nn = e >> 6, kp = e & 63;
                        *(unsigned*)(Wt + (size_t)(n0 + nn) * K + k0 + 2 * kp) = pack2(s[nn * 129 + 2 * kp], s[nn * 129 + 2 * kp + 1]); } }
                __syncthreads();
            }
#undef P0_DESC
        } else if (EN(2) && ph == 2) {
            gdn_a_phase(lds, A, bid, G, TID);
#ifndef NO_DEC
            for (int it = bid; it < 1024; it += G) gdn_dec_item(lds, A, it, TID);
#endif
        } else if (EN(3) && ph == 3) {
            for (int it = bid; it < 256; it += G) gdn_scan_item(lds, A, it, TID);
        } else if (EN(4) && ph == 4) {
            const int tid = TID, wid = tid >> 6, lane = tid & 63; (void)tid; (void)wid; (void)lane;
            for (int it = bid; it < MP / 16; it += G) gdn_gate_row2(A, (size_t)it * 16 + wid * 2, lane);
        } else if (EN(8) && (ph == 8 || ph == 18)) {
            const int layer = (ph == 18);
            const float* cw = A.in[23] + (size_t)layer * 3 * DFF; const float* cb = A.in[24] + (size_t)layer * DFF;
            for (int it = bid; it < 256 + DB; it += G) {
                if (it < 256) ffn_fixup_item((const float*)(ws + WS_XF), (const float*)(ws + WS_XF) + (size_t)256 * 2 * DFF, (bf16_t*)(ws + WS_YB), cw, it, TID);
                else ffn_gate_dec_item((const bf16_t*)(ws + WS_PROJD), (bf16_t*)(ws + WS_YBD), cw, cb, A.in[6] + (size_t)layer * 128 * 2 * DFF, A.out + O_FCS + (size_t)layer * 128 * 2 * DFF, it - 256, TID); }
        } else if (EN(12) && ph == 12) {
            for (int it = bid; it < MP / 16; it += G) ssd_conv_item(A, it, TID);
            __syncthreads();
            for (int it = bid; it < 512; it += G) ssd_dec_item(lds, A, it, TID);
        } else if (EN(13) && ph == 13) {
            for (int it = bid; it < 256; it += G) ssd_scan_item(lds, A, it, TID);
        } else if (EN(14) && ph == 14) {
            const int tid = TID, wid = tid >> 6, lane = tid & 63; (void)tid; (void)wid; (void)lane;
            for (int it = bid; it < MP / 8; it += G) ssd_gate_row(A, (size_t)it * 8 + wid, lane);
        }
        }
        const bool again = (((unsigned)REPMASK >> ph) & 1u) && !rep_done;
        rep_done = again ? 1 : 0;
        const int phn = __builtin_amdgcn_readfirstlane(again ? ph : ph + 1);
        if (phn < ph_end) {
            { XcdBarrier xbar; xbar.bar = (unsigned*)(A.ws + WS_BARR); xbar.x = xb_xcc_id(); xbar.st = (volatile LAS unsigned*)(lds + 131072); xcd_barrier(xbar, TID); }
        }
        ph = phn;
    }
}

extern "C" void kernel_launch(void* const* d_in, const int* in_sizes, int n_in, void* d_out, int out_size, void* d_ws, size_t ws_size, hipStream_t stream) {
    static int grid = 0;
    if (grid == 0) {
        if (n_in != 30 || ws_size < WS_END) { fprintf(stderr, "kernel_launch: need 30 inputs and >= %zu bytes of workspace (got %d, %zu)\n", (size_t)WS_END, n_in, ws_size); grid = -1; return; }
        int dev = 0, cus = 0, per_cu = 0;
        (void)hipGetDevice(&dev); (void)hipDeviceGetAttribute(&cus, hipDeviceAttributeMultiprocessorCount, dev);
        if (hipOccupancyMaxActiveBlocksPerMultiprocessor(&per_cu, (const void*)fwd_kernel, 512, 0) != hipSuccess || per_cu < 1) { fprintf(stderr, "kernel_launch: occupancy query failed (%d)\n", per_cu); per_cu = 1; (void)hipGetLastError(); }
        grid = cus * per_cu;
    }
    if (grid < 0) return;
    if (hipMemsetAsync((char*)d_ws + WS_BARR, 0, 16384, stream) != hipSuccess) { fprintf(stderr, "kernel_launch: memset of barrier words failed\n"); return; }
    Args a{};
    for (int i = 0; i < 30; ++i) a.in[i] = (const float*)d_in[i];
    a.out = (float*)d_out; a.ws = (unsigned char*)d_ws;
#if ONE_LAUNCH
    a.ph_lo = 0; a.ph_hi = NPHASE;
    void* args[] = {&a};
    hipError_t e = hipLaunchCooperativeKernel((const void*)fwd_kernel, dim3(grid), dim3(512), args, 0, stream);
    if (e != hipSuccess) fprintf(stderr, "cooperative launch failed: %s (grid %d)\n", hipGetErrorString(e), grid);
#else
#ifndef NPH_RUN
#define NPH_RUN NPHASE
#endif
    for (int p = 0; p < NPH_RUN; ++p) { a.ph_lo = p; a.ph_hi = p + 1; hipLaunchKernelGGL(fwd_kernel, dim3(grid), dim3(512), 0, stream, a); }
#endif
}
```

```cpp
#include <hip/hip_runtime.h>
#include <hip/hip_cooperative_groups.h>
#include <cstdio>
namespace cg = cooperative_groups;

#ifndef ONE_LAUNCH
#define ONE_LAUNCH 1
#endif

#define LAS __attribute__((address_space(3)))
typedef unsigned short bf16_t;
typedef short bf16x8 __attribute__((ext_vector_type(8)));
typedef float f32x4 __attribute__((ext_vector_type(4)));
typedef float f32x2 __attribute__((ext_vector_type(2)));
typedef unsigned u32x4 __attribute__((ext_vector_type(4)));
typedef unsigned u32x2 __attribute__((ext_vector_type(2)));

constexpr int D = 1024, BP = 8, SL = 2048, MP = BP * SL, DB = 128;
constexpr int GH = 8, GIN = 4112, GINP = 4352;
constexpr int SIN = 5152, SINP = 5376, SINNER = 2048, SHEADS = 32;
constexpr int DFF = 2816, NUP = 5632;
constexpr float DN_ALPHA = 1.4142135623730951f;
constexpr float LN_EPS = 1e-5f, RMS_EPS = 1e-6f;

constexpr size_t MB = 1u << 20;
constexpr size_t WS_WGI = 0, WS_WGO = 17 * MB / 2, WS_WSI = 21 * MB / 2, WS_WSO = 21 * MB, WS_WUP0 = 25 * MB, WS_WUP1 = 36 * MB,
                 WS_WDN0 = 47 * MB, WS_WDN1 = 105 * MB / 2, WS_XB = 58 * MB, WS_XF = 90 * MB, WS_PROJ = 154 * MB, WS_H = 330 * MB,
                 WS_YB = 394 * MB, WS_BA = 482 * MB, WS_DEC = 484 * MB;
constexpr size_t WS_XBD = WS_DEC, WS_XFD = WS_XBD + 256 * 1024, WS_PROJD = WS_XFD + 512 * 1024, WS_BAD = WS_PROJD + 1441792,
                 WS_HD = WS_BAD + 16384, WS_YBD = WS_HD + 512 * 1024, WS_EGL = WS_YBD + 720896, WS_BARR = WS_EGL + 8192, WS_END = WS_BARR + 16384;
constexpr size_t WS_UT = WS_YB, WS_WN = WS_YB + 32 * MB, WS_QK = WS_YB + 64 * MB, WS_QD = WS_PROJ + 128 * MB, WS_KDT = WS_XF;
constexpr size_t WS_O = WS_H, WS_XA = WS_H, WS_BCA = WS_XF;

constexpr size_t O_YP = 0, O_YS = 16777216, O_GCP = 16908288, O_GCS = 16982016, O_GSP = 18161664, O_GSS = 19210240, O_SCP = 35987456,
                 O_SCS = 36061184, O_SSP = 37240832, O_SSS = 39337984, O_FCP = 72892416, O_FCS = 72982528;

constexpr int LDS_BYTES = 131072 + 2048;

__device__ __forceinline__ int make_tid(int wave_s) { unsigned ones = ~0u; asm volatile("" : "+s"(ones)); int t = wave_s * 64 + (int)__builtin_amdgcn_mbcnt_hi(ones, __builtin_amdgcn_mbcnt_lo(ones, 0u)); asm volatile("" : "+v"(t)); return t; }
__device__ __forceinline__ float bf2f(unsigned b) { return __uint_as_float(b << 16); }
typedef __bf16 bf16x2_t __attribute__((ext_vector_type(2)));
__device__ __forceinline__ unsigned pack2(float lo, float hi) { const f32x2 v = {lo, hi}; const bf16x2_t b = __builtin_convertvector(v, bf16x2_t); return __builtin_bit_cast(unsigned, b); }
__device__ __forceinline__ float lo_f(unsigned w) { return __uint_as_float(w << 16); }
__device__ __forceinline__ float hi_f(unsigned w) { return __uint_as_float(w & 0xffff0000u); }
__device__ __forceinline__ float silu_f(float x) { return x * __builtin_amdgcn_rcpf(1.f + __expf(-x)); }
__device__ __forceinline__ float sigmoid_f(float x) { return __builtin_amdgcn_rcpf(1.f + __expf(-x)); }
__device__ __forceinline__ float softplus_f(float x) { return x > 20.f ? x : log1pf(__expf(x)); }
#define DPP_F(x, ctrl, rmask) __builtin_bit_cast(float, __builtin_amdgcn_update_dpp(0, __builtin_bit_cast(int, (x)), (ctrl), (rmask), 0xf, false))
__device__ __forceinline__ float wave_sum(float v) {
    v += DPP_F(v, 0xB1, 0xf);
    v += DPP_F(v, 0x4E, 0xf);
    v += DPP_F(v, 0x141, 0xf);
    v += DPP_F(v, 0x140, 0xf);
    v += DPP_F(v, 0x142, 0xa);
    v += DPP_F(v, 0x143, 0xc);
    return __builtin_bit_cast(float, __builtin_amdgcn_readlane(__builtin_bit_cast(int, v), 63));
}
__device__ __forceinline__ float wave_incl_scan(float v, int lane) {
#pragma unroll
    for (int o = 1; o < 64; o <<= 1) { float t = __shfl_up(v, o); if (lane >= o) v += t; }
    return v;
}
__device__ __forceinline__ f32x4 mfma16(bf16x8 a, bf16x8 b, f32x4 c) { return __builtin_amdgcn_mfma_f32_16x16x32_bf16(a, b, c, 0, 0, 0); }
__device__ __forceinline__ void lds_barrier() { asm volatile("s_waitcnt lgkmcnt(0)" ::: "memory"); __builtin_amdgcn_s_barrier(); asm volatile("" ::: "memory"); }
__device__ __forceinline__ u32x2 pack4(f32x4 v) { u32x2 r; r.x = pack2(v[0], v[1]); r.y = pack2(v[2], v[3]); return r; }

namespace pg8 {
constexpr int BM = 256, BK = 64, HALF = 128, HTB = HALF * BK * 2, STAGE_BYTES = 8 * HTB, NXCD = 8, WGM = 8;
__device__ __forceinline__ int lds_byte(int r, int c) { const int st = (r >> 4) * 2 + (c >> 5), rr = r & 15, cc = c & 31, ob = rr * 64 + cc * 2; return st * 1024 + (ob ^ (((ob >> 9) & 1) << 5)); }
__device__ __forceinline__ void stage_rc(int b, int& R, int& C) { const int st = b / 1024, sb = b % 1024, swz = sb ^ (((sb >> 9) & 1) << 5); R = (st >> 1) * 16 + swz / 64; C = (st & 1) * 32 + (swz % 64) / 2; }
__device__ __forceinline__ int perm32(int rho) { const int n = rho >> 4, i = rho & 15; return 8 * (i >> 2) + 4 * n + (i & 3); }
struct Unit { int pm, pn; };
struct Gemm { const bf16_t* A; const bf16_t* Bt; int M, N, K; };
struct StaticOrder {
    int nM, nN, nwg, G, c;
    __device__ void init(int M, int N, int G_, int c_) { nM = M / BM; nN = N / BM; nwg = nM * nN; G = G_; c = c_; }
    __device__ bool next(int i, Unit& u) const {
        const long L = (long)i * G + c; if (L >= nwg) return false;
        int wgid = (int)L; { const int q = nwg / NXCD, r = nwg % NXCD, xcd = wgid % NXCD, off = wgid / NXCD; wgid = (xcd < r ? xcd * (q + 1) : r * (q + 1) + (xcd - r) * q) + off; }
        const int nig = WGM * nN, gid = wgid / nig, fm = gid * WGM, gsz = (nM - fm) < WGM ? (nM - fm) : WGM;
        u.pm = fm + ((wgid % nig) % gsz); u.pn = (wgid % nig) / gsz; return true;
    }
};
struct EpiF32 {
    static constexpr bool PERM = false;
    float* C; int ldc;
    __device__ __forceinline__ void operator()(const f32x4 (&acc)[2][2][4][2], const Unit& u, int wr, int wc, int fr, int fq) const {
        const int row0 = u.pm * BM + wr * 64 + fr, col0 = u.pn * BM + wc * 32 + 4 * fq;
#pragma unroll
        for (int ai = 0; ai < 2; ++ai)
#pragma unroll
            for (int m = 0; m < 4; ++m) { float* rowp = C + (size_t)(row0 + ai * HALF + m * 16) * ldc + col0;
#pragma unroll
                for (int bj = 0; bj < 2; ++bj)
#pragma unroll
                    for (int n = 0; n < 2; ++n) *(f32x4*)(rowp + bj * HALF + n * 16) = acc[ai][bj][m][n]; }
    }
};
struct EpiBf16 {
    static constexpr bool PERM = true;
    bf16_t* O; int ldo;
    __device__ __forceinline__ void operator()(const f32x4 (&acc)[2][2][4][2], const Unit& u, int wr, int wc, int fr, int fq) const {
        const int row0 = u.pm * BM + wr * 64 + fr, col0 = u.pn * BM + wc * 32 + 8 * fq;
#pragma unroll
        for (int ai = 0; ai < 2; ++ai)
#pragma unroll
            for (int m = 0; m < 4; ++m) { bf16_t* rowp = O + (size_t)(row0 + ai * HALF + m * 16) * ldo + col0;
#pragma unroll
                for (int bj = 0; bj < 2; ++bj) { const f32x4 v0 = acc[ai][bj][m][0], v1 = acc[ai][bj][m][1];
                    u32x4 w; w.x = pack2(v0[0], v0[1]); w.y = pack2(v0[2], v0[3]); w.z = pack2(v1[0], v1[1]); w.w = pack2(v1[2], v1[3]);
                    *(u32x4*)(rowp + bj * HALF) = w; } }
    }
};
__device__ __forceinline__ float dpp_ror1(float x) { return __builtin_bit_cast(float, __builtin_amdgcn_update_dpp(0, __builtin_bit_cast(int, x), 0x121, 0xf, 0xf, false)); }
__device__ __forceinline__ float dpp_ror2(float x) { return __builtin_bit_cast(float, __builtin_amdgcn_update_dpp(0, __builtin_bit_cast(int, x), 0x122, 0xf, 0xf, false)); }
struct EpiGate {
    bf16_t* HB; const float* cw; const float* cb; float* edge; float* first; float* cache;
    __device__ __forceinline__ void operator()(const f32x4 (&acc)[2][2][4][2], const Unit& u, int wr, int wc, int fr_, int fq_) const {
        int fr = fr_, fq = fq_; asm volatile("" : "+v"(fr), "+v"(fq));
#pragma unroll
        for (int n = 0; n < 2; ++n) {
            const int ch = u.pn * 128 + wc * 32 + 8 * fq + 4 * n;
            const f32x4 w0 = *(const f32x4*)(cw + ch), w1 = *(const f32x4*)(cw + DFF + ch), w2 = *(const f32x4*)(cw + 2 * DFF + ch), bb = *(const f32x4*)(cb + ch);
#pragma unroll
            for (int ai = 0; ai < 2; ++ai) {
                const int strip = u.pm * 4 + ai * 2 + wr;
                f32x4 pr1 = (f32x4){0.f, 0.f, 0.f, 0.f}, pr2 = pr1;
#pragma unroll
                for (int m = 0; m < 4; ++m) {
                    const f32x4 g = acc[ai][0][m][n], v = acc[ai][1][m][n];
                    f32x4 c1, c2;
#pragma unroll
                    for (int j = 0; j < 4; ++j) { c1[j] = dpp_ror1(g[j]); c2[j] = dpp_ror2(g[j]); }
                    const f32x4 p1 = (m == 0 || fr >= 1) ? c1 : pr1;
                    const f32x4 p2 = (m == 0 || fr >= 2) ? c2 : pr2;
                    pr1 = c1; pr2 = c2;
                    const size_t row = (size_t)u.pm * 256 + ai * 128 + wr * 64 + m * 16 + fr;
                    if (m == 0 && fr < 2) {
                        const f32x4 pa = (fr == 0) ? (bb + w2 * g) : (bb + w1 * p1 + w2 * g);
                        float* fp = first + ((size_t)strip * 2 + fr) * (2 * DFF) + ch;
                        *(f32x4*)fp = pa; *(f32x4*)(fp + DFF) = v;
                    } else {
                        const f32x4 y = bb + w0 * p2 + w1 * p1 + w2 * g; f32x4 o;
#pragma unroll
                        for (int j = 0; j < 4; ++j) o[j] = silu_f(y[j]) * v[j];
                        *(u32x2*)(HB + row * DFF + ch) = pack4(o);
                    }
                    if (m == 3 && fr >= 14) {
                        *(f32x4*)(edge + ((size_t)strip * 2 + (fr - 14)) * DFF + ch) = g;
                        if ((strip & 31) == 31) *(f32x4*)(cache + ((size_t)(strip >> 5) * 2 + (fr - 14)) * DFF + ch) = g;
                    }
                }
            }
        }
    }
};
struct EpiUni {
    int mode; bf16_t* O; int ldo; const float* cw; const float* cb; float* aux; float* cache;
    __device__ __forceinline__ void operator()(const f32x4 (&acc)[2][2][4][2], const Unit& u, int wr, int wc, int fr_, int fq_) const {
        (void)fr_; (void)fq_;
        unsigned ones = ~0u; asm volatile("" : "+s"(ones));
        const int lane_e = (int)__builtin_amdgcn_mbcnt_hi(ones, __builtin_amdgcn_mbcnt_lo(ones, 0u)), fr = lane_e & 15, fq = lane_e >> 4;
        if (mode == 2) { EpiGate e{O, cw, cb, aux, aux + (size_t)256 * 2 * DFF, cache}; e(acc, u, wr, wc, fr, fq); }
        else { EpiBf16 e{O, ldo}; e(acc, u, wr, wc, fr, fq); }
    }
};

template <class Epi, class Sched>
__device__ __forceinline__ void gemm_phase(LAS unsigned char* lds, const Gemm g, const Sched& S, const Epi& E, int tid_in) {
    const int tid = tid_in, wid = __builtin_amdgcn_readfirstlane(tid >> 6), lane = tid & 63, wr = wid >> 2, wc = wid & 3, fr = lane & 15, fq = lane >> 4;
    const int K = g.K, nt = K / BK;
    unsigned voffA[2], voffB[2];
#pragma unroll
    for (int i = 0; i < 2; ++i) { int R, C; stage_rc(tid * 16 + i * 8192, R, C); const int Rb = (E.mode != 0) ? ((R & ~31) + perm32(R & 31)) : R;
        voffA[i] = (unsigned)(R * K + C) * 2u; voffB[i] = (unsigned)(Rb * K + C) * 2u; }
    const size_t kstep = (size_t)(BK * 2);
    const size_t hstep = (size_t)HALF * K * 2;
    const size_t tstep = 2 * hstep;
    const unsigned ldsw = (unsigned)wid * 1024u;
    const int aoff = lds_byte(wr * 64 + fr, fq * 8), boff = lds_byte(wc * 32 + fr, fq * 8);
#define PG8_SA(b, h) (((b) * 2 + (h)) * HTB)
#define PG8_SB(b, h) ((4 + (b) * 2 + (h)) * HTB)
#define PG8_STAGE(bufoff, gbase, voff) do { _Pragma("unroll") for (int _i = 0; _i < 2; ++_i) \
        __builtin_amdgcn_global_load_lds((const unsigned*)((const char*)(gbase) + (voff)[_i]), (LAS unsigned*)(lds + (bufoff) + ldsw + _i * 8192), 16, 0, 0); } while (0)
#define PG8_LDA(dst, b, h) do { _Pragma("unroll") for (int m = 0; m < 4; ++m) _Pragma("unroll") for (int k = 0; k < 2; ++k) dst[m][k] = *(const LAS bf16x8*)(lds + PG8_SA(b, h) + aoff + m * 2048 + k * 1024); } while (0)
#define PG8_LDB(dst, b, h) do { _Pragma("unroll") for (int n = 0; n < 2; ++n) _Pragma("unroll") for (int k = 0; k < 2; ++k) dst[n][k] = *(const LAS bf16x8*)(lds + PG8_SB(b, h) + boff + n * 2048 + k * 1024); } while (0)
#define PG8_MMA(ai, bj, At, Bt) do { __builtin_amdgcn_s_setprio(1); _Pragma("unroll") for (int m = 0; m < 4; ++m) _Pragma("unroll") for (int n = 0; n < 2; ++n) _Pragma("unroll") for (int k = 0; k < 2; ++k) \
        acc[ai][bj][m][n] = __builtin_amdgcn_mfma_f32_16x16x32_bf16(Bt[n][k], At[m][k], acc[ai][bj][m][n], 0, 0, 0); __builtin_amdgcn_s_setprio(0); } while (0)
#define PG8_WAIT_V(n) asm volatile("s_waitcnt vmcnt(" #n ")" ::: "memory")
#define PG8_WAIT_L(n) asm volatile("s_waitcnt lgkmcnt(" #n ")" ::: "memory")
#define PG8_BAR __builtin_amdgcn_s_barrier()
#define PG8_SCHED __builtin_amdgcn_sched_barrier(0)
    Unit cur, nxt; int ui = 0;
    if (!S.next(0, cur)) return;
    f32x4 acc[2][2][4][2];
#pragma unroll
    for (int a = 0; a < 2; ++a)
#pragma unroll
        for (int b = 0; b < 2; ++b)
#pragma unroll
            for (int m = 0; m < 4; ++m)
#pragma unroll
                for (int n = 0; n < 2; ++n) acc[a][b][m][n] = (f32x4){0.f, 0.f, 0.f, 0.f};
    bf16x8 At[4][2], B0[2][2], B1[2][2];
    const char* cA = (const char*)g.A + (size_t)cur.pm * tstep; const char* cB = (const char*)g.Bt + (size_t)cur.pn * tstep;
    PG8_STAGE(PG8_SB(0, 0), cB, voffB); PG8_STAGE(PG8_SA(0, 0), cA, voffA); PG8_STAGE(PG8_SB(0, 1), cB + hstep, voffB); PG8_STAGE(PG8_SA(0, 1), cA + hstep, voffA);
    if (wr == 1) PG8_BAR;
    PG8_WAIT_V(4); PG8_BAR;
    PG8_STAGE(PG8_SB(1, 0), cB + kstep, voffB); PG8_STAGE(PG8_SA(1, 0), cA + kstep, voffA); PG8_STAGE(PG8_SB(1, 1), cB + hstep + kstep, voffB);
    PG8_WAIT_V(6); PG8_BAR;
    for (;;) {
        const bool has_next = S.next(ui + 1, nxt);
        const char* nA = has_next ? (const char*)g.A + (size_t)nxt.pm * tstep : cA; const char* nB = has_next ? (const char*)g.Bt + (size_t)nxt.pn * tstep : cB;
        for (int t = 0; t < nt; t += 2) {
            const bool last = (t == nt - 2);
            const char* a1 = cA + (size_t)(t + 1) * kstep;
            const char* a2 = last ? nA : cA + (size_t)(t + 2) * kstep; const char* b2 = last ? nB : cB + (size_t)(t + 2) * kstep;
            const char* a3 = a2 + kstep; const char* b3 = b2 + kstep;
            PG8_LDB(B0, 0, 0); PG8_SCHED; PG8_LDA(At, 0, 0); PG8_STAGE(PG8_SA(1, 1), a1 + hstep, voffA);
            PG8_WAIT_L(8); PG8_BAR; PG8_WAIT_L(0); PG8_MMA(0, 0, At, B0); PG8_BAR; PG8_SCHED;
            PG8_LDB(B1, 0, 1); PG8_STAGE(PG8_SB(0, 0), b2, voffB);
            PG8_BAR; PG8_WAIT_L(0); PG8_MMA(0, 1, At, B1); PG8_BAR;
            PG8_LDA(At, 0, 1); PG8_STAGE(PG8_SA(0, 0), a2, voffA);
            PG8_BAR; PG8_WAIT_L(0); PG8_MMA(1, 0, At, B0); PG8_BAR; PG8_SCHED;
            PG8_STAGE(PG8_SB(0, 1), b2 + hstep, voffB);
            PG8_WAIT_V(6); PG8_BAR; PG8_MMA(1, 1, At, B1); PG8_BAR;
            PG8_LDB(B0, 1, 0); PG8_SCHED; PG8_LDA(At, 1, 0); PG8_STAGE(PG8_SA(0, 1), a2 + hstep, voffA);
            PG8_WAIT_L(8); PG8_BAR; PG8_WAIT_L(0); PG8_MMA(0, 0, At, B0); PG8_BAR; PG8_SCHED;
            PG8_LDB(B1, 1, 1); PG8_STAGE(PG8_SB(1, 0), b3, voffB);
            PG8_BAR; PG8_WAIT_L(0); PG8_MMA(0, 1, At, B1); PG8_BAR;
            PG8_LDA(At, 1, 1); PG8_STAGE(PG8_SA(1, 0), a3, voffA);
            PG8_BAR; PG8_WAIT_L(0); PG8_MMA(1, 0, At, B0); PG8_BAR; PG8_SCHED;
            PG8_STAGE(PG8_SB(1, 1), b3 + hstep, voffB);
            PG8_WAIT_V(6); PG8_BAR; PG8_MMA(1, 1, At, B1); PG8_BAR;
        }
        E(acc, cur, wr, wc, fr, fq);
        if (!has_next) break;
#pragma unroll
        for (int a = 0; a < 2; ++a)
#pragma unroll
            for (int b = 0; b < 2; ++b)
#pragma unroll
                for (int m = 0; m < 4; ++m)
#pragma unroll
                    for (int n = 0; n < 2; ++n) acc[a][b][m][n] = (f32x4){0.f, 0.f, 0.f, 0.f};
        cur = nxt; cA = nA; cB = nB; ++ui;
    }
    PG8_WAIT_V(0);
    if (wr == 0) PG8_BAR;
    PG8_BAR;
#undef PG8_SA
#undef PG8_SB
#undef PG8_STAGE
#undef PG8_LDA
#undef PG8_LDB
#undef PG8_MMA
#undef PG8_WAIT_V
#undef PG8_WAIT_L
#undef PG8_BAR
#undef PG8_SCHED
}
}

struct Args {
    const float* in[30];
    float* out;
    unsigned char* ws;
    int ph_lo, ph_hi;
};

struct DecStore {
    int ldp, nbf, nf; bf16_t* Pd; float* BAd;
    __device__ __forceinline__ void operator()(int row, int col, float v0, float v1) const {
        if (col < nbf) { *(unsigned*)(Pd + (size_t)row * ldp + col) = pack2(v0, v1); }
        else if (col < nbf + nf) { BAd[row * 32 + col - nbf] = v0; BAd[row * 32 + col - nbf + 1] = v1; }
    }
};
__device__ __forceinline__ void small_gemm_item(LAS unsigned char* lds, const bf16_t* __restrict__ A, int lda, const bf16_t* __restrict__ Bt, int K, int item, const DecStore& st, int tid_in) {
    const int tid = tid_in, wid = tid >> 6, lane = tid & 63, fr = lane & 15, fq = lane >> 4;
    const int rg = item & 7, cgp = item >> 3;
    const int kw = K >> 3;
    const bf16_t* ap = A + (size_t)(rg * 16 + fr) * lda + wid * kw + fq * 8;
    const bf16_t* bp = Bt + (size_t)(cgp * 64 + fr) * K + wid * kw + fq * 8;
    f32x4 acc[4];
#pragma unroll
    for (int n = 0; n < 4; ++n) acc[n] = (f32x4){0.f, 0.f, 0.f, 0.f};
    int k0 = 0;
    for (; k0 + 128 <= kw; k0 += 128) {
        bf16x8 a[4], bq[4][4];
#pragma unroll
        for (int q = 0; q < 4; ++q) { a[q] = *(const bf16x8*)(ap + k0 + 32 * q);
#pragma unroll
            for (int n = 0; n < 4; ++n) bq[q][n] = *(const bf16x8*)(bp + (size_t)n * 16 * K + k0 + 32 * q); }
#pragma unroll
        for (int q = 0; q < 4; ++q)
#pragma unroll
            for (int n = 0; n < 4; ++n) acc[n] = mfma16(a[q], bq[q][n], acc[n]);
    }
    if (k0 < kw) {
        bf16x8 a[3], bq[3][4];
#pragma unroll
        for (int q = 0; q < 3; ++q) { a[q] = *(const bf16x8*)(ap + k0 + 32 * q);
#pragma unroll
            for (int n = 0; n < 4; ++n) bq[q][n] = *(const bf16x8*)(bp + (size_t)n * 16 * K + k0 + 32 * q); }
#pragma unroll
        for (int q = 0; q < 3; ++q)
#pragma unroll
            for (int n = 0; n < 4; ++n) acc[n] = mfma16(a[q], bq[q][n], acc[n]);
    }
    LAS float* red = (LAS float*)lds;
#pragma unroll
    for (int n = 0; n < 4; ++n)
#pragma unroll
        for (int r = 0; r < 4; ++r) red[wid * 1024 + (fq * 4 + r) * 64 + n * 16 + fr] = acc[n][r];
    __syncthreads();
    {
        const int row = tid >> 5, c2 = (tid & 31) * 2; float v0 = 0.f, v1 = 0.f;
#pragma unroll
        for (int w = 0; w < 8; ++w) { v0 += red[w * 1024 + row * 64 + c2]; v1 += red[w * 1024 + row * 64 + c2 + 1]; }
        st(rg * 16 + row, cgp * 64 + c2, v0, v1);
    }
    __syncthreads();
}

template <int NT>
__device__ __forceinline__ void narrow_item(const bf16_t* __restrict__ A, const bf16_t* __restrict__ Bt, int K, float* __restrict__ BAo, int item, int tid_in) {
    const int tid = tid_in, wid = tid >> 6, lane = tid & 63, fr = lane & 15, fq = lane >> 4;
    const int row0 = item * 128 + wid * 16;
    const bf16_t* ap = A + (size_t)(row0 + fr) * K + fq * 8;
    const bf16_t* bp = Bt + (size_t)fr * K + fq * 8;
    f32x4 acc[NT];
#pragma unroll
    for (int n = 0; n < NT; ++n) acc[n] = (f32x4){0.f, 0.f, 0.f, 0.f};
#pragma unroll 8
    for (int k = 0; k < K; k += 32) {
        const bf16x8 a = *(const bf16x8*)(ap + k);
#pragma unroll
        for (int n = 0; n < NT; ++n) { const bf16x8 bfr = *(const bf16x8*)(bp + (size_t)n * 16 * K + k); acc[n] = mfma16(bfr, a, acc[n]); }
    }
#pragma unroll
    for (int n = 0; n < NT; ++n) *(f32x4*)(BAo + (size_t)(row0 + fr) * 32 + n * 16 + fq * 4) = acc[n];
}

__device__ __forceinline__ void convert_rows16(const float* __restrict__ src, bf16_t* __restrict__ dst, int tid_in) {
#pragma unroll
    for (int i = 0; i < 8; ++i) { const int e = i * 512 + tid_in; const f32x4 v = __builtin_nontemporal_load((const f32x4*)src + e);
        u32x2 w; w.x = pack2(v[0], v[1]); w.y = pack2(v[2], v[3]); ((u32x2*)dst)[e] = w; }
}

__device__ __forceinline__ void unpack8(const u32x4 w, float (&f)[8]) {
    f[0] = lo_f(w.x); f[1] = hi_f(w.x); f[2] = lo_f(w.y); f[3] = hi_f(w.y); f[4] = lo_f(w.z); f[5] = hi_f(w.z); f[6] = lo_f(w.w); f[7] = hi_f(w.w);
}
__device__ __forceinline__ u32x4 pack8(const float (&f)[8]) { u32x4 w; w.x = pack2(f[0], f[1]); w.y = pack2(f[2], f[3]); w.z = pack2(f[4], f[5]); w.w = pack2(f[6], f[7]); return w; }
__device__ __forceinline__ void ln_row(const bf16_t* __restrict__ xres, const bf16_t* __restrict__ h, const float* __restrict__ gam, const float* __restrict__ bet,
                                       float* __restrict__ outF, bf16_t* __restrict__ outB, int lane) {
    float v[2][8]; float s = 0.f;
#pragma unroll
    for (int i = 0; i < 2; ++i) { float a[8], b[8]; unpack8(((const u32x4*)xres)[i * 64 + lane], a); unpack8(((const u32x4*)h)[i * 64 + lane], b);
#pragma unroll
        for (int j = 0; j < 8; ++j) { v[i][j] = a[j] * DN_ALPHA + b[j]; s += v[i][j]; } }
    const float mu = wave_sum(s) * (1.f / 1024.f); float q = 0.f;
#pragma unroll
    for (int i = 0; i < 2; ++i)
#pragma unroll
        for (int j = 0; j < 8; ++j) { v[i][j] -= mu; q += v[i][j] * v[i][j]; }
    const float rstd = __builtin_amdgcn_rsqf(wave_sum(q) * (1.f / 1024.f) + LN_EPS);
#pragma unroll
    for (int i = 0; i < 2; ++i) { float o[8];
#pragma unroll
        for (int hh = 0; hh < 2; ++hh) { const f32x4 g = ((const f32x4*)gam)[i * 128 + lane * 2 + hh], b = ((const f32x4*)bet)[i * 128 + lane * 2 + hh];
#pragma unroll
            for (int j = 0; j < 4; ++j) o[hh * 4 + j] = v[i][hh * 4 + j] * rstd * g[j] + b[j]; }
        if (outB) ((u32x4*)outB)[i * 64 + lane] = pack8(o);
        if (outF) { ((f32x4*)outF)[i * 128 + lane * 2] = (f32x4){o[0], o[1], o[2], o[3]}; ((f32x4*)outF)[i * 128 + lane * 2 + 1] = (f32x4){o[4], o[5], o[6], o[7]}; } }
}

__device__ __forceinline__ void ln_row2(const bf16_t* __restrict__ x0, const bf16_t* __restrict__ h0, const bf16_t* __restrict__ x1, const bf16_t* __restrict__ h1,
                                        const float* __restrict__ gam, const float* __restrict__ bet, float* oF0, bf16_t* oB0, float* oF1, bf16_t* oB1, int lane) {
    u32x4 xa[2][2], ha[2][2];
#pragma unroll
    for (int i = 0; i < 2; ++i) { xa[0][i] = ((const u32x4*)x0)[i * 64 + lane]; ha[0][i] = ((const u32x4*)h0)[i * 64 + lane]; xa[1][i] = ((const u32x4*)x1)[i * 64 + lane]; ha[1][i] = ((const u32x4*)h1)[i * 64 + lane]; }
#pragma unroll
    for (int rr = 0; rr < 2; ++rr) {
        float v[2][8]; float s = 0.f;
#pragma unroll
        for (int i = 0; i < 2; ++i) { float a[8], b[8]; unpack8(xa[rr][i], a); unpack8(ha[rr][i], b);
#pragma unroll
            for (int j = 0; j < 8; ++j) { v[i][j] = a[j] * DN_ALPHA + b[j]; s += v[i][j]; } }
        const float mu = wave_sum(s) * (1.f / 1024.f); float q = 0.f;
#pragma unroll
        for (int i = 0; i < 2; ++i)
#pragma unroll
            for (int j = 0; j < 8; ++j) { v[i][j] -= mu; q += v[i][j] * v[i][j]; }
        const float rstd = __builtin_amdgcn_rsqf(wave_sum(q) * (1.f / 1024.f) + LN_EPS);
        float* outF = rr ? oF1 : oF0; bf16_t* outB = rr ? oB1 : oB0;
#pragma unroll
        for (int i = 0; i < 2; ++i) { float o[8];
#pragma unroll
            for (int hh = 0; hh < 2; ++hh) { const f32x4 g = ((const f32x4*)gam)[i * 128 + lane * 2 + hh], b = ((const f32x4*)bet)[i * 128 + lane * 2 + hh];
#pragma unroll
                for (int j = 0; j < 4; ++j) o[hh * 4 + j] = v[i][hh * 4 + j] * rstd * g[j] + b[j]; }
            if (outB) ((u32x4*)outB)[i * 64 + lane] = pack8(o);
            if (outF) { __builtin_nontemporal_store((f32x4){o[0], o[1], o[2], o[3]}, (f32x4*)outF + i * 128 + lane * 2); __builtin_nontemporal_store((f32x4){o[4], o[5], o[6], o[7]}, (f32x4*)outF + i * 128 + lane * 2 + 1); } }
    }
}
__device__ __forceinline__ void ln_row3(const bf16_t* __restrict__ x0, const bf16_t* __restrict__ h0, const bf16_t* __restrict__ x1, const bf16_t* __restrict__ h1, const bf16_t* __restrict__ x2, const bf16_t* __restrict__ h2,
                                        const float* __restrict__ gam, const float* __restrict__ bet, float* oF0, bf16_t* oB0, float* oF1, bf16_t* oB1, float* oF2, bf16_t* oB2, int lane) {
    u32x4 xa[3][2], ha[3][2];
#pragma unroll
    for (int i = 0; i < 2; ++i) { xa[0][i] = ((const u32x4*)x0)[i * 64 + lane]; ha[0][i] = ((const u32x4*)h0)[i * 64 + lane]; xa[1][i] = ((const u32x4*)x1)[i * 64 + lane]; ha[1][i] = ((const u32x4*)h1)[i * 64 + lane]; xa[2][i] = ((const u32x4*)x2)[i * 64 + lane]; ha[2][i] = ((const u32x4*)h2)[i * 64 + lane]; }
#pragma unroll
    for (int rr = 0; rr < 3; ++rr) {
        float v[2][8]; float s = 0.f;
#pragma unroll
        for (int i = 0; i < 2; ++i) { float a[8], b[8]; unpack8(xa[rr][i], a); unpack8(ha[rr][i], b);
#pragma unroll
            for (int j = 0; j < 8; ++j) { v[i][j] = a[j] * DN_ALPHA + b[j]; s += v[i][j]; } }
        const float mu = wave_sum(s) * (1.f / 1024.f); float q = 0.f;
#pragma unroll
        for (int i = 0; i < 2; ++i)
#pragma unroll
            for (int j = 0; j < 8; ++j) { v[i][j] -= mu; q += v[i][j] * v[i][j]; }
        const float rstd = __builtin_amdgcn_rsqf(wave_sum(q) * (1.f / 1024.f) + LN_EPS);
        float* outF = rr == 0 ? oF0 : (rr == 1 ? oF1 : oF2); bf16_t* outB = rr == 0 ? oB0 : (rr == 1 ? oB1 : oB2);
#pragma unroll
        for (int i = 0; i < 2; ++i) { float o[8];
#pragma unroll
            for (int hh = 0; hh < 2; ++hh) { const f32x4 g = ((const f32x4*)gam)[i * 128 + lane * 2 + hh], b = ((const f32x4*)bet)[i * 128 + lane * 2 + hh];
#pragma unroll
                for (int j = 0; j < 4; ++j) o[hh * 4 + j] = v[i][hh * 4 + j] * rstd * g[j] + b[j]; }
            if (outB) ((u32x4*)outB)[i * 64 + lane] = pack8(o);
            if (outF) { __builtin_nontemporal_store((f32x4){o[0], o[1], o[2], o[3]}, (f32x4*)outF + i * 128 + lane * 2); __builtin_nontemporal_store((f32x4){o[4], o[5], o[6], o[7]}, (f32x4*)outF + i * 128 + lane * 2 + 1); } }
    }
}

__device__ __forceinline__ void ffn_fixup_item(const float* __restrict__ edge, const float* __restrict__ first, bf16_t* __restrict__ HB, const float* __restrict__ cw, int strip, int tid_in) {
    const int t = tid_in; if (t >= 352) return;
    const int c0 = t * 8;
    const bool has_hist = (strip & 31) != 0;
#pragma unroll
    for (int hh = 0; hh < 2; ++hh) {
        const int ch = c0 + 4 * hh;
        const f32x4 w0 = *(const f32x4*)(cw + ch), w1 = *(const f32x4*)(cw + DFF + ch);
        f32x4 e0 = (f32x4){0.f, 0.f, 0.f, 0.f}, e1 = e0;
        if (has_hist) { e0 = *(const f32x4*)(edge + ((size_t)(strip - 1) * 2 + 0) * DFF + ch); e1 = *(const f32x4*)(edge + ((size_t)(strip - 1) * 2 + 1) * DFF + ch); }
#pragma unroll
        for (int rr = 0; rr < 2; ++rr) {
            const float* fp = first + ((size_t)strip * 2 + rr) * (2 * DFF) + ch;
            const f32x4 pa = *(const f32x4*)fp, v = *(const f32x4*)(fp + DFF);
            const f32x4 y = (rr == 0) ? (pa + w0 * e0 + w1 * e1) : (pa + w0 * e1); f32x4 o;
#pragma unroll
            for (int j = 0; j < 4; ++j) o[j] = silu_f(y[j]) * v[j];
            *(u32x2*)(HB + ((size_t)strip * 64 + rr) * DFF + ch) = pack4(o);
        }
    }
}
__device__ __forceinline__ void ffn_gate_dec_item(const bf16_t* __restrict__ GVd, bf16_t* __restrict__ HBd, const float* __restrict__ cw, const float* __restrict__ cb,
                                                  const float* __restrict__ cache_in  , float* __restrict__ cache_out, int item, int tid_in) {
    const int t = tid_in; if (t >= 352) return;
    const int c0 = t * 8;
    float w0[8], w1[8], w2[8], bb[8];
#pragma unroll
    for (int j = 0; j < 8; ++j) { w0[j] = cw[c0 + j]; w1[j] = cw[DFF + c0 + j]; w2[j] = cw[2 * DFF + c0 + j]; bb[j] = cb[c0 + j]; }
    {
        const int row = item;
        float gcur[8], vv[8], o[8];
        const int cp = 256 * (c0 >> 7) + (c0 & 127);
        unpack8(*(const u32x4*)(GVd + (size_t)row * NUP + cp), gcur); unpack8(*(const u32x4*)(GVd + (size_t)row * NUP + cp + 128), vv);
        const float* ci = cache_in + (size_t)row * 2 * DFF + c0; float* co = cache_out + (size_t)row * 2 * DFF + c0;
#pragma unroll
        for (int j = 0; j < 8; ++j) { const float c0v = ci[j], c1v = ci[DFF + j]; const float y = bb[j] + w0[j] * c0v + w1[j] * c1v + w2[j] * gcur[j]; o[j] = silu_f(y) * vv[j];
            co[j] = c1v; co[DFF + j] = gcur[j]; }
        *(u32x4*)(HBd + (size_t)row * DFF + c0) = pack8(o);
    }
}

constexpr int GA_QS = 0, GA_KS = 17408, GA_VBT = 34816, GA_KBGT = 53248, GA_MS = 71680, GA_TS = 89088, GA_GC = 98304, GA_BT = 98560, GA_TL = 99328, GA_PB = 115712;
__device__ __forceinline__ void gdn_a_phase(LAS unsigned char* lds, const Args& A, int bid, int G, int tid_in) {
    const bf16_t* PROJ = (const bf16_t*)(A.ws + WS_PROJ);
    const float* BA = (const float*)(A.ws + WS_BA);
    float* EGL = (float*)(A.ws + WS_EGL);
    LAS unsigned* Qs = (LAS unsigned*)(lds + GA_QS); LAS unsigned* Ks = (LAS unsigned*)(lds + GA_KS);
    LAS float* Ms = (LAS float*)(lds + GA_MS); LAS bf16_t* Ts = (LAS bf16_t*)(lds + GA_TS);
    LAS float* gc = (LAS float*)(lds + GA_GC); LAS float* bt = (LAS float*)(lds + GA_BT);
    LAS float* Tl = (LAS float*)(lds + GA_TL); LAS float* Pb = (LAS float*)(lds + GA_PB);
    unsigned xw[3][11]; float pbr = 0.f, par = 0.f;
#define GA_IDS int tid = tid_in; asm volatile("" : "+v"(tid)); const int wid = tid >> 6, lane = tid & 63, fr = lane & 15, fq = lane >> 4, i0 = wid * 8, c = 2 * lane; (void)fr; (void)fq;
#define GA_LOAD(it) { const int _n = (it) & 31, _h = ((it) >> 5) & 7, _b = (it) >> 8; \
        _Pragma("unroll") for (int seg = 0; seg < 3; ++seg) _Pragma("unroll") for (int r = 0; r < 11; ++r) { const int t = _n * 64 + i0 + r - 3; \
            xw[seg][r] = *(const unsigned*)(PROJ + ((size_t)_b * SL + (t < 0 ? 0 : t)) * 4096 + seg * 1024 + _h * 128 + c); } \
        if (wid == 0) { const size_t _rb = (size_t)_b * SL + _n * 64 + lane; pbr = BA[_rb * 32 + _h]; par = BA[_rb * 32 + 8 + _h]; } }
    if (bid < 2048) { GA_IDS GA_LOAD(bid) }
    for (int item = bid; item < 2048; item += G) {
        GA_IDS
        const int n = item & 31, h = (item >> 5) & 7, b = item >> 8, chunk = (b * 8 + h) * 32 + n;
        bf16_t* UT = (bf16_t*)(A.ws + WS_UT) + (size_t)chunk * 8192; bf16_t* WN = (bf16_t*)(A.ws + WS_WN) + (size_t)chunk * 8192;
        bf16_t* QD = (bf16_t*)(A.ws + WS_QD) + (size_t)chunk * 8192; bf16_t* KDT = (bf16_t*)(A.ws + WS_KDT) + (size_t)chunk * 8192;
        bf16_t* QK = (bf16_t*)(A.ws + WS_QK) + (size_t)chunk * 4096;
        if (wid == 0) {
            const float g = -__expf(A.in[10][h]) * softplus_f(par + A.in[11][h]);
            const float gcum = wave_incl_scan(g, lane);
            gc[lane] = gcum; bt[lane] = sigmoid_f(pbr);
            if (lane == 63) EGL[chunk] = __expf(gcum);
        }
        lds_barrier();
        {
            const float glast = gc[63];
#pragma unroll
            for (int seg = 0; seg < 3; ++seg) {
                const int col = seg * 1024 + h * 128 + c;
                float w0[4], w1[4];
#pragma unroll
                for (int k = 0; k < 4; ++k) { const f32x2 t = *(const f32x2*)(A.in[8] + k * 3072 + col); w0[k] = t.x; w1[k] = t.y; }
                const f32x2 bb = *(const f32x2*)(A.in[9] + col);
                float x0[11], x1[11];
#pragma unroll
                for (int r = 0; r < 11; ++r) { const bool okr = (n * 64 + i0 + r - 3) >= 0; x0[r] = okr ? lo_f(xw[seg][r]) : 0.f; x1[r] = okr ? hi_f(xw[seg][r]) : 0.f; }
                if (n == 31 && wid == 7) {
#pragma unroll
                    for (int rr = 0; rr < 3; ++rr) *(f32x2*)(A.out + O_GCP + ((size_t)b * 3 + rr) * 3072 + col) = (f32x2){x0[8 + rr], x1[8 + rr]};
                }
                float y0[8], y1[8];
#pragma unroll
                for (int r = 0; r < 8; ++r) {
                    y0[r] = silu_f(bb.x + w0[0] * x0[r] + w0[1] * x0[r + 1] + w0[2] * x0[r + 2] + w0[3] * x0[r + 3]);
                    y1[r] = silu_f(bb.y + w1[0] * x1[r] + w1[1] * x1[r + 1] + w1[2] * x1[r + 2] + w1[3] * x1[r + 3]);
                }
                if (seg < 2) {
#pragma unroll
                    for (int r = 0; r < 8; ++r) { const float ss = wave_sum(y0[r] * y0[r] + y1[r] * y1[r]); const float rn = __builtin_amdgcn_rsqf(ss + 1e-6f) * (seg == 0 ? 0.08838834764831845f : 1.f); y0[r] *= rn; y1[r] *= rn; }
                }
                if (seg == 0) {
#pragma unroll
                    for (int r = 0; r < 8; ++r) { const int i = i0 + r; Qs[i * 68 + lane] = pack2(y0[r], y1[r]); const float eg = __expf(gc[i]);
                        *(unsigned*)(QD + i * 128 + c) = pack2(y0[r] * eg, y1[r] * eg); }
                } else if (seg == 1) {
                    float a0[8], a1[8], d0[8], d1[8];
#pragma unroll
                    for (int r = 0; r < 8; ++r) { const int i = i0 + r; Ks[i * 68 + lane] = pack2(y0[r], y1[r]); const float gi = gc[i], s1 = bt[i] * __expf(gi), s2 = __expf(glast - gi);
                        a0[r] = y0[r] * s1; a1[r] = y1[r] * s1; d0[r] = y0[r] * s2; d1[r] = y1[r] * s2; }
                    *(LAS u32x4*)(lds + GA_KBGT + (c * 72 + i0) * 2) = pack8(a0); *(LAS u32x4*)(lds + GA_KBGT + ((c + 1) * 72 + i0) * 2) = pack8(a1);
                    *(u32x4*)(KDT + c * 64 + i0) = pack8(d0); *(u32x4*)(KDT + (c + 1) * 64 + i0) = pack8(d1);
                } else {
                    float a0[8], a1[8];
#pragma unroll
                    for (int r = 0; r < 8; ++r) { const float be = bt[i0 + r]; a0[r] = y0[r] * be; a1[r] = y1[r] * be; }
                    *(LAS u32x4*)(lds + GA_VBT + (c * 72 + i0) * 2) = pack8(a0); *(LAS u32x4*)(lds + GA_VBT + ((c + 1) * 72 + i0) * 2) = pack8(a1);
                }
                __builtin_amdgcn_sched_barrier(0);
            }
        }
        lds_barrier();
        if (item + G < 2048) { GA_LOAD(item + G) }
        {
            const int ti = wid >> 1;
#pragma unroll
            for (int tjj = 0; tjj < 2; ++tjj) {
                const int tj = (wid & 1) * 2 + tjj;
                f32x4 ak = (f32x4){0.f, 0.f, 0.f, 0.f}, aq = (f32x4){0.f, 0.f, 0.f, 0.f};
                if (tj <= ti) {
#pragma unroll
                    for (int kk = 0; kk < 4; ++kk) {
                        const bf16x8 bk = *(const LAS bf16x8*)(lds + GA_KS + ((tj * 16 + fr) * 136 + kk * 32 + fq * 8) * 2);
                        const bf16x8 fk = *(const LAS bf16x8*)(lds + GA_KS + ((ti * 16 + fr) * 136 + kk * 32 + fq * 8) * 2);
                        const bf16x8 fqv = *(const LAS bf16x8*)(lds + GA_QS + ((ti * 16 + fr) * 136 + kk * 32 + fq * 8) * 2);
                        ak = mfma16(fk, bk, ak); aq = mfma16(fqv, bk, aq);
                    }
                }
                const int j = tj * 16 + fr; const float gj = gc[j];
#pragma unroll
                for (int r = 0; r < 4; ++r) { const int i = ti * 16 + fq * 4 + r; const float gi = gc[i];
                    const float e = (i >= j) ? __expf(gi - gj) : 0.f;
                    if (tj <= ti) Ms[i * 68 + j] = (i > j) ? bt[i] * ak[r] * e : 0.f;
                    QK[i * 64 + j] = (bf16_t)(pack2(aq[r] * e, 0.f) & 0xffffu); }
            }
        }
        lds_barrier();
        for (int ib = 0; ib < 4; ++ib) {
            if (ib > 0) {
                float p0 = 0.f, p1 = 0.f;
                const int ra = ib * 16 + 2 * wid;
                for (int j = 0; j < ib * 16; j += 4) {
                    const float t0 = Tl[j * 64 + lane], t1 = Tl[(j + 1) * 64 + lane], t2 = Tl[(j + 2) * 64 + lane], t3 = Tl[(j + 3) * 64 + lane];
                    const f32x4 m0 = *(const LAS f32x4*)(Ms + ra * 68 + j), m1 = *(const LAS f32x4*)(Ms + (ra + 1) * 68 + j);
                    p0 += (m0[0] * t0 + m0[1] * t1) + (m0[2] * t2 + m0[3] * t3);
                    p1 += (m1[0] * t0 + m1[1] * t1) + (m1[2] * t2 + m1[3] * t3);
                }
                Pb[(2 * wid) * 64 + lane] = p0; Pb[(2 * wid + 1) * 64 + lane] = p1;
                lds_barrier();
            }
            if (wid == 0) {
                float Tr[16];
#pragma unroll
                for (int r = 0; r < 16; ++r) {
                    float a = (ib > 0) ? -Pb[r * 64 + lane] : 0.f;
#pragma unroll
                    for (int q = 0; q < r; q += 4) {
                        const f32x4 m = *(const LAS f32x4*)(Ms + (ib * 16 + r) * 68 + ib * 16 + q);
                        a -= m[0] * Tr[q];
                        if (q + 1 < r) a -= m[1] * Tr[q + 1];
                        if (q + 2 < r) a -= m[2] * Tr[q + 2];
                        if (q + 3 < r) a -= m[3] * Tr[q + 3];
                    }
                    Tr[r] = a + ((lane == ib * 16 + r) ? 1.f : 0.f);
                    Tl[(ib * 16 + r) * 64 + lane] = Tr[r];
                    Ts[(ib * 16 + r) * 72 + lane] = (bf16_t)(pack2(Tr[r], 0.f) & 0xffffu);
                }
            }
            lds_barrier();
        }
        {
            const int td = wid;
            bf16x8 bv[2], bk[2];
#pragma unroll
            for (int kk = 0; kk < 2; ++kk) { bv[kk] = *(const LAS bf16x8*)(lds + GA_VBT + ((td * 16 + fr) * 72 + kk * 32 + fq * 8) * 2);
                bk[kk] = *(const LAS bf16x8*)(lds + GA_KBGT + ((td * 16 + fr) * 72 + kk * 32 + fq * 8) * 2); }
#pragma unroll
            for (int ti = 0; ti < 4; ++ti) {
                f32x4 au = (f32x4){0.f, 0.f, 0.f, 0.f}, aw = (f32x4){0.f, 0.f, 0.f, 0.f};
#pragma unroll
                for (int kk = 0; kk < 2; ++kk) { const bf16x8 ft = *(const LAS bf16x8*)(lds + GA_TS + ((ti * 16 + fr) * 72 + kk * 32 + fq * 8) * 2);
                    au = mfma16(ft, bv[kk], au);
                    aw = mfma16(bk[kk], ft, aw); }
                *(u32x2*)(UT + (td * 16 + fr) * 64 + ti * 16 + fq * 4) = pack4(au);
                *(u32x2*)(WN + (ti * 16 + fr) * 128 + td * 16 + fq * 4) = pack4(-aw);
            }
        }
        lds_barrier();
    }
#undef GA_LOAD
#undef GA_IDS
}

__device__ __forceinline__ void gdn_dec_item(LAS unsigned char* lds, const Args& A, int item, int tid_in) {
    const int tid = tid_in, wid = tid >> 6, lane = tid & 63;
    const int h = item & 7, b = item >> 3;
    const bf16_t* Pd = (const bf16_t*)(A.ws + WS_PROJD) + (size_t)b * NUP; const float* BAd = (const float*)(A.ws + WS_BAD) + b * 32;
    bf16_t* YBd = (bf16_t*)(A.ws + WS_YBD) + (size_t)b * DFF;
    LAS float* qs = (LAS float*)lds; LAS float* ks = qs + 128; LAS float* vs = qs + 256; LAS float* sc = qs + 384;
    LAS float* part = qs + 512;
    LAS float* os = qs + 512 + 1024;
    if (tid < 384) {
        const int seg = tid >> 7, d = tid & 127, col = seg * 1024 + h * 128 + d;
        const float* cin = A.in[2] + (size_t)b * 3 * 3072 + col;
        const float c0 = cin[0], c1 = cin[3072], c2 = cin[6144], nw = bf2f(Pd[col]);
        const float* cw = A.in[8] + col;
        const float y = A.in[9][col] + cw[0] * c0 + cw[3072] * c1 + cw[6144] * c2 + cw[9216] * nw;
        qs[tid] = silu_f(y);
        float* co = A.out + O_GCS + (size_t)b * 3 * 3072 + col; co[0] = c1; co[3072] = c2; co[6144] = nw;
    }
    __syncthreads();
    if (wid < 3) {
        const float q0 = qs[lane], q1 = qs[lane + 64], k0 = ks[lane], k1 = ks[lane + 64];
        const float v = (wid == 0) ? (q0 * q0 + q1 * q1) : (wid == 1) ? (k0 * k0 + k1 * k1) : (q0 * k0 + q1 * k1);
        const float s = wave_sum(v); if (lane == 0) sc[wid] = s;
    }
    __syncthreads();
    const float rq = __builtin_amdgcn_rsqf(sc[0] + 1e-6f) * 0.08838834764831845f, rk = __builtin_amdgcn_rsqf(sc[1] + 1e-6f), qk = sc[2] * rq * rk;
    const float g = -__expf(A.in[10][h]) * softplus_f(BAd[8 + h] + A.in[11][h]), eg = __expf(g), beta = sigmoid_f(BAd[h]);
    const int v = tid & 127, kg = tid >> 7;
    const float* Sin = A.in[3] + ((size_t)(b * 8 + h) * 128 + kg * 32) * 128 + v;
    float S[32]; float pk = 0.f, pq = 0.f;
#pragma unroll
    for (int k = 0; k < 32; ++k) S[k] = __builtin_nontemporal_load(Sin + k * 128);
#pragma unroll
    for (int k = 0; k < 32; ++k) { pk += ks[kg * 32 + k] * S[k]; pq += qs[kg * 32 + k] * S[k]; }
    part[kg * 128 + v] = pk * rk; part[512 + kg * 128 + v] = pq * rq;
    __syncthreads();
    const float kS = (part[v] + part[128 + v]) + (part[256 + v] + part[384 + v]);
    const float qS = (part[512 + v] + part[640 + v]) + (part[768 + v] + part[896 + v]);
    const float vnew = beta * (vs[v] - eg * kS);
    const float o = eg * qS + qk * vnew;
    float* Sout = A.out + O_GSS + ((size_t)(b * 8 + h) * 128 + kg * 32) * 128 + v;
#pragma unroll
    for (int k = 0; k < 32; ++k) __builtin_nontemporal_store(eg * S[k] + (ks[kg * 32 + k] * rk) * vnew, Sout + k * 128);
    if (kg == 0) os[v] = o;
    __syncthreads();
    if (wid == 0) {
        const float o0 = os[lane], o1 = os[lane + 64];
        const float rstd = __builtin_amdgcn_rsqf(wave_sum(o0 * o0 + o1 * o1) * (1.f / 128.f) + RMS_EPS);
        const float z0 = bf2f(Pd[3072 + h * 128 + lane]), z1 = bf2f(Pd[3072 + h * 128 + lane + 64]);
        const float r0 = o0 * rstd * A.in[12][lane] * silu_f(z0), r1 = o1 * rstd * A.in[12][lane + 64] * silu_f(z1);
        YBd[h * 128 + lane] = (bf16_t)(pack2(r0, 0.f) & 0xffffu); YBd[h * 128 + lane + 64] = (bf16_t)(pack2(r1, 0.f) & 0xffffu);
    }
    __syncthreads();
}

constexpr int GS_SB0 = 0, GS_SB1 = 8704, GS_VN = 17408;
__device__ __forceinline__ void gdn_scan_item(LAS unsigned char* lds, const Args& A, int item, int tid_in) {
    const int tid = tid_in, wid = tid >> 6, lane = tid & 63, fr = lane & 15, fq = lane >> 4;
    const int xcd = item & 7, slot = item >> 3, pair = xcd * 8 + (slot >> 2);
    const int vs = slot & 3, h = pair & 7, b = pair >> 3;
    const int ti = wid >> 1, tv = wid & 1;
    const bf16_t* UTb = (const bf16_t*)(A.ws + WS_UT); const bf16_t* WNb = (const bf16_t*)(A.ws + WS_WN);
    const bf16_t* QDb = (const bf16_t*)(A.ws + WS_QD); const bf16_t* KDTb = (const bf16_t*)(A.ws + WS_KDT);
    const bf16_t* QKb = (const bf16_t*)(A.ws + WS_QK); const float* EGL = (const float*)(A.ws + WS_EGL);
    float* O = (float*)(A.ws + WS_O);
    for (int e = tid; e < 8704 / 4; e += 512) ((LAS unsigned*)(lds + GS_SB0))[e] = 0u;
    f32x4 sacc[2]; sacc[0] = (f32x4){0.f, 0.f, 0.f, 0.f}; sacc[1] = sacc[0];
    __syncthreads();
    const int chunk0 = (b * 8 + h) * 32;
    bf16x8 nfw0[4], nfqd0[4], nfqk0[2], nfkd0[2]; u32x2 nuu0; float ndecay0;
    bf16x8 nfw1[4], nfqd1[4], nfqk1[2], nfkd1[2]; u32x2 nuu1; float ndecay1;
#define GS_LOAD(S, ch) { const size_t _c = (size_t)(ch); \
        _Pragma("unroll") for (int kk = 0; kk < 4; ++kk) { nfw##S[kk] = *(const bf16x8*)(WNb + _c * 8192 + (ti * 16 + fr) * 128 + kk * 32 + fq * 8); nfqd##S[kk] = *(const bf16x8*)(QDb + _c * 8192 + (ti * 16 + fr) * 128 + kk * 32 + fq * 8); } \
        _Pragma("unroll") for (int kk = 0; kk < 2; ++kk) { nfqk##S[kk] = *(const bf16x8*)(QKb + _c * 4096 + (ti * 16 + fr) * 64 + kk * 32 + fq * 8); nfkd##S[kk] = *(const bf16x8*)(KDTb + _c * 8192 + (wid * 16 + fr) * 64 + kk * 32 + fq * 8); } \
        nuu##S = *(const u32x2*)(UTb + _c * 8192 + (vs * 32 + tv * 16 + fr) * 64 + ti * 16 + fq * 4); ndecay##S = EGL[_c]; }
#define GS_STEP(S, nn, SBC, SBN, DOLOAD) { \
        bf16x8 fw[4], fqd[4], fqk[2], fkd[2]; \
        _Pragma("unroll") for (int kk = 0; kk < 4; ++kk) { fw[kk] = nfw##S[kk]; fqd[kk] = nfqd##S[kk]; } \
        _Pragma("unroll") for (int kk = 0; kk < 2; ++kk) { fqk[kk] = nfqk##S[kk]; fkd[kk] = nfkd##S[kk]; } \
        const u32x2 uu = nuu##S; const float decay = ndecay##S; \
        if (DOLOAD) { GS_LOAD(S, chunk0 + (nn) + 2) } \
        f32x4 acc = (f32x4){lo_f(uu.x), hi_f(uu.x), lo_f(uu.y), hi_f(uu.y)}; \
        bf16x8 fs[4]; \
        _Pragma("unroll") for (int kk = 0; kk < 4; ++kk) { fs[kk] = *(const LAS bf16x8*)(lds + (SBC) + ((tv * 16 + fr) * 136 + kk * 32 + fq * 8) * 2); acc = mfma16(fw[kk], fs[kk], acc); } \
        *(LAS u32x2*)(lds + GS_VN + ((tv * 16 + fr) * 72 + ti * 16 + fq * 4) * 2) = pack4(acc); \
        lds_barrier(); \
        f32x4 ao = (f32x4){0.f, 0.f, 0.f, 0.f}; \
        _Pragma("unroll") for (int kk = 0; kk < 4; ++kk) ao = mfma16(fs[kk], fqd[kk], ao); \
        bf16x8 fv[2][2]; \
        _Pragma("unroll") for (int t2 = 0; t2 < 2; ++t2) _Pragma("unroll") for (int kk = 0; kk < 2; ++kk) fv[t2][kk] = *(const LAS bf16x8*)(lds + GS_VN + ((t2 * 16 + fr) * 72 + kk * 32 + fq * 8) * 2); \
        _Pragma("unroll") for (int kk = 0; kk < 2; ++kk) { const bf16x8 fvo = *(const LAS bf16x8*)(lds + GS_VN + ((tv * 16 + fr) * 72 + kk * 32 + fq * 8) * 2); ao = mfma16(fvo, fqk[kk], ao); } \
        *(f32x4*)(O + ((size_t)b * SL + (nn) * 64 + ti * 16 + fr) * 1024 + h * 128 + vs * 32 + tv * 16 + fq * 4) = ao; \
        _Pragma("unroll") for (int t2 = 0; t2 < 2; ++t2) { sacc[t2] = sacc[t2] * decay; \
            _Pragma("unroll") for (int kk = 0; kk < 2; ++kk) sacc[t2] = mfma16(fkd[kk], fv[t2][kk], sacc[t2]); \
            *(LAS u32x2*)(lds + (SBN) + ((t2 * 16 + fr) * 136 + wid * 16 + fq * 4) * 2) = pack4(sacc[t2]); } \
        lds_barrier(); }
    GS_LOAD(0, chunk0) GS_LOAD(1, chunk0 + 1)
    for (int n = 0; n < 32; n += 8) {
        __builtin_amdgcn_s_waitcnt(0x0F70);
        GS_STEP(0, n, GS_SB0, GS_SB1, 1) GS_STEP(1, n + 1, GS_SB1, GS_SB0, 1) GS_STEP(0, n + 2, GS_SB0, GS_SB1, 1) GS_STEP(1, n + 3, GS_SB1, GS_SB0, 1)
        GS_STEP(0, n + 4, GS_SB0, GS_SB1, 1) GS_STEP(1, n + 5, GS_SB1, GS_SB0, 1) GS_STEP(0, n + 6, GS_SB0, GS_SB1, (n + 8 < 32)) GS_STEP(1, n + 7, GS_SB1, GS_SB0, (n + 9 < 32))
    }
#undef GS_STEP
#undef GS_LOAD
    float* So = A.out + O_GSP + (size_t)(b * 8 + h) * 16384;
#pragma unroll
    for (int t2 = 0; t2 < 2; ++t2)
#pragma unroll
        for (int r = 0; r < 4; ++r) So[(wid * 16 + fq * 4 + r) * 128 + vs * 32 + t2 * 16 + fr] = sacc[t2][r];
    __syncthreads();
}

__device__ __forceinline__ void gdn_gate_row(const Args& A, size_t row, int lane) {
    const float* O = (const float*)(A.ws + WS_O) + row * 1024 + lane * 16;
    const bf16_t* Z = (const bf16_t*)(A.ws + WS_PROJ) + row * 4096 + 3072 + lane * 16;
    bf16_t* Y = (bf16_t*)(A.ws + WS_YB) + row * 1024 + lane * 16;
    const float* nw = A.in[12] + (lane & 7) * 16;
    float o[16]; float ss = 0.f;
#pragma unroll
    for (int i = 0; i < 4; ++i) { const f32x4 v = ((const f32x4*)O)[i]; o[4 * i] = v[0]; o[4 * i + 1] = v[1]; o[4 * i + 2] = v[2]; o[4 * i + 3] = v[3]; ss += (v[0] * v[0] + v[1] * v[1]) + (v[2] * v[2] + v[3] * v[3]); }
    ss += __shfl_xor(ss, 1); ss += __shfl_xor(ss, 2); ss += __shfl_xor(ss, 4);
    const float rstd = __builtin_amdgcn_rsqf(ss * (1.f / 128.f) + RMS_EPS);
    float z[16]; { float t[8]; unpack8(((const u32x4*)Z)[0], t);
#pragma unroll
        for (int j = 0; j < 8; ++j) z[j] = t[j];
        unpack8(((const u32x4*)Z)[1], t);
#pragma unroll
        for (int j = 0; j < 8; ++j) z[8 + j] = t[j]; }
    float r[8];
#pragma unroll
    for (int hh = 0; hh < 2; ++hh) {
#pragma unroll
        for (int j = 0; j < 8; ++j) r[j] = o[hh * 8 + j] * rstd * nw[hh * 8 + j] * silu_f(z[hh * 8 + j]);
        ((u32x4*)Y)[hh] = pack8(r);
    }
}
__device__ __forceinline__ void gdn_gate_row2(const Args& A, size_t row, int lane) {
    const float* O = (const float*)(A.ws + WS_O) + row * 1024 + lane * 16;
    const bf16_t* Z = (const bf16_t*)(A.ws + WS_PROJ) + row * 4096 + 3072 + lane * 16;
    bf16_t* Y = (bf16_t*)(A.ws + WS_YB) + row * 1024 + lane * 16;
    const float* nw = A.in[12] + (lane & 7) * 16;
    f32x4 ov[2][4]; u32x4 zv[2][2];
#pragma unroll
    for (int rr = 0; rr < 2; ++rr) {
#pragma unroll
        for (int i = 0; i < 4; ++i) ov[rr][i] = ((const f32x4*)(O + rr * 1024))[i];
        zv[rr][0] = ((const u32x4*)(Z + rr * 4096))[0]; zv[rr][1] = ((const u32x4*)(Z + rr * 4096))[1];
    }
#pragma unroll
    for (int rr = 0; rr < 2; ++rr) {
        float ss = 0.f;
#pragma unroll
        for (int i = 0; i < 4; ++i) ss += (ov[rr][i][0] * ov[rr][i][0] + ov[rr][i][1] * ov[rr][i][1]) + (ov[rr][i][2] * ov[rr][i][2] + ov[rr][i][3] * ov[rr][i][3]);
        ss += __shfl_xor(ss, 1); ss += __shfl_xor(ss, 2); ss += __shfl_xor(ss, 4);
        const float rstd = __builtin_amdgcn_rsqf(ss * (1.f / 128.f) + RMS_EPS);
#pragma unroll
        for (int hh = 0; hh < 2; ++hh) { float z[8], r[8]; unpack8(zv[rr][hh], z);
#pragma unroll
            for (int j = 0; j < 8; ++j) r[j] = ov[rr][hh * 2 + (j >> 2)][j & 3] * rstd * nw[hh * 8 + j] * silu_f(z[j]);
            ((u32x4*)(Y + rr * 1024))[hh] = pack8(r); }
    }
}

__device__ __forceinline__ void ssd_conv_item(const Args& A, int item, int tid_in) {
    const int t = tid_in; if (t >= 384) return;
    const int c0 = t * 8, r0 = item * 16, tb = r0 & (SL - 1), b = r0 >> 11;
    const bf16_t* P = (const bf16_t*)(A.ws + WS_PROJ);
    bf16_t* XA = (bf16_t*)(A.ws + WS_XA); bf16_t* BCA = (bf16_t*)(A.ws + WS_BCA);
    u32x4 xq[19];
#pragma unroll
    for (int r = 0; r < 19; ++r) xq[r] = (tb == 0 && r < 3) ? (u32x4){0u, 0u, 0u, 0u} : *(const u32x4*)(P + (size_t)(r0 + r - 3) * 5120 + 2048 + c0);
    float w[4][8], bb[8];
#pragma unroll
    for (int j = 0; j < 8; ++j) { bb[j] = A.in[16][c0 + j];
#pragma unroll
        for (int k = 0; k < 4; ++k) w[k][j] = A.in[15][k * 3072 + c0 + j]; }
    float p3[8], p2[8], p1[8];
    unpack8(xq[0], p3); unpack8(xq[1], p2); unpack8(xq[2], p1);
#pragma unroll
    for (int r = 0; r < 16; ++r) {
        const size_t row = (size_t)(r0 + r);
        float cur[8], o[8];
        unpack8(xq[r + 3], cur);
#pragma unroll
        for (int j = 0; j < 8; ++j) o[j] = silu_f(bb[j] + w[0][j] * p3[j] + w[1][j] * p2[j] + w[2][j] * p1[j] + w[3][j] * cur[j]);
        if (c0 < 2048) *(u32x4*)(XA + row * 2048 + c0) = pack8(o); else *(u32x4*)(BCA + row * 1024 + (c0 - 2048)) = pack8(o);
        const int tt = tb + r;
        if (tt >= SL - 3) { float* cp = A.out + O_SCP + ((size_t)b * 3 + (tt - (SL - 3))) * 3072 + c0;
#pragma unroll
            for (int j = 0; j < 8; ++j) cp[j] = cur[j]; }
#pragma unroll
        for (int j = 0; j < 8; ++j) { p3[j] = p2[j]; p2[j] = p1[j]; p1[j] = cur[j]; }
    }
}

__device__ __forceinline__ void ssd_dec_item(LAS unsigned char* lds, const Args& A, int item, int tid_in) {
    const int tid = tid_in, wid = tid >> 6, lane = tid & 63;
    const int g = item & 3, b = item >> 2;
    const bf16_t* Pd = (const bf16_t*)(A.ws + WS_PROJD) + (size_t)b * NUP; const float* BAd = (const float*)(A.ws + WS_BAD) + b * 32;
    bf16_t* YBd = (bf16_t*)(A.ws + WS_YBD) + (size_t)b * DFF;
    LAS float* xs = (LAS float*)lds; LAS float* Bs = xs + 512; LAS float* Cs = xs + 640; LAS float* ys = xs + 768; LAS float* dts = xs + 1280; LAS float* dAs = xs + 1288; LAS float* red = xs + 1296;
    for (int c = tid; c < 768; c += 512) {
        const int xc = (c < 512) ? (g * 512 + c) : (c < 640) ? (2048 + g * 128 + (c - 512)) : (2560 + g * 128 + (c - 640));
        const float* cin = A.in[(4)] + (size_t)b * 3 * 3072 + xc;
        const float c0 = cin[0], c1 = cin[3072], c2 = cin[6144], nw = bf2f(Pd[2048 + xc]);
        const float* cw = A.in[(15)] + xc;
        xs[c] = silu_f(A.in[(16)][xc] + cw[0] * c0 + cw[3072] * c1 + cw[6144] * c2 + cw[9216] * nw);
        float* co = A.out + O_SCS + (size_t)b * 3 * 3072 + xc; co[0] = c1; co[3072] = c2; co[6144] = nw;
    }
    if (tid < 8) { const int h = g * 8 + tid; const float dt = softplus_f(BAd[h] + A.in[(18)][h]); dts[tid] = dt; dAs[tid] = __expf(-__expf(A.in[(17)][h]) * dt); }
    __syncthreads();
    const int sl = tid & 31, pr = tid >> 5;
    const f32x4 B4 = *(const LAS f32x4*)(Bs + sl * 4), C4 = *(const LAS f32x4*)(Cs + sl * 4);
    const float* Sin0 = A.in[(5)] + ((size_t)(b * 32 + g * 8) * 64) * 128 + sl * 4;
    float* Sout0 = A.out + O_SSS + ((size_t)(b * 32 + g * 8) * 64) * 128 + sl * 4;
    f32x4 Snx[4];
#pragma unroll
    for (int it = 0; it < 4; ++it) Snx[it] = __builtin_nontemporal_load((const f32x4*)(Sin0 + (it * 16 + pr) * 128));
#pragma unroll
    for (int j = 0; j < 8; ++j) {
        const float dt = dts[j], dA = dAs[j];
        f32x4 S[4];
#pragma unroll
        for (int it = 0; it < 4; ++it) S[it] = Snx[it];
        if (j + 1 < 8) {
#pragma unroll
            for (int it = 0; it < 4; ++it) Snx[it] = __builtin_nontemporal_load((const f32x4*)(Sin0 + (size_t)(j + 1) * 8192 + (it * 16 + pr) * 128));
        }
#pragma unroll
        for (int it = 0; it < 4; ++it) { const int p = it * 16 + pr; const float xd = xs[j * 64 + p] * dt;
            const f32x4 Sn = S[it] * dA + B4 * xd; __builtin_nontemporal_store(Sn, (f32x4*)(Sout0 + (size_t)j * 8192 + p * 128));
            float y = (Sn[0] * C4[0] + Sn[1] * C4[1]) + (Sn[2] * C4[2] + Sn[3] * C4[3]);
            y += DPP_F(y, 0xB1, 0xf); y += DPP_F(y, 0x4E, 0xf); y += DPP_F(y, 0x141, 0xf); y += DPP_F(y, 0x140, 0xf); y += DPP_F(y, 0x142, 0xa);
            if (sl == 31) ys[j * 64 + p] = y; }
    }
    __syncthreads();
    {
        const int c = tid, h = g * 8 + (c >> 6);
        const float y = (ys[c] + A.in[(19)][h] * xs[c]) * silu_f(bf2f(Pd[g * 512 + c]));
        const float s = wave_sum(y * y); if (lane == 0) red[wid] = s;
        __syncthreads();
        float tot = 0.f;
#pragma unroll
        for (int w = 0; w < 8; ++w) tot += red[w];
        const float r = y * __builtin_amdgcn_rsqf(tot * (1.f / 512.f) + RMS_EPS) * A.in[(20)][g * 512 + c];
        YBd[g * 512 + c] = (bf16_t)(pack2(r, 0.f) & 0xffffu);
    }
    __syncthreads();
}

constexpr int SS_XT = 0, SS_XDT = 9216, SS_BT = 18432, SS_SC = 36864, SS_SB0 = 46080, SS_SB1 = 63488, SS_BS = 80896, SS_CS = 98304, SS_AC = 115712, SS_DT = 115968;
__device__ __forceinline__ void ssd_step(LAS unsigned char* lds, bf16_t* __restrict__ Y, const size_t t0, const int h, const int sbc, const int sbn,
                                         const u32x4 px, const u32x4 pb0, const u32x4 pb1, const u32x4 pc0, const u32x4 pc1, const float pdt,
                                         const float aneg, const float dtb, const float Dh, f32x4 (&sacc)[4], const int tid) {
    const int wid = tid >> 6, lane = tid & 63, fr = lane & 15, fq = lane >> 4, ti = wid >> 1;
    const int jx = tid >> 3, xm = tid & 7, jb0 = tid >> 4, jb1 = 32 + (tid >> 4), bm = tid & 15;
    LAS float* acum = (LAS float*)(lds + SS_AC); LAS float* dtv = (LAS float*)(lds + SS_DT);
        if (wid == 0) { const float dt = softplus_f(pdt + dtb); const float ac = wave_incl_scan(dt * aneg, lane); acum[lane] = ac; dtv[lane] = dt; }
        *(LAS u32x4*)(lds + SS_BS + (jb0 * 136 + bm * 8) * 2) = pb0; *(LAS u32x4*)(lds + SS_BS + (jb1 * 136 + bm * 8) * 2) = pb1;
        *(LAS u32x4*)(lds + SS_CS + (jb0 * 136 + bm * 8) * 2) = pc0; *(LAS u32x4*)(lds + SS_CS + (jb1 * 136 + bm * 8) * 2) = pc1;
        lds_barrier();
        const float alast = acum[63];
        {
            const float sx = dtv[jx] * __expf(alast - acum[jx]);
            const int colx = (((jx >> 3) ^ xm) * 8 + (jx & 7)) * 2;
            const unsigned wx[4] = {px.x, px.y, px.z, px.w};
#pragma unroll
            for (int q = 0; q < 8; ++q) { const unsigned w = wx[q >> 1]; const unsigned short raw = (q & 1) ? (unsigned short)(w >> 16) : (unsigned short)(w & 0xffffu);
                const float xv = bf2f(raw); const int rowb = (xm * 8 + q) * 144;
                *(LAS unsigned short*)(lds + SS_XT + rowb + colx) = raw;
                *(LAS unsigned short*)(lds + SS_XDT + rowb + colx) = (unsigned short)(pack2(xv * sx, 0.f) & 0xffffu); }
            const int colb0 = (((jb0 >> 3) ^ (bm & 7)) * 8 + (jb0 & 7)) * 2, colb1 = (((jb1 >> 3) ^ (bm & 7)) * 8 + (jb1 & 7)) * 2;
            const unsigned wb0[4] = {pb0.x, pb0.y, pb0.z, pb0.w}, wb1[4] = {pb1.x, pb1.y, pb1.z, pb1.w};
#pragma unroll
            for (int q = 0; q < 8; ++q) { const int rowb = (bm * 8 + q) * 144;
                *(LAS unsigned short*)(lds + SS_BT + rowb + colb0) = (q & 1) ? (unsigned short)(wb0[q >> 1] >> 16) : (unsigned short)(wb0[q >> 1] & 0xffffu);
                *(LAS unsigned short*)(lds + SS_BT + rowb + colb1) = (q & 1) ? (unsigned short)(wb1[q >> 1] >> 16) : (unsigned short)(wb1[q >> 1] & 0xffffu); }
        }
        bf16x8 fc[4];
#pragma unroll
        for (int kk = 0; kk < 4; ++kk) fc[kk] = *(const LAS bf16x8*)(lds + SS_CS + ((ti * 16 + fr) * 136 + kk * 32 + fq * 8) * 2);
#pragma unroll
        for (int tjj = 0; tjj < 2; ++tjj) {
            const int tj = (wid & 1) * 2 + tjj;
            f32x4 acc = (f32x4){0.f, 0.f, 0.f, 0.f};
            if (tj <= ti) {
#pragma unroll
                for (int kk = 0; kk < 4; ++kk) { const bf16x8 fb = *(const LAS bf16x8*)(lds + SS_BS + ((tj * 16 + fr) * 136 + kk * 32 + fq * 8) * 2); acc = mfma16(fb, fc[kk], acc); }
            }
            const int i = ti * 16 + fr; const float ai = acum[i]; f32x4 sc;
#pragma unroll
            for (int r = 0; r < 4; ++r) { const int j = tj * 16 + fq * 4 + r; sc[r] = (i >= j) ? acc[r] * __expf(ai - acum[j]) * dtv[j] : 0.f; }
            *(LAS u32x2*)(lds + SS_SC + (i * 72 + tj * 16 + fq * 4) * 2) = pack4(sc);
        }
        lds_barrier();
        {
            bf16x8 fsc[2];
#pragma unroll
            for (int kk = 0; kk < 2; ++kk) fsc[kk] = *(const LAS bf16x8*)(lds + SS_SC + ((ti * 16 + fr) * 72 + kk * 32 + fq * 8) * 2);
            const int i = ti * 16 + fr; const float ea = __expf(acum[i]);
#pragma unroll
            for (int tpp = 0; tpp < 2; ++tpp) {
                const int tp = (wid & 1) * 2 + tpp, prow = tp * 16 + fr, psw = (prow >> 3) & 7;
                f32x4 a1 = (f32x4){0.f, 0.f, 0.f, 0.f}, a2 = (f32x4){0.f, 0.f, 0.f, 0.f};
#pragma unroll
                for (int kk = 0; kk < 2; ++kk) { const bf16x8 fx = *(const LAS bf16x8*)(lds + SS_XT + (prow * 72 + (((kk * 4 + fq) ^ psw) * 8)) * 2); a1 = mfma16(fx, fsc[kk], a1); }
#pragma unroll
                for (int kk = 0; kk < 4; ++kk) { const bf16x8 fs = *(const LAS bf16x8*)(lds + sbc + (prow * 136 + kk * 32 + fq * 8) * 2); a2 = mfma16(fs, fc[kk], a2); }
                const int p0 = tp * 16 + fq * 4;
                const int xcol = (((i >> 3) ^ ((p0 >> 3) & 7)) * 8 + (i & 7)) * 2;
                f32x4 y = a1 + a2 * ea;
#pragma unroll
                for (int r = 0; r < 4; ++r) y[r] += Dh * bf2f(*(const LAS unsigned short*)(lds + SS_XT + (p0 + r) * 144 + xcol));
                *(u32x2*)(Y + (t0 + i) * 2048 + h * 64 + p0) = pack4(y);
            }
        }
        {
            const int tp = wid >> 1, prow = tp * 16 + fr, psw = (prow >> 3) & 7; const float el = __expf(alast);
            bf16x8 fxd[2];
#pragma unroll
            for (int kk = 0; kk < 2; ++kk) fxd[kk] = *(const LAS bf16x8*)(lds + SS_XDT + (prow * 72 + (((kk * 4 + fq) ^ psw) * 8)) * 2);
#pragma unroll
            for (int q = 0; q < 4; ++q) { const int ts = (wid & 1) * 4 + q, srow = ts * 16 + fr, ssw = (srow >> 3) & 7; sacc[q] = sacc[q] * el;
#pragma unroll
                for (int kk = 0; kk < 2; ++kk) { const bf16x8 fb = *(const LAS bf16x8*)(lds + SS_BT + (srow * 72 + (((kk * 4 + fq) ^ ssw) * 8)) * 2); sacc[q] = mfma16(fb, fxd[kk], sacc[q]); }
                *(LAS u32x2*)(lds + sbn + (prow * 136 + ts * 16 + fq * 4) * 2) = pack4(sacc[q]); }
        }
        lds_barrier();
}

__device__ __forceinline__ void ssd_scan_item(LAS unsigned char* lds, const Args& A, int item, int tid_in) {
    const int tid = tid_in, wid = tid >> 6, lane = tid & 63, fr = lane & 15, fq = lane >> 4;
    const int xcd = item & 7, slot = item >> 3, grp = xcd * 4 + (slot >> 3);
    const int b = grp >> 2, g = grp & 3, h = g * 8 + (slot & 7);
    const bf16_t* XA = (const bf16_t*)(A.ws + WS_XA); const bf16_t* BCA = (const bf16_t*)(A.ws + WS_BCA); const float* BA = (const float*)(A.ws + WS_BA);
    bf16_t* Y = (bf16_t*)(A.ws + WS_YB);
    LAS float* acum = (LAS float*)(lds + SS_AC); LAS float* dtv = (LAS float*)(lds + SS_DT);
    const float aneg = -__expf(A.in[17][h]), dtb = A.in[18][h], Dh = A.in[19][h];
    for (int e = tid; e < 17408 / 4; e += 512) ((LAS unsigned*)(lds + SS_SB0))[e] = 0u;
    f32x4 sacc[4];
#pragma unroll
    for (int q = 0; q < 4; ++q) sacc[q] = (f32x4){0.f, 0.f, 0.f, 0.f};
    int cur = 0;
    const int ti = wid >> 1;
    const int jx = tid >> 3, xm = tid & 7;
    const int jb0 = tid >> 4, jb1 = 32 + (tid >> 4), bm = tid & 15;
    u32x4 npx0, npb00, npb10, npc00, npc10; float npdt0 = 0.f;
    u32x4 npx1, npb01, npb11, npc01, npc11; float npdt1 = 0.f;
#define SS_LOAD(S, nn) { const size_t _t0 = (size_t)b * SL + (nn) * 64; \
        npx##S = *(const u32x4*)(XA + (_t0 + jx) * 2048 + h * 64 + xm * 8); \
        npb0##S = *(const u32x4*)(BCA + (_t0 + jb0) * 1024 + g * 128 + bm * 8); npb1##S = *(const u32x4*)(BCA + (_t0 + jb1) * 1024 + g * 128 + bm * 8); \
        npc0##S = *(const u32x4*)(BCA + (_t0 + jb0) * 1024 + 512 + g * 128 + bm * 8); npc1##S = *(const u32x4*)(BCA + (_t0 + jb1) * 1024 + 512 + g * 128 + bm * 8); \
        if (wid == 0) npdt##S = BA[(_t0 + lane) * 32 + h]; }
#define SS_STEP(S, nn, DOLOAD) { \
        const size_t t0 = (size_t)b * SL + (nn) * 64; \
        const int sbc = cur ? SS_SB1 : SS_SB0, sbn = cur ? SS_SB0 : SS_SB1; \
        const u32x4 px = npx##S, pb0 = npb0##S, pb1 = npb1##S, pc0 = npc0##S, pc1 = npc1##S; const float pdt = npdt##S; \
        if (DOLOAD) { SS_LOAD(S, (nn) + 2) } \
        ssd_step(lds, Y, t0, h, sbc, sbn, px, pb0, pb1, pc0, pc1, pdt, aneg, dtb, Dh, sacc, tid); \
        cur ^= 1; }
    SS_LOAD(0, 0) SS_LOAD(1, 1)
    __syncthreads();
    for (int n = 0; n < 28; n += 4) {
        __builtin_amdgcn_s_waitcnt(0x0F70);
        SS_STEP(0, n, 1) SS_STEP(1, n + 1, 1) SS_STEP(0, n + 2, 1) SS_STEP(1, n + 3, 1)
    }
    __builtin_amdgcn_s_waitcnt(0x0F70);
    SS_STEP(0, 28, 1) SS_STEP(1, 29, 1) SS_STEP(0, 30, 0) SS_STEP(1, 31, 0)
#undef SS_STEP
#undef SS_LOAD
    {
        const int tp = wid >> 1; float* So = A.out + O_SSP + (size_t)(b * 32 + h) * 8192;
#pragma unroll
        for (int q = 0; q < 4; ++q) { const int ts = (wid & 1) * 4 + q; *(f32x4*)(So + (tp * 16 + fr) * 128 + ts * 16 + fq * 4) = sacc[q]; }
    }
    __syncthreads();
}

__device__ __forceinline__ void ssd_gate_row(const Args& A, size_t row, int lane) {
    bf16_t* Y = (bf16_t*)(A.ws + WS_YB) + row * 2048; const bf16_t* Z = (const bf16_t*)(A.ws + WS_PROJ) + row * 5120;
    u32x4 yq[4], zq[4];
#pragma unroll
    for (int g = 0; g < 4; ++g) { yq[g] = *(const u32x4*)(Y + g * 512 + lane * 8); zq[g] = *(const u32x4*)(Z + g * 512 + lane * 8); }
#pragma unroll
    for (int g = 0; g < 4; ++g) {
        const int c0 = g * 512 + lane * 8; float y[8], z[8];
        unpack8(yq[g], y); unpack8(zq[g], z);
        float ss = 0.f;
#pragma unroll
        for (int j = 0; j < 8; ++j) { y[j] *= silu_f(z[j]); ss += y[j] * y[j]; }
        const float rstd = __builtin_amdgcn_rsqf(wave_sum(ss) * (1.f / 512.f) + RMS_EPS);
        const float* nw = A.in[20] + c0;
#pragma unroll
        for (int j = 0; j < 8; ++j) y[j] = y[j] * rstd * nw[j];
        *(u32x4*)(Y + c0) = pack8(y);
    }
}


__constant__ int P0_BASE[8] = {0, 544, 672, 1344, 1600, 2304, 3008, 3360};
__constant__ int P0_IN[8] = {7, 13, 14, 21, 22, 22, 25, 25};
__constant__ unsigned P0_INOFF[8] = {0, 0, 0, 0, 0, 1024u * 5632u, 0, 2816u * 1024u};
__constant__ unsigned P0_WOFS[8] = {(unsigned)WS_WGI, (unsigned)WS_WGO, (unsigned)WS_WSI, (unsigned)WS_WSO, (unsigned)WS_WUP0, (unsigned)WS_WUP1, (unsigned)WS_WDN0, (unsigned)WS_WDN1};
__constant__ int P0_K[8] = {1024, 1024, 1024, 2048, 1024, 1024, 2816, 2816};
__constant__ int P0_N[8] = {4112, 1024, 5152, 1024, 5632, 5632, 1024, 1024};

#define XB_TMO      128
#define XB_XCNT(j)  (256  + 64 * (j))
#define XB_XSUB(j)  (1280 + 64 * (j))
#define XB_XGEN(j)  (2304 + 64 * (j))
#define XB_TOP      3328
#define XB_TOPGEN   3392
#define XCD_BAR_WORDS 3456
#define XB_SPIN_CAP (1u << 18)
__device__ __forceinline__ unsigned xb_ld(unsigned* p)              { return __hip_atomic_load(p, __ATOMIC_RELAXED, __HIP_MEMORY_SCOPE_AGENT); }
__device__ __forceinline__ unsigned xb_add(unsigned* p, unsigned v) { return __hip_atomic_fetch_add(p, v, __ATOMIC_RELAXED, __HIP_MEMORY_SCOPE_AGENT); }
__device__ __forceinline__ unsigned xb_xcc_id() { return (unsigned)__builtin_amdgcn_s_getreg((3 << 11) | 20) & 0xFu; }
#define XB_SPIN(cond, bar) do { unsigned _sp = 0; while (cond) { __builtin_amdgcn_s_sleep(1); \
    if ((++_sp & 255u) == 0u) { if (xb_ld(&(bar)[XB_TMO])) break; if (_sp > XB_SPIN_CAP) { atomicAdd(&(bar)[XB_TMO], 1u); break; } } } } while (0)
struct XcdBarrier { unsigned* bar; unsigned x; volatile LAS unsigned* st; };
__device__ __forceinline__ XcdBarrier xcd_barrier_post(unsigned* bar, volatile LAS unsigned* st) {
    XcdBarrier b; b.bar = bar; b.x = xb_xcc_id(); b.st = st;
    if (threadIdx.x == 0) (void)xb_add(&bar[XB_XCNT(b.x)], 1u);
    return b;
}
__device__ __forceinline__ void xcd_barrier_complete(unsigned* bar, unsigned x, unsigned& nloc, unsigned& nx) {
    const unsigned G = gridDim.x * gridDim.y * gridDim.z;
    unsigned sum, cnt, mine, sp = 0u;
    for (;;) {
        sum = 0u; cnt = 0u; mine = 0u;
#pragma unroll
        for (unsigned j = 0; j < 16; ++j) { const unsigned c = xb_ld(&bar[XB_XCNT(j)]); sum += c; cnt += (c > 0u) ? 1u : 0u; mine = (j == x) ? c : mine; }
        if (sum == G) break;
        __builtin_amdgcn_s_sleep(1);
        if ((++sp & 255u) == 0u) { if (xb_ld(&bar[XB_TMO])) break; if (sp > XB_SPIN_CAP) { atomicAdd(&bar[XB_TMO], 1u); break; } }
    }
    nloc = mine > 0u ? mine : 1u; nx = cnt > 0u ? cnt : 1u;
}
__device__ __forceinline__ void xcd_barrier(const XcdBarrier& b, int tid) {
    asm volatile("s_waitcnt vmcnt(0)" ::: "memory");
    __syncthreads();
    if (tid == 0) {
        unsigned* bar = b.bar;
        __builtin_amdgcn_s_waitcnt(0);
        unsigned nloc = b.st[0], nx = b.st[1];
        if (nloc == 0u) { xcd_barrier_complete(bar, b.x, nloc, nx); b.st[0] = nloc; b.st[1] = nx; }
        const unsigned old = xb_add(&bar[XB_XSUB(b.x)], 1u);
        const unsigned gen = old / nloc;
        if (old + 1u == (gen + 1u) * nloc) {
            __builtin_amdgcn_fence(__ATOMIC_RELEASE, "agent");
            asm volatile("s_waitcnt vmcnt(0)" ::: "memory");
            const unsigned og = xb_add(&bar[XB_TOP], 1u);
            const unsigned tg = og / nx;
            if (og + 1u == (tg + 1u) * nx) xb_add(&bar[XB_TOPGEN], 1u);
            else XB_SPIN(xb_ld(&bar[XB_TOPGEN]) == tg, bar);
            __builtin_amdgcn_fence(__ATOMIC_ACQUIRE, "agent");
            xb_add(&bar[XB_XGEN(b.x)], 1u);
            asm volatile("s_waitcnt vmcnt(0)" ::: "memory");
        } else {
            XB_SPIN(xb_ld(&bar[XB_XGEN(b.x)]) == gen, bar);
            __builtin_amdgcn_fence(__ATOMIC_ACQUIRE, "agent");
            asm volatile("s_waitcnt vmcnt(0)" ::: "memory");
        }
    }
    __syncthreads();
}

#ifndef PHMASK
#define PHMASK 0xffffff
#endif
#define EN(k) ((PHMASK >> (k)) & 1)
constexpr int NPHASE = 21;
__global__ void __launch_bounds__(512, 2) fwd_kernel(Args A) {
    __shared__ __attribute__((aligned(16))) unsigned char lds_raw[LDS_BYTES];
    LAS unsigned char* lds = (LAS unsigned char*)lds_raw;
    const int wave_s = __builtin_amdgcn_readfirstlane((int)threadIdx.x >> 6);
#define TID make_tid(wave_s)
    if (threadIdx.x < 4) ((LAS unsigned*)(lds + 131072))[threadIdx.x] = 0u;
    __syncthreads();
    (void)xcd_barrier_post((unsigned*)(A.ws + WS_BARR), (volatile LAS unsigned*)(lds + 131072));
    if (A.ph_hi > NPHASE) cg::this_grid().sync();
#ifndef REPMASK
#define REPMASK 0
#endif
    const int ph_end = __builtin_amdgcn_readfirstlane(A.ph_hi);
    int rep_done = 0;
    for (int ph = __builtin_amdgcn_readfirstlane(A.ph_lo); ph < ph_end; ) {
        {
        int G = gridDim.x, bid = blockIdx.x; asm volatile("" : "+s"(G), "+s"(bid));
        unsigned long long zoff = 0; asm volatile("" : "+s"(zoff));
        unsigned char* ws = A.ws + zoff;
        const bool is_gemm = (ph == 1) | (ph == 5) | (ph == 7) | (ph == 9) | (ph == 11) | (ph == 15) | (ph == 17) | (ph == 19);
        const bool is_ln = (ph == 6) | (ph == 10) | (ph == 16) | (ph == 20);
        if (EN(1) && is_gemm) {
            const bf16_t* Ap = (const bf16_t*)(ws + WS_XB); const bf16_t* Ad = (const bf16_t*)(ws + WS_XBD); int ldad = 1024;
            size_t wofs = WS_WGI, oofs = WS_PROJ, dofs = WS_PROJD; int N = 4096, K = 1024, ldo = 4096, nbf = 4096, nf = 16, ncg = 65, ldp = NUP;
            if (ph == 5) { Ap = (const bf16_t*)(ws + WS_YB); Ad = (const bf16_t*)(ws + WS_YBD); ldad = DFF; wofs = WS_WGO; N = 1024; K = 1024; }
            else if (ph == 7 || ph == 17) { wofs = (ph == 7) ? WS_WUP0 : WS_WUP1; N = NUP; K = 1024; ldo = NUP; nbf = NUP; nf = 0; ncg = 88; }
            else if (ph == 9 || ph == 19) { Ap = (const bf16_t*)(ws + WS_YB); Ad = (const bf16_t*)(ws + WS_YBD); ldad = DFF; wofs = (ph == 9) ? WS_WDN0 : WS_WDN1; N = 1024; K = DFF; }
            else if (ph == 11) { wofs = WS_WSI; N = 5120; K = 1024; ldo = 5120; nbf = 5120; nf = 32; ncg = 81; }
            else if (ph == 15) { Ap = (const bf16_t*)(ws + WS_YB); Ad = (const bf16_t*)(ws + WS_YBD); ldad = DFF; wofs = WS_WSO; N = 1024; K = 2048; }
            if (N == 1024) { oofs = WS_H; dofs = WS_HD; ldo = 1024; nbf = 1024; nf = 0; ncg = 16; ldp = 1024; }
            const bf16_t* Bt = (const bf16_t*)(ws + wofs);
            pg8::Gemm g{Ap, Bt, MP, N, K}; pg8::StaticOrder S; S.init(MP, N, G, bid);
            const bool gated = (ph == 7) | (ph == 17); const int lyr = (ph == 17);
            if (gated) oofs = WS_YB;
            pg8::EpiUni E{gated ? 2 : 1, (bf16_t*)(ws + oofs), ldo,
                          A.in[23] + (size_t)lyr * 3 * DFF, A.in[24] + (size_t)lyr * DFF, (float*)(ws + WS_XF), A.out + O_FCP + (size_t)lyr * 8 * 2 * DFF};
            pg8::gemm_phase(lds, g, S, E, TID);
            DecStore st{ldp, nbf, nf, (bf16_t*)(ws + dofs), (float*)(ws + WS_BAD)};
            {
                const int rxt = S.nwg % G, nfree = G - rxt;
                if (bid >= rxt) for (int it = bid - rxt; it < 8 * ncg; it += nfree) small_gemm_item(lds, Ad, ldad, Bt, K, it, st, TID);
            }
            if (ph == 1) { for (int it = bid; it < MP / 128; it += G) narrow_item<1>(Ap, Bt + (size_t)4096 * 1024, 1024, (float*)(ws + WS_BA), it, TID); }
            if (ph == 11) { for (int it = bid; it < MP / 128; it += G) narrow_item<2>(Ap, Bt + (size_t)5120 * 1024, 1024, (float*)(ws + WS_BA), it, TID); }
        } else if (EN(6) && is_ln) {
            const int tid = TID, wid = tid >> 6, lane = tid & 63; (void)tid;
            const int layer = (ph >= 16); const bool fin = (ph == 20), is2 = (ph == 10) | (ph == 20);
            const float* gam = A.in[is2 ? 28 : 26] + layer * 1024; const float* bet = A.in[is2 ? 29 : 27] + layer * 1024;
            bf16_t* XB = (bf16_t*)(ws + WS_XB); bf16_t* XBd = (bf16_t*)(ws + WS_XBD);
            const bf16_t* H = (const bf16_t*)(ws + WS_H); const bf16_t* Hd = (const bf16_t*)(ws + WS_HD);
            const bool fold = (G == 256); const int nit = fold ? MP / 16 : (MP + DB) / 16;
            for (int it = bid; it < nit; it += G) { const int row = it * 16 + wid * 2;
                if (row < MP) { const size_t o0 = (size_t)row * 1024, o1 = o0 + 1024;
                    const bool x3 = fold && (it + G >= nit) && (bid < 64) && (wid < 2);
                    if (x3) { const size_t o2 = (size_t)(bid * 2 + wid) * 1024;
                        ln_row3(XB + o0, H + o0, XB + o1, H + o1, XBd + o2, Hd + o2, gam, bet, fin ? A.out + O_YP + o0 : (float*)nullptr, fin ? (bf16_t*)nullptr : XB + o0,
                                fin ? A.out + O_YP + o1 : (float*)nullptr, fin ? (bf16_t*)nullptr : XB + o1, fin ? A.out + O_YS + o2 : (float*)nullptr, fin ? (bf16_t*)nullptr : XBd + o2, lane); }
                    else ln_row2(XB + o0, H + o0, XB + o1, H + o1, gam, bet, fin ? A.out + O_YP + o0 : (float*)nullptr, fin ? (bf16_t*)nullptr : XB + o0, fin ? A.out + O_YP + o1 : (float*)nullptr, fin ? (bf16_t*)nullptr : XB + o1, lane); }
                else { const size_t o0 = (size_t)(row - MP) * 1024, o1 = o0 + 1024;
                    ln_row2(XBd + o0, Hd + o0, XBd + o1, Hd + o1, gam, bet, fin ? A.out + O_YS + o0 : (float*)nullptr, fin ? (bf16_t*)nullptr : XBd + o0, fin ? A.out + O_YS + o1 : (float*)nullptr, fin ? (bf16_t*)nullptr : XBd + o1, lane); } }
        } else if (EN(0) && ph == 0) {
            const int tid = TID, wid = tid >> 6, lane = tid & 63; (void)tid; (void)wid; (void)lane;
#define P0_DESC(it) \
            int mi = 0; \
            _Pragma("unroll") for (int q = 1; q < 8; ++q) mi += ((it) >= P0_BASE[q]) ? 1 : 0; \
            const float* W = A.in[P0_IN[mi]] + P0_INOFF[mi]; bf16_t* Wt = (bf16_t*)(ws + P0_WOFS[mi]); const int K = P0_K[mi], N = P0_N[mi]; \
            const int idx = (it) - P0_BASE[mi], nk = K / 128, k0 = (idx % nk) * 128, n0 = (idx / nk) * 64; \
            const int ns0 = (mi == 4 || mi == 5) ? (((n0 >> 7) & 1) * DFF + (n0 >> 8) * 128 + (n0 & 127)) : n0;
            for (int it = bid; it < 1032; it += G) {
                if (it < 1024) convert_rows16(A.in[0] + (size_t)it * 16 * 1024, (bf16_t*)(ws + WS_XB) + (size_t)it * 16 * 1024, TID);
                else convert_rows16(A.in[1] + (size_t)(it - 1024) * 16 * 1024, (bf16_t*)(ws + WS_XBD) + (size_t)(it - 1024) * 16 * 1024, TID);
            }
            LAS float* s = (LAS float*)lds;
            float rr[16];
            if (bid < 3712) { P0_DESC(bid)
#pragma unroll
                for (int i = 0; i < 16; ++i) { const int e = i * 512 + tid, kk = e >> 6, nn = e & 63, n = ns0 + nn; rr[i] = (n < N) ? __builtin_nontemporal_load(W + (size_t)(k0 + kk) * N + n) : 0.f; } }
            for (int it = bid; it < 3712; it += G) {
#pragma unroll
                for (int i = 0; i < 16; ++i) { const int e = i * 512 + tid, kk = e >> 6, nn = e & 63; s[nn * 129 + kk] = rr[i]; }
                __syncthreads();
                if (it + G < 3712) { P0_DESC(it + G)
#pragma unroll
                    for (int i = 0; i < 16; ++i) { const int e = i * 512 + tid, kk = e >> 6, nn = e & 63, n = ns0 + nn; rr[i] = (n < N) ? __builtin_nontemporal_load(W + (size_t)(k0 + kk) * N + n) : 0.f; } }
                { P0_DESC(it)
#pragma unroll
                    for (int i = 0; i < 8; ++i) { const int e = i * 512 + tid, nn = e >> 6, kp = e & 63;
                        *(unsigned*)(Wt + (size_t)(n0 + nn) * K + k0 + 2 * kp) = pack2(s[nn * 129 + 2 * kp], s[nn * 129 + 2 * kp + 1]); } }
                __syncthreads();
            }
#undef P0_DESC
        } else if (EN(2) && ph == 2) {
            gdn_a_phase(lds, A, bid, G, TID);
#ifndef NO_DEC
            for (int it = bid; it < 1024; it += G) gdn_dec_item(lds, A, it, TID);
#endif
        } else if (EN(3) && ph == 3) {
            for (int it = bid; it < 256; it += G) gdn_scan_item(lds, A, it, TID);
        } else if (EN(4) && ph == 4) {
            const int tid = TID, wid = tid >> 6, lane = tid & 63; (void)tid; (void)wid; (void)lane;
            for (int it = bid; it < MP / 16; it += G) gdn_gate_row2(A, (size_t)it * 16 + wid * 2, lane);
        } else if (EN(8) && (ph == 8 || ph == 18)) {
            const int layer = (ph == 18);
            const float* cw = A.in[23] + (size_t)layer * 3 * DFF; const float* cb = A.in[24] + (size_t)layer * DFF;
            for (int it = bid; it < 256 + DB; it += G) {
                if (it < 256) ffn_fixup_item((const float*)(ws + WS_XF), (const float*)(ws + WS_XF) + (size_t)256 * 2 * DFF, (bf16_t*)(ws + WS_YB), cw, it, TID);
                else ffn_gate_dec_item((const bf16_t*)(ws + WS_PROJD), (bf16_t*)(ws + WS_YBD), cw, cb, A.in[6] + (size_t)layer * 128 * 2 * DFF, A.out + O_FCS + (size_t)layer * 128 * 2 * DFF, it - 256, TID); }
        } else if (EN(12) && ph == 12) {
            for (int it = bid; it < MP / 16; it += G) ssd_conv_item(A, it, TID);
            __syncthreads();
            for (int it = bid; it < 512; it += G) ssd_dec_item(lds, A, it, TID);
        } else if (EN(13) && ph == 13) {
            for (int it = bid; it < 256; it += G) ssd_scan_item(lds, A, it, TID);
        } else if (EN(14) && ph == 14) {
            const int tid = TID, wid = tid >> 6, lane = tid & 63; (void)tid; (void)wid; (void)lane;
            for (int it = bid; it < MP / 8; it += G) ssd_gate_row(A, (size_t)it * 8 + wid, lane);
        }
        }
        const bool again = (((unsigned)REPMASK >> ph) & 1u) && !rep_done;
        rep_done = again ? 1 : 0;
        const int phn = __builtin_amdgcn_readfirstlane(again ? ph : ph + 1);
        if (phn < ph_end) {
            { XcdBarrier xbar; xbar.bar = (unsigned*)(A.ws + WS_BARR); xbar.x = xb_xcc_id(); xbar.st = (volatile LAS unsigned*)(lds + 131072); xcd_barrier(xbar, TID); }
        }
        ph = phn;
    }
}

extern "C" void kernel_launch(void* const* d_in, const int* in_sizes, int n_in, void* d_out, int out_size, void* d_ws, size_t ws_size, hipStream_t stream) {
    static int grid = 0;
    if (grid == 0) {
        if (n_in != 30 || ws_size < WS_END) { fprintf(stderr, "kernel_launch: need 30 inputs and >= %zu bytes of workspace (got %d, %zu)\n", (size_t)WS_END, n_in, ws_size); grid = -1; return; }
        int dev = 0, cus = 0, per_cu = 0;
        (void)hipGetDevice(&dev); (void)hipDeviceGetAttribute(&cus, hipDeviceAttributeMultiprocessorCount, dev);
        if (hipOccupancyMaxActiveBlocksPerMultiprocessor(&per_cu, (const void*)fwd_kernel, 512, 0) != hipSuccess || per_cu < 1) { fprintf(stderr, "kernel_launch: occupancy query failed (%d)\n", per_cu); per_cu = 1; (void)hipGetLastError(); }
        grid = cus * per_cu;
    }
    if (grid < 0) return;
    if (hipMemsetAsync((char*)d_ws + WS_BARR, 0, 16384, stream) != hipSuccess) { fprintf(stderr, "kernel_launch: memset of barrier words failed\n"); return; }
    Args a{};
    for (int i = 0; i < 30; ++i) a.in[i] = (const float*)d_in[i];
    a.out = (float*)d_out; a.ws = (unsigned char*)d_ws;
#if ONE_LAUNCH
    a.ph_lo = 0; a.ph_hi = NPHASE;
    void* args[] = {&a};
    hipError_t e = hipLaunchCooperativeKernel((const void*)fwd_kernel, dim3(grid), dim3(512), args, 0, stream);
    if (e != hipSuccess) fprintf(stderr, "cooperative launch failed: %s (grid %d)\n", hipGetErrorString(e), grid);
#else
#ifndef NPH_RUN
#define NPH_RUN NPHASE
#endif
    for (int p = 0; p < NPH_RUN; ++p) { a.ph_lo = p; a.ph_hi = p + 1; hipLaunchKernelGGL(fwd_kernel, dim3(grid), dim3(512), 0, stream, a); }
#endif
}
```
